# Optimizing an MI355X kernel written in HIP

```python
import jax
import jax.numpy as jnp
from jax import lax
import numpy as np

D_MODEL = 2048
BATCH = 4
SEQ = 2048
DEPTH = 2

N_MEM = 256
EPS = 1e-6
NEG_BIG = -1e30
MIN_FORGET = 1e-20
HG_HEADS = 8
HG_DK = 128
HG_DV = 128
HG_CHUNK = 64
MLA_HEADS = 8
MLA_Q_RANK = 512
MLA_KV_RANK = 512
MLA_NOPE = 128
MLA_ROPE = 64
MLA_V = 128
ROPE_THETA = 10000.0
Q_BLOCK = 128
MEM_HEADS = 4
MEM_HEAD_DIM = 256
N_BRANCH = 3
BRANCH_WIDTH = HG_HEADS * HG_DV
D_IN = (2 * HG_HEADS * HG_DK + 2 * HG_HEADS * HG_DV + MLA_Q_RANK + MLA_KV_RANK
        + MLA_ROPE + MEM_HEADS * MEM_HEAD_DIM + N_BRANCH * D_MODEL)
D_FF = 5632
N_EXPERTS = 8
TOP_K = 2
D_FF_EXPERT = 7168
MOE_BLOCK = 128
N_DENSE = (DEPTH + 1) // 2
N_MOE = DEPTH // 2

kernel_name = 'hybrid_hgrn2_mla_memxattn_moe_trunk'


def rmsnorm(x, g):
    xf = x.astype(jnp.float32)
    y = xf * lax.rsqrt(jnp.mean(xf * xf, axis=-1, keepdims=True) + EPS)
    return (y * g.astype(jnp.float32)).astype(x.dtype)


def apply_rope(x, cos, sin):
    half = MLA_ROPE // 2
    x1 = x[..., :half].astype(jnp.float32)
    x2 = x[..., half:].astype(jnp.float32)
    return jnp.concatenate([x1 * cos - x2 * sin, x2 * cos + x1 * sin], axis=-1).astype(x.dtype)


def hgrn2_mix(q, f_logit, i, lb):
    B, S = q.shape[:2]
    lbf = lb.astype(jnp.float32)
    f = lbf + (1.0 - lbf) * jax.nn.sigmoid(f_logit.astype(jnp.float32))
    log_f = jnp.log(jnp.maximum(f, MIN_FORGET))
    k = 1.0 - f
    nc = S // HG_CHUNK

    def to_chunks(t, d):
        return t.astype(jnp.float32).reshape(B, nc, HG_CHUNK, HG_HEADS, d).transpose(1, 0, 3, 2, 4)

    qc, kc, vc, lfc = to_chunks(q, HG_DK), to_chunks(k, HG_DK), to_chunks(i, HG_DV), to_chunks(log_f, HG_DK)
    causal = jnp.tril(jnp.ones((HG_CHUNK, HG_CHUNK), dtype=bool))

    def step(state, inp):
        qb, kb, vb, lfb = inp
        b = jnp.cumsum(lfb, axis=2)
        o_inter = jnp.einsum('bhtd,bhde->bhte', qb * jnp.exp(b), state)
        diff = b[:, :, :, None, :] - b[:, :, None, :, :]
        decay = jnp.exp(jnp.where(causal[None, None, :, :, None], diff, NEG_BIG))
        scores = jnp.einsum('bhtd,bhsd,bhtsd->bhts', qb, kb, decay)
        o_intra = jnp.einsum('bhts,bhse->bhte', scores, vb)
        b_last = b[:, :, -1:, :]
        new_state = (jnp.exp(b_last[:, :, 0, :])[..., None] * state
                     + jnp.einsum('bhsd,bhse->bhde', kb * jnp.exp(b_last - b), vb))
        return new_state, o_inter + o_intra

    state0 = jnp.zeros((B, HG_HEADS, HG_DK, HG_DV), jnp.float32)
    _, oc = lax.scan(step, state0, (qc, kc, vc, lfc))
    return oc.transpose(1, 0, 3, 2, 4).reshape(B, S, HG_HEADS, HG_DV)


def causal_block_attention(q, k, v):
    B, S, H, _ = q.shape
    nqb = S // Q_BLOCK
    qb = q.reshape(B, nqb, Q_BLOCK, H, q.shape[-1]).transpose(1, 0, 2, 3, 4)
    key_pos = jnp.arange(S)

    def one_block(args):
        q_blk, blk = args
        s = jnp.einsum('bqhd,bkhd->bhqk', q_blk, k, preferred_element_type=jnp.float32)
        q_pos = blk * Q_BLOCK + jnp.arange(Q_BLOCK)
        s = jnp.where(key_pos[None, :] <= q_pos[:, None], s, NEG_BIG)
        p = jax.nn.softmax(s, axis=-1).astype(v.dtype)
        return jnp.einsum('bhqk,bkhd->bqhd', p, v)

    out = lax.map(one_block, (qb, jnp.arange(nqb)))
    return out.transpose(1, 0, 2, 3, 4).reshape(B, S, H, v.shape[-1])


def mla_mix(c_q, kv_a, q_norm, w_q_up, kv_norm, w_kv_up, cos, sin):
    B, S = c_q.shape[:2]
    q = (rmsnorm(c_q, q_norm) @ w_q_up).reshape(B, S, MLA_HEADS, MLA_NOPE + MLA_ROPE)
    q_nope, q_rope = q[..., :MLA_NOPE], apply_rope(q[..., MLA_NOPE:], cos, sin)
    c_kv, k_rope = kv_a[..., :MLA_KV_RANK], kv_a[..., MLA_KV_RANK:]
    kv = (rmsnorm(c_kv, kv_norm) @ w_kv_up).reshape(B, S, MLA_HEADS, MLA_NOPE + MLA_V)
    k_nope, v = kv[..., :MLA_NOPE], kv[..., MLA_NOPE:]
    k_rope = apply_rope(k_rope[:, :, None, :], cos, sin)
    k = jnp.concatenate([k_nope, jnp.broadcast_to(k_rope, (B, S, MLA_HEADS, MLA_ROPE))], axis=-1)
    q = jnp.concatenate([q_nope, q_rope], axis=-1) * (MLA_NOPE + MLA_ROPE) ** -0.5
    return causal_block_attention(q, k, v).reshape(B, S, MLA_HEADS * MLA_V)


def memory_xattn(q_mem, mem_n, w_mem_kv):
    B, S = q_mem.shape[:2]
    q = q_mem.reshape(B, S, MEM_HEADS, MEM_HEAD_DIM)
    kv = (mem_n @ w_mem_kv).reshape(B, N_MEM, 2, MEM_HEADS, MEM_HEAD_DIM)
    k, v = kv[:, :, 0], kv[:, :, 1]
    s = jnp.einsum('bshd,bmhd->bhsm', q, k, preferred_element_type=jnp.float32) * MEM_HEAD_DIM ** -0.5
    p = jax.nn.softmax(s, axis=-1).astype(v.dtype)
    return jnp.einsum('bhsm,bmhd->bshd', p, v).reshape(B, S, MEM_HEADS * MEM_HEAD_DIM)


def mixer(a, lb, w_in, hg_norm, mla_q_norm, w_q_up, mla_kv_norm, w_kv_up, mem_n, w_mem_kv,
          w_branch, w_o, cos, sin):
    B, S, _ = a.shape
    sizes = [HG_HEADS * HG_DK, HG_HEADS * HG_DK, HG_HEADS * HG_DV, HG_HEADS * HG_DV,
             MLA_Q_RANK, MLA_KV_RANK + MLA_ROPE, MEM_HEADS * MEM_HEAD_DIM, N_BRANCH * D_MODEL]
    idx = [int(c) for c in np.cumsum(sizes)[:-1]]
    q_hg, f_hg, i_hg, g_hg, c_q, kv_a, q_mem, gate_logits = jnp.split(a @ w_in, idx, axis=-1)
    o_hg = hgrn2_mix(q_hg, f_hg, i_hg, lb)
    y_hg = rmsnorm(o_hg, hg_norm).reshape(B, S, BRANCH_WIDTH).astype(a.dtype) * jax.nn.silu(g_hg)
    y_mla = mla_mix(c_q, kv_a, mla_q_norm, w_q_up, mla_kv_norm, w_kv_up, cos, sin)
    y_mem = memory_xattn(q_mem, mem_n, w_mem_kv)
    branches = jnp.stack([y_hg, y_mla, y_mem], axis=2)
    proj = jnp.einsum('bsnc,ncd->bsnd', branches, w_branch)
    gates = jax.nn.sigmoid(gate_logits).reshape(B, S, N_BRANCH, D_MODEL)
    merged = jnp.sum(gates * proj, axis=2)
    return merged @ w_o


def swiglu(x, w_gu, w_down):
    g, u = jnp.split(x @ w_gu, 2, axis=-1)
    return (jax.nn.silu(g) * u) @ w_down


def moe_ffn(x, w_router, w_gu, w_down):
    B, S, D = x.shape
    T = B * S
    A = T * TOP_K
    xt = x.reshape(T, D)
    logits = (xt @ w_router).astype(jnp.float32)
    top_logit, top_idx = lax.top_k(logits, TOP_K)
    top_w = jax.nn.softmax(top_logit, axis=-1)
    flat_e = top_idx.reshape(A)
    flat_tok = jnp.repeat(jnp.arange(T, dtype=jnp.int32), TOP_K)
    flat_w = top_w.reshape(A)
    order = jnp.argsort(flat_e)
    sorted_e = flat_e[order]
    counts = jnp.bincount(flat_e, length=N_EXPERTS)
    padded = (counts + MOE_BLOCK - 1) // MOE_BLOCK * MOE_BLOCK
    pad_end = jnp.cumsum(padded)
    pad_start = pad_end - padded
    grp_start = jnp.cumsum(counts) - counts
    dest = pad_start[sorted_e] + jnp.arange(A) - grp_start[sorted_e]
    P = ((A + MOE_BLOCK - 1) // MOE_BLOCK + N_EXPERTS) * MOE_BLOCK
    n_blk = P // MOE_BLOCK
    slot_tok = jnp.full((P,), T, jnp.int32).at[dest].set(flat_tok[order])
    slot_w = jnp.zeros((P,), jnp.float32).at[dest].set(flat_w[order])
    blk_e = jnp.minimum(jnp.sum(jnp.arange(n_blk)[:, None] * MOE_BLOCK >= pad_end[None, :], axis=1),
                        N_EXPERTS - 1)
    x_pad = jnp.concatenate([xt, jnp.zeros((1, D), xt.dtype)], axis=0)
    xs = x_pad[slot_tok].reshape(n_blk, MOE_BLOCK, D)

    def expert_block(args):
        xb, e = args
        return swiglu(xb, w_gu[e], w_down[e])

    ys = lax.map(expert_block, (xs, blk_e)).reshape(P, D)
    out = jax.ops.segment_sum(ys.astype(jnp.float32) * slot_w[:, None], slot_tok, num_segments=T + 1)[:T]
    return out.astype(x.dtype).reshape(B, S, D)


def setup_inputs(seed: int = 0) -> dict:
    key = jax.random.key(seed)
    ks = jax.random.split(key, 22)
    f32 = jnp.float32

    def nrm(k, shape, fan_in):
        return jax.random.normal(k, shape, f32) * fan_in ** -0.5

    def gain(k, shape):
        return 1.0 + 0.02 * jax.random.normal(k, shape, f32)

    positions = (jax.random.randint(ks[2], (BATCH, 1), 0, 4096, dtype=jnp.int32)
                 + jnp.arange(SEQ, dtype=jnp.int32)[None, :])
    return {
        'x': jax.random.normal(ks[0], (BATCH, SEQ, D_MODEL), f32),
        'mem': jax.random.normal(ks[1], (BATCH, N_MEM, D_MODEL), f32),
        'positions': positions,
        'hg_lb_logits': 0.1 * jax.random.normal(ks[3], (DEPTH, HG_HEADS * HG_DK), f32),
        'attn_norm': gain(ks[4], (DEPTH, D_MODEL)),
        'w_in': nrm(ks[5], (DEPTH, D_MODEL, D_IN), D_MODEL),
        'hg_norm': gain(ks[6], (DEPTH, HG_DV)),
        'mla_q_norm': gain(ks[7], (DEPTH, MLA_Q_RANK)),
        'w_q_up': nrm(ks[8], (DEPTH, MLA_Q_RANK, MLA_HEADS * (MLA_NOPE + MLA_ROPE)), MLA_Q_RANK),
        'mla_kv_norm': gain(ks[9], (DEPTH, MLA_KV_RANK)),
        'w_kv_up': nrm(ks[10], (DEPTH, MLA_KV_RANK, MLA_HEADS * (MLA_NOPE + MLA_V)), MLA_KV_RANK),
        'mem_norm': gain(ks[11], (D_MODEL,)),
        'w_mem_kv': nrm(ks[12], (DEPTH, D_MODEL, 2 * MEM_HEADS * MEM_HEAD_DIM), D_MODEL),
        'w_branch': nrm(ks[13], (DEPTH, N_BRANCH, BRANCH_WIDTH, D_MODEL), BRANCH_WIDTH),
        'w_o': nrm(ks[14], (DEPTH, D_MODEL, D_MODEL), D_MODEL),
        'ffn_norm': gain(ks[15], (DEPTH, D_MODEL)),
        'w_dense_gu': nrm(ks[16], (N_DENSE, D_MODEL, 2 * D_FF), D_MODEL),
        'w_dense_down': nrm(ks[17], (N_DENSE, D_FF, D_MODEL), D_FF),
        'w_router': nrm(ks[18], (N_MOE, D_MODEL, N_EXPERTS), D_MODEL),
        'w_expert_gu': nrm(ks[19], (N_MOE, N_EXPERTS, D_MODEL, 2 * D_FF_EXPERT), D_MODEL),
        'w_expert_down': nrm(ks[20], (N_MOE, N_EXPERTS, D_FF_EXPERT, D_MODEL), D_FF_EXPERT),
        'final_norm': gain(ks[21], (D_MODEL,)),
    }


def reference(x, mem, positions, hg_lb_logits, attn_norm, w_in, hg_norm, mla_q_norm, w_q_up,
              mla_kv_norm, w_kv_up, mem_norm, w_mem_kv, w_branch, w_o, ffn_norm, w_dense_gu,
              w_dense_down, w_router, w_expert_gu, w_expert_down, final_norm):
    half = MLA_ROPE // 2
    inv_freq = ROPE_THETA ** (-(jnp.arange(half, dtype=jnp.float32) / half))
    ang = positions.astype(jnp.float32)[:, :, None, None] * inv_freq
    cos, sin = jnp.cos(ang), jnp.sin(ang)
    lb_sm = jax.nn.softmax(hg_lb_logits.astype(jnp.float32), axis=0)
    lb_all = jnp.clip(jnp.cumsum(lb_sm, axis=0) - lb_sm[0:1], 0.0, 1.0)
    mem_n = rmsnorm(mem, mem_norm)
    h = x
    for l in range(DEPTH):
        a = rmsnorm(h, attn_norm[l])
        h = h + mixer(a, lb_all[l], w_in[l], hg_norm[l], mla_q_norm[l], w_q_up[l], mla_kv_norm[l],
                      w_kv_up[l], mem_n, w_mem_kv[l], w_branch[l], w_o[l], cos, sin)
        a = rmsnorm(h, ffn_norm[l])
        if l % 2 == 0:
            h = h + swiglu(a, w_dense_gu[l // 2], w_dense_down[l // 2])
        else:
            h = h + moe_ffn(a, w_router[l // 2], w_expert_gu[l // 2], w_expert_down[l // 2])
    return rmsnorm(h, final_norm)
```

```cpp
#include <hip/hip_runtime.h>
#ifndef MK_PROBE_MODE
#define MK_PROBE_MODE -1
#endif
#include <cstdio>
#include <cstdint>
#include <cstddef>

#ifndef MK_N_LAUNCHES
#define MK_N_LAUNCHES 1
#endif
#ifndef MK_MOE_F8
#define MK_MOE_F8 1
#endif
#ifndef MK_GATE_F8
#define MK_GATE_F8 1
#endif
#ifndef MK_LAST_PHASE
#define MK_LAST_PHASE 99
#endif

#define GAS __attribute__((address_space(1)))
#define LAS __attribute__((address_space(3)))
#define CAS __attribute__((address_space(4)))
#ifndef HG_SIGMOID
#define HG_SIGMOID fast_sigmoid
#endif
#ifndef EPI_SIGMOID
#define EPI_SIGMOID fast_sigmoid
#endif
typedef unsigned short bf16;
typedef short bf16x8 __attribute__((ext_vector_type(8)));
typedef short s16x4 __attribute__((ext_vector_type(4)));
typedef float f32x2 __attribute__((ext_vector_type(2)));
typedef float f32x4 __attribute__((ext_vector_type(4)));
typedef float f32x16 __attribute__((ext_vector_type(16)));
typedef unsigned u32x2 __attribute__((ext_vector_type(2)));
typedef unsigned u32x4 __attribute__((ext_vector_type(4)));

constexpr int DM = 2048, NBATCH = 4, SEQ = 2048, NTOK = NBATCH * SEQ, NMEM = 256;
constexpr int HGH = 8, HGD = 128, CHUNK = 64, NCHUNK = SEQ / CHUNK;
constexpr int MLAH = 8, QRANK = 512, KVRANK = 512, NOPE = 128, ROPE = 64, QKD = NOPE + ROPE, MLAV = 128;
constexpr int MEMH = 4, MEMD = 256;
constexpr int DIN = 12352, DINP = 12544;
constexpr int FF = 5632, NEXP = 8, FFE = 7168;
constexpr float EPS = 1e-6f;
constexpr int PC_Q = 0, PC_F = 1024, PC_I = 2048, PC_G = 3072, PC_CQ = 4096, PC_CKV = 4608, PC_KR = 5120, PC_QM = 5376, PC_GATE = 6400;
constexpr int MAXRT = 72;

constexpr size_t MiB = 1u << 20;
constexpr size_t WS_CTL = 0, CTL_BYTES = 1 * MiB;
constexpr int CW_BAR = 4096;
constexpr size_t CB_SSQ = 65536;
constexpr int SSQ_F0 = 0, SSQ_A1 = 1, SSQ_F1 = 2, SSQ_CQ0 = 3, SSQ_CKV0 = 4, SSQ_CQ1 = 5, SSQ_CKV1 = 6;
constexpr size_t CB_BLKCNT = 65536 + 7 * 65536;
constexpr size_t W0 = 1 * MiB;
constexpr size_t WS_WIN = W0;
constexpr size_t WS_WMKV = WS_WIN + 2ull * DINP * 2048 * 2;
constexpr size_t WS_WQUP = WS_WMKV + 2ull * 2048 * 2048 * 2;
constexpr size_t WS_WKVUP = WS_WQUP + 2ull * 1536 * 512 * 2;
constexpr size_t WS_WBR = WS_WKVUP + 2ull * 2048 * 512 * 2;
constexpr size_t WS_WO = WS_WBR + 6ull * 2048 * 1024 * 2;
constexpr size_t WS_WGU = WS_WO + 2ull * 2048 * 2048 * 2;
constexpr size_t WS_WDN = WS_WGU + 11264ull * 2048 * 2;
constexpr size_t WS_WEGU = WS_WDN + 2048ull * 5632 * 2;
constexpr size_t WS_WEDN = WS_WEGU + 8ull * 14336 * 2048 * 2;
constexpr size_t WS_WEND = WS_WEDN + 8ull * 2048 * 7168 * 2;
constexpr size_t A0 = (WS_WEND + MiB - 1) / MiB * MiB;
constexpr size_t WS_H = A0;
constexpr size_t WS_HB = WS_H + (size_t)NTOK * DM * 4;
constexpr size_t WS_PROJ = WS_HB + (size_t)NTOK * DM * 2;
constexpr size_t WS_ZF = WS_PROJ + (size_t)NTOK * DINP * 2;
constexpr size_t WS_MEMN = WS_ZF + (size_t)NTOK * 1024 * 4;
constexpr size_t WS_MKV = WS_MEMN + 1024ull * 2048 * 2;
constexpr size_t WS_QMLA = WS_MKV + 1024ull * 2048 * 2;
constexpr size_t WS_KVB = WS_QMLA + (size_t)NTOK * 1536 * 2;
constexpr size_t WS_Y = WS_KVB + (size_t)NTOK * 2048 * 2;
constexpr size_t WS_HU = WS_Y + (size_t)NTOK * 3072 * 2;
constexpr size_t WS_HDEC = WS_HU + 1024ull * 128 * 128 * 4;
constexpr size_t WS_MRG = WS_HDEC + 1024ull * 128 * 4;
constexpr size_t WS_MRGB = WS_MRG + (size_t)NTOK * DM * 4;
constexpr size_t WS_ACT = WS_MRGB + (size_t)NTOK * DM * 2;
constexpr size_t WS_XS = WS_ACT + (size_t)NTOK * FF * 2;
constexpr size_t WS_ACTE = WS_XS + (size_t)MAXRT * 256 * DM * 2;
constexpr size_t WS_YS = WS_ACTE + (size_t)MAXRT * 256 * FFE * 2;
constexpr size_t WS_COS = WS_YS + 2ull * NTOK * DM * 4;
constexpr size_t WS_SIN = WS_COS + (size_t)NTOK * 32 * 4;
constexpr size_t WS_LB = WS_SIN + (size_t)NTOK * 32 * 4;
constexpr size_t WS_SSQA0 = WS_LB + 2 * 1024 * 4;
constexpr size_t WS_TOPI = WS_SSQA0 + (size_t)NTOK * 8;
constexpr size_t WS_TOPW = WS_TOPI + (size_t)NTOK * 8;
constexpr size_t WS_RASS = WS_TOPW + (size_t)NTOK * 8;
constexpr size_t WS_TEXP = WS_RASS + (size_t)MAXRT * 256 * 8;
constexpr size_t WS_POS = WS_TEXP + 512;
constexpr size_t WS_YSQ = WS_POS + 2ull * NTOK * 4;
constexpr size_t WS_HS = WS_YSQ + 4ull * 2048 * DM * 2;
constexpr size_t WS_HB8 = WS_HS + 1024ull * 128 * 128 * 2;
constexpr size_t WS_WIN8 = WS_HB8 + (size_t)NTOK * DM;
constexpr size_t WS_END = WS_WIN8 + 2ull * 6144 * DM;

constexpr int RING_BYTES = 131072;
constexpr int MISC_OFF = RING_BYTES;
constexpr int LDS_BYTES = 163840;
constexpr int NWAVES = 8, NTHR = 512;

#define RLX_AGENT __ATOMIC_RELAXED, __HIP_MEMORY_SCOPE_AGENT
#define LDS_WAIT() asm volatile("s_waitcnt lgkmcnt(0)" ::: "memory")
#define VM_WAIT() asm volatile("s_waitcnt vmcnt(0)" ::: "memory")
#define SBAR() __builtin_amdgcn_sched_barrier(0)
__device__ __forceinline__ unsigned cvt_pk_bf16(float lo, float hi) { unsigned r; asm volatile("s_nop 0\n\tv_cvt_pk_bf16_f32 %0, %1, %2" : "=v"(r) : "v"(lo), "v"(hi)); return r; }
__device__ __forceinline__ bf16 f2bf(float f) { return (bf16)(cvt_pk_bf16(f, 0.f) & 0xffffu); }
__device__ __forceinline__ float bf2f(bf16 b) { return __uint_as_float(((unsigned)b) << 16); }
__device__ __forceinline__ float bflo(unsigned w) { return __uint_as_float(w << 16); }
__device__ __forceinline__ float bfhi(unsigned w) { return __uint_as_float(w & 0xffff0000u); }
__device__ __forceinline__ f32x4 ld4h(const bf16* p) { const u32x2 w = *(const u32x2*)p; return (f32x4){bflo(w.x), bfhi(w.x), bflo(w.y), bfhi(w.y)}; }
__device__ __forceinline__ float fast_sigmoid(float x) { return __builtin_amdgcn_rcpf(1.0f + __builtin_amdgcn_exp2f(x * -1.4426950408889634f)); }
__device__ __forceinline__ float ieee_sigmoid(float x) { return 1.0f / (1.0f + __expf(-x)); }
__device__ __forceinline__ int lane_id() { int r; asm volatile("v_mbcnt_lo_u32_b32 %0, -1, 0\n\tv_mbcnt_hi_u32_b32 %0, -1, %0" : "=v"(r)); return r; }
__device__ __forceinline__ float shflx(float v, int mask, int lane) { return __int_as_float(__builtin_amdgcn_ds_bpermute((lane ^ mask) << 2, __float_as_int(v))); }
__device__ __forceinline__ float wave_sum(float v, int lane) {
#pragma unroll
    for (int o = 1; o < 64; o <<= 1) v += shflx(v, o, lane);
    return v;
}
constexpr float F8_XS = 32.0f, F8_WGU = 1024.0f, F8_ACT = 8.0f, F8_WDN = 2048.0f, F8_H = 32.0f, F8_WIN = 1024.0f;
typedef int i32x8 __attribute__((ext_vector_type(8)));
__device__ __forceinline__ float clamp448(float v) { return fminf(fmaxf(v, -448.0f), 448.0f); }
__device__ __forceinline__ u32x2 pack8_f8(const f32x4& a, const f32x4& b) {
    int w0 = 0, w1 = 0;
    w0 = __builtin_amdgcn_cvt_pk_fp8_f32(clamp448(a[0]), clamp448(a[1]), w0, false); w0 = __builtin_amdgcn_cvt_pk_fp8_f32(clamp448(a[2]), clamp448(a[3]), w0, true);
    w1 = __builtin_amdgcn_cvt_pk_fp8_f32(clamp448(b[0]), clamp448(b[1]), w1, false); w1 = __builtin_amdgcn_cvt_pk_fp8_f32(clamp448(b[2]), clamp448(b[3]), w1, true);
    u32x2 r; r.x = (unsigned)w0; r.y = (unsigned)w1; return r;
}
__device__ __forceinline__ u32x4 pack8(const f32x4& a, const f32x4& b) {
    u32x4 w; w.x = cvt_pk_bf16(a[0], a[1]); w.y = cvt_pk_bf16(a[2], a[3]); w.z = cvt_pk_bf16(b[0], b[1]); w.w = cvt_pk_bf16(b[2], b[3]); return w;
}

#define XB_TMO      128
#define XB_XCNT(j)  (256  + 64 * (j))
#define XB_XSUB(j)  (1280 + 64 * (j))
#define XB_XGEN(j)  (2304 + 64 * (j))
#define XB_TOP      3328
#define XB_TOPGEN   3392
#define XCD_BAR_WORDS 3456
#define XB_SPIN_CAP (1u << 18)
__device__ __forceinline__ unsigned xb_ld(unsigned* p)              { return __hip_atomic_load(p, __ATOMIC_RELAXED, __HIP_MEMORY_SCOPE_AGENT); }
__device__ __forceinline__ unsigned xb_add(unsigned* p, unsigned v) { return __hip_atomic_fetch_add(p, v, __ATOMIC_RELAXED, __HIP_MEMORY_SCOPE_AGENT); }
__device__ __forceinline__ unsigned xb_xcc_id() { return (unsigned)__builtin_amdgcn_s_getreg((3 << 11) | 20) & 0xFu; }
#define XB_SPIN(cond, bar) do { unsigned _sp = 0; while (cond) { __builtin_amdgcn_s_sleep(1); \
    if ((++_sp & 255u) == 0u) { if (xb_ld(&(bar)[XB_TMO])) break; if (_sp > XB_SPIN_CAP) { atomicAdd(&(bar)[XB_TMO], 1u); break; } } } } while (0)
struct XcdBarrier { unsigned* bar; unsigned x; volatile LAS unsigned* st; unsigned nloc, nx; };
__device__ __forceinline__ XcdBarrier xcd_barrier_post(unsigned* bar, volatile LAS unsigned* st, int tid) {
    XcdBarrier b; b.bar = bar; b.x = xb_xcc_id(); b.st = st; b.nloc = 0u; b.nx = 0u;
    if (tid == 0) (void)xb_add(&bar[XB_XCNT(b.x)], 1u);
    return b;
}
__device__ __forceinline__ void xcd_barrier_complete(unsigned* bar, unsigned x, unsigned& nloc, unsigned& nx) {
    const unsigned G = gridDim.x * gridDim.y * gridDim.z;
    unsigned sum, cnt, mine, sp = 0u;
    for (;;) {
        sum = 0u; cnt = 0u; mine = 0u;
#pragma unroll
        for (unsigned j = 0; j < 16; ++j) { const unsigned c = xb_ld(&bar[XB_XCNT(j)]); sum += c; cnt += (c > 0u) ? 1u : 0u; mine = (j == x) ? c : mine; }
        if (sum == G) break;
        __builtin_amdgcn_s_sleep(1);
        if ((++sp & 255u) == 0u) { if (xb_ld(&bar[XB_TMO])) break; if (sp > XB_SPIN_CAP) { atomicAdd(&bar[XB_TMO], 1u); break; } }
    }
    nloc = mine > 0u ? mine : 1u; nx = cnt > 0u ? cnt : 1u;
}
__device__ __forceinline__ void xcd_barrier(XcdBarrier& b, int tid) {
    asm volatile("s_waitcnt vmcnt(0)" ::: "memory");
    __syncthreads();
    unsigned nloc_new = b.nloc, nx_new = b.nx;
    if (tid == 0) {
        unsigned* bar = b.bar; unsigned bxx = b.x; asm volatile("" : "+s"(bar), "+s"(bxx));
        __builtin_amdgcn_s_waitcnt(0);
        unsigned nloc = b.nloc, nx = b.nx;
        if (nloc == 0u) { xcd_barrier_complete(bar, bxx, nloc, nx); nloc_new = nloc; nx_new = nx; }
        const unsigned old = xb_add(&bar[XB_XSUB(bxx)], 1u);
        const unsigned gen = old / nloc;
        if (old + 1u == (gen + 1u) * nloc) {
            __builtin_amdgcn_fence(__ATOMIC_RELEASE, "agent");
            asm volatile("s_waitcnt vmcnt(0)" ::: "memory");
            const unsigned og = xb_add(&bar[XB_TOP], 1u);
            const unsigned tg = og / nx;
            if (og + 1u != (tg + 1u) * nx) XB_SPIN(xb_ld(&bar[XB_TOP]) < (tg + 1u) * nx, bar);
            __builtin_amdgcn_fence(__ATOMIC_ACQUIRE, "agent");
            xb_add(&bar[XB_XGEN(bxx)], 1u);
            asm volatile("s_waitcnt vmcnt(0)" ::: "memory");
        } else {
            XB_SPIN(xb_ld(&bar[XB_XGEN(bxx)]) == gen, bar);
            __builtin_amdgcn_fence(__ATOMIC_ACQUIRE, "agent");
            asm volatile("s_waitcnt vmcnt(0)" ::: "memory");
        }
    }
    b.nloc = __builtin_amdgcn_readfirstlane(nloc_new); b.nx = __builtin_amdgcn_readfirstlane(nx_new);
    __syncthreads();
}

typedef unsigned long long u64;
namespace pg8 {
typedef int i32x4v __attribute__((ext_vector_type(4)));
constexpr int BM = 256, BK = 64, HALF = 128, HTB = HALF * BK * 2, STAGE_BYTES = 8 * HTB, NXCD = 8, WGM = 8;
__device__ __forceinline__ int lds_byte(int r, int c) { const int st = (r >> 4) * 2 + (c >> 5), rr = r & 15, cc = c & 31, ob = rr * 64 + cc * 2; return st * 1024 + (ob ^ (((ob >> 9) & 1) << 5)); }
__device__ __forceinline__ void stage_rc(int b, int& R, int& C) { const int st = b / 1024, sb = b % 1024, swz = sb ^ (((sb >> 9) & 1) << 5); R = (st >> 1) * 16 + swz / 64; C = (st & 1) * 32 + (swz % 64) / 2; }
__device__ __forceinline__ int perm32(int rho) { const int n = rho >> 4, i = rho & 15; return 8 * (i >> 2) + 4 * n + (i & 3); }

struct Unit { unsigned A, B; int pm, pn, kind, aux; };

__device__ __forceinline__ int xcd_remap(int L, int nwg) { const int q = nwg / NXCD, r = nwg % NXCD, xcd = L % NXCD, off = L / NXCD; return (xcd < r ? xcd * (q + 1) : r * (q + 1) + (xcd - r) * q) + off; }
__device__ __forceinline__ void tile_decode(int wgid, int nM, int nN, int& pm, int& pn) {
    const int nig = WGM * nN, gid = wgid / nig, fm = gid * WGM, gsz = (nM - fm) < WGM ? (nM - fm) : WGM;
    pm = fm + ((wgid % nig) % gsz); pn = (wgid % nig) / gsz;
}

template <class Epi, class Sched, bool ALIGN_EPI = true, bool F8 = false, int PM = 0>
__device__ __forceinline__ void gemm_run(LAS unsigned char* lds, const int tid, const unsigned char* wsbase, const int K, const int lda, const int ldb, const Sched& S, const Epi& E) {
    const int wid = __builtin_amdgcn_readfirstlane(tid >> 6), lane = tid & 63, wr = wid >> 2, wc = wid & 3, fr = lane & 15, fq = lane >> 4;
    const int nt = K / BK;
    const unsigned long long wsb = (unsigned long long)wsbase; const unsigned wlo = __builtin_amdgcn_readfirstlane((unsigned)wsb), whi = __builtin_amdgcn_readfirstlane((unsigned)(wsb >> 32));
    const __amdgpu_buffer_rsrc_t rsrc = __builtin_amdgcn_make_buffer_rsrc((void*)(((unsigned long long)whi << 32) | wlo), 0, 0xFFFFF000u, 0x00020000);
    unsigned voffA, voffB;
    { int R, C; stage_rc(tid * 16, R, C); const int Rb = (R & ~31) + perm32(R & 31); voffA = (unsigned)(R * lda + C) * 2u; voffB = (unsigned)(Rb * ldb + C) * 2u; }
    const unsigned pieceA = 64u * lda * 2u, pieceB = 64u * ldb * 2u;
    const unsigned kstep = BK * 2;
    const unsigned hstepA = (unsigned)HALF * lda * 2u, hstepB = (unsigned)HALF * ldb * 2u;
    const unsigned ldsw = (unsigned)wid * 1024u;
    const int aoff = lds_byte(wr * 64 + fr, fq * 8), boff = lds_byte(wc * 32 + fr, fq * 8);
#define PG8_SA(b, h) (((b) * 2 + (h)) * HTB)
#define PG8_SB(b, h) ((4 + (b) * 2 + (h)) * HTB)
#define PG8_STAGE(bufoff, goff, voff) do { if constexpr (PM == 2) break; \
        __builtin_amdgcn_raw_ptr_buffer_load_lds(rsrc, (LAS void*)(lds + (bufoff) + ldsw), 16, (int)(voff), (int)(goff), 0, 0); \
        __builtin_amdgcn_raw_ptr_buffer_load_lds(rsrc, (LAS void*)(lds + (bufoff) + ldsw + 8192), 16, (int)(voff), (int)((goff) + piece##voff), 0, 0); } while (0)
#define piecevoffA pieceA
#define piecevoffB pieceB
#define PG8_LDA(dst, b, h) do { if constexpr (PM == 1) break; _Pragma("unroll") for (int m = 0; m < 4; ++m) _Pragma("unroll") for (int k = 0; k < 2; ++k) dst[m][k] = *(const LAS bf16x8*)(lds + PG8_SA(b, h) + aoff + m * 2048 + k * 1024); } while (0)
#define PG8_LDB(dst, b, h) do { if constexpr (PM == 1) break; _Pragma("unroll") for (int n = 0; n < 2; ++n) _Pragma("unroll") for (int k = 0; k < 2; ++k) dst[n][k] = *(const LAS bf16x8*)(lds + PG8_SB(b, h) + boff + n * 2048 + k * 1024); } while (0)
#define PG8_CAT(lo, hi) __builtin_shufflevector(__builtin_bit_cast(i32x4v, lo), __builtin_bit_cast(i32x4v, hi), 0, 1, 2, 3, 4, 5, 6, 7)
#define PG8_MMA(ai, bj, At, Bt) do { if constexpr (PM == 3) break; __builtin_amdgcn_s_setprio(1); if constexpr (F8) { _Pragma("unroll") for (int m = 0; m < 4; ++m) _Pragma("unroll") for (int n = 0; n < 2; ++n) \
        acc[ai][bj][m][n] = __builtin_amdgcn_mfma_scale_f32_16x16x128_f8f6f4(PG8_CAT(Bt[n][0], Bt[n][1]), PG8_CAT(At[m][0], At[m][1]), acc[ai][bj][m][n], 0, 0, 0, 0x7F7F7F7F, 0, 0x7F7F7F7F); } \
      else { _Pragma("unroll") for (int m = 0; m < 4; ++m) _Pragma("unroll") for (int n = 0; n < 2; ++n) _Pragma("unroll") for (int k = 0; k < 2; ++k) \
        acc[ai][bj][m][n] = __builtin_amdgcn_mfma_f32_16x16x32_bf16(Bt[n][k], At[m][k], acc[ai][bj][m][n], 0, 0, 0); } __builtin_amdgcn_s_setprio(0); } while (0)
#define PG8_WAIT_V(n) asm volatile("s_waitcnt vmcnt(" #n ")" ::: "memory")
#define PG8_WAIT_L(n) asm volatile("s_waitcnt lgkmcnt(" #n ")" ::: "memory")
#define PG8_BAR __builtin_amdgcn_s_barrier()
#define PG8_SCHED __builtin_amdgcn_sched_barrier(0)
    Unit cur, nxt; int ui = 0;
    if (!S.next(0, cur)) return;
    LAS unsigned char* pfslot = lds + STAGE_BYTES + ldsw * 2u;
#define PG8_PF(unit) do { if constexpr (Epi::PF) { const int po = __builtin_amdgcn_readfirstlane((int)E.pf_off(unit)); \
        __builtin_amdgcn_raw_ptr_buffer_load_lds(rsrc, (LAS void*)pfslot, 16, lane * 16, po, 0, 0); \
        __builtin_amdgcn_raw_ptr_buffer_load_lds(rsrc, (LAS void*)(pfslot + 1024), 16, lane * 16, po + 1024, 0, 0); } } while (0)
    PG8_PF(cur);
    f32x4 acc[2][2][4][2];
#pragma unroll
    for (int a = 0; a < 2; ++a)
#pragma unroll
        for (int b = 0; b < 2; ++b)
#pragma unroll
            for (int m = 0; m < 4; ++m)
#pragma unroll
                for (int n = 0; n < 2; ++n) acc[a][b][m][n] = (f32x4){0.f, 0.f, 0.f, 0.f};
    bf16x8 At[4][2], B0[2][2], B1[2][2];
    if constexpr (PM == 1) {
#pragma unroll
        for (int m = 0; m < 4; ++m) { asm volatile("" : "=v"(At[m][0])); asm volatile("" : "=v"(At[m][1])); }
#pragma unroll
        for (int m = 0; m < 2; ++m) { asm volatile("" : "=v"(B0[m][0])); asm volatile("" : "=v"(B0[m][1])); asm volatile("" : "=v"(B1[m][0])); asm volatile("" : "=v"(B1[m][1])); }
    }
    unsigned cA = cur.A, cB = cur.B;
    PG8_STAGE(PG8_SB(0, 0), cB, voffB); PG8_STAGE(PG8_SB(0, 1), cB + hstepB, voffB); PG8_STAGE(PG8_SA(0, 0), cA, voffA); PG8_STAGE(PG8_SA(0, 1), cA + hstepA, voffA);
    if (wr == 1) PG8_BAR;
    PG8_WAIT_V(2); PG8_BAR;
    PG8_STAGE(PG8_SB(1, 0), cB + kstep, voffB); PG8_STAGE(PG8_SA(1, 0), cA + kstep, voffA); PG8_STAGE(PG8_SB(1, 1), cB + hstepB + kstep, voffB);
    PG8_WAIT_V(6); PG8_BAR;
    for (;;) {
        const bool has_next = S.next(ui + 1, nxt);
        const unsigned nA = has_next ? nxt.A : cA, nB = has_next ? nxt.B : cB;
        for (int t = 0; t < nt; t += 2) {
            const bool last = (t == nt - 2);
            const unsigned a1 = cA + (unsigned)(t + 1) * kstep;
            const unsigned a2 = last ? nA : cA + (unsigned)(t + 2) * kstep, b2 = last ? nB : cB + (unsigned)(t + 2) * kstep;
            const unsigned a3 = a2 + kstep, b3 = b2 + kstep;
            PG8_LDB(B0, 0, 0); PG8_LDB(B1, 0, 1); PG8_SCHED; PG8_LDA(At, 0, 0); PG8_STAGE(PG8_SA(1, 1), a1 + hstepA, voffA);
            PG8_WAIT_V(8); PG8_WAIT_L(0); PG8_BAR; PG8_MMA(0, 0, At, B0); PG8_MMA(0, 1, At, B1); PG8_BAR; PG8_SCHED;
            PG8_LDA(At, 0, 1); PG8_STAGE(PG8_SB(0, 0), b2, voffB); PG8_STAGE(PG8_SB(0, 1), b2 + hstepB, voffB); PG8_STAGE(PG8_SA(0, 0), a2, voffA);
            PG8_WAIT_V(8); PG8_WAIT_L(0); PG8_BAR; PG8_MMA(1, 0, At, B0); PG8_MMA(1, 1, At, B1); PG8_BAR; PG8_SCHED;
            PG8_LDB(B0, 1, 0); PG8_LDB(B1, 1, 1); PG8_SCHED; PG8_LDA(At, 1, 0); PG8_STAGE(PG8_SA(0, 1), a2 + hstepA, voffA);
            PG8_WAIT_V(8); PG8_WAIT_L(0); PG8_BAR; PG8_MMA(0, 0, At, B0); PG8_MMA(0, 1, At, B1); PG8_BAR; PG8_SCHED;
            PG8_LDA(At, 1, 1); PG8_STAGE(PG8_SB(1, 0), b3, voffB); PG8_STAGE(PG8_SB(1, 1), b3 + hstepB, voffB); PG8_STAGE(PG8_SA(1, 0), a3, voffA);
            PG8_WAIT_V(8); PG8_WAIT_L(0); PG8_BAR; PG8_MMA(1, 0, At, B0); PG8_MMA(1, 1, At, B1); PG8_BAR; PG8_SCHED;
        }
        if constexpr (ALIGN_EPI) { if (wr == 0) PG8_BAR; }
        bool zero_acc = true;
        { Unit eu = cur; asm volatile("" : "+s"(eu.pm), "+s"(eu.pn));
          const int lane_o = lane_id(); if constexpr (Epi::INPLACE) zero_acc = E(acc, eu, wr, wc, lane_o & 15, lane_o >> 4, (const LAS u64*)pfslot); else E(acc, eu, wr, wc, lane_o & 15, lane_o >> 4, (const LAS u64*)pfslot); }
        if (!has_next) break;
        PG8_SCHED; PG8_PF(nxt); PG8_SCHED;
        if (zero_acc) {
#pragma unroll
        for (int a = 0; a < 2; ++a)
#pragma unroll
            for (int b = 0; b < 2; ++b)
#pragma unroll
                for (int m = 0; m < 4; ++m)
#pragma unroll
                    for (int n = 0; n < 2; ++n) acc[a][b][m][n] = (f32x4){0.f, 0.f, 0.f, 0.f};
        }
        cur = nxt; cA = nA; cB = nB; ++ui;
        if constexpr (ALIGN_EPI) { if (wr == 1) PG8_BAR; }
    }
    PG8_WAIT_V(0);
    if constexpr (!ALIGN_EPI) { if (wr == 0) PG8_BAR; }
    PG8_BAR;
#undef PG8_PF
#undef PG8_SA
#undef PG8_SB
#undef PG8_STAGE
#undef piecevoffA
#undef piecevoffB
#undef PG8_LDA
#undef PG8_LDB
#undef PG8_MMA
#undef PG8_CAT
#undef PG8_WAIT_V
#undef PG8_WAIT_L
#undef PG8_BAR
#undef PG8_SCHED
}
}
using pg8::Unit;

typedef f32x4 Acc[2][2][4][2];
#define EPI_ROWS(u, wr, fr) const int row0 = (u).pm * 256 + (wr) * 64 + (fr)

__device__ __forceinline__ float ssq_val(const u64* ssq, int row) { return (float)ssq[row] * 2.3283064365386963e-10f; }
__device__ __forceinline__ u64 ssq_fix(float s) { return (u64)(s * 4294967296.0f); }
__device__ __forceinline__ float row_rstd_lds(const LAS u64* pf, int lrow, float invn) { return rsqrtf((float)pf[lrow] * 2.3283064365386963e-10f * invn + EPS); }
__device__ __forceinline__ float row_rstd(const u64* ssq, int row, float invn) { return rsqrtf(ssq_val(ssq, row) * invn + EPS); }
__device__ __forceinline__ void ssq_atomic(u64* ssq, int row, float s, int fr, int fq) {
    const int lane = fr + 16 * fq; s += shflx(s, 16, lane); s += shflx(s, 32, lane);
    if (fq == 0) atomicAdd(ssq + row, ssq_fix(s));
}

struct EpiIn {
    static constexpr bool INPLACE = false, PF = true;
    unsigned char* ws; int l; bool do_ssq;
    __device__ __forceinline__ unsigned pf_off(const Unit& u) const { return (unsigned)(l == 0 ? WS_SSQA0 : CB_SSQ + (size_t)SSQ_A1 * NTOK * 8) + (u.kind == 1 ? 0u : (unsigned)u.pm * 2048u); }
    __device__ __forceinline__ void operator()(const Acc& acc, const Unit& u, int wr, int wc, int fr, int fq, const LAS u64* pf) const {
        EPI_ROWS(u, wr, fr);
        bf16* proj = (bf16*)(ws + WS_PROJ); float* zf = (float*)(ws + WS_ZF); bf16* mkv = (bf16*)(ws + WS_MKV);
        const u64* ssq_h = l == 0 ? (const u64*)(ws + WS_SSQA0) : (const u64*)(ws + CB_SSQ) + SSQ_A1 * NTOK;
        u64* ssq_cq = (u64*)(ws + CB_SSQ) + (l == 0 ? SSQ_CQ0 : SSQ_CQ1) * NTOK; u64* ssq_ckv = (u64*)(ws + CB_SSQ) + (l == 0 ? SSQ_CKV0 : SSQ_CKV1) * NTOK;
        const float* cosT = (const float*)(ws + WS_COS); const float* sinT = (const float*)(ws + WS_SIN);
        if (u.kind == 1) {
#pragma unroll
            for (int ai = 0; ai < 2; ++ai)
#pragma unroll
                for (int m = 0; m < 4; ++m) { const int row = row0 + ai * 128 + m * 16;
#pragma unroll
                    for (int bj = 0; bj < 2; ++bj) { const int col = u.pn * 256 + bj * 128 + wc * 32 + 8 * fq;
                        *(u32x4*)(mkv + (size_t)row * 2048 + col) = pack8(acc[ai][bj][m][0], acc[ai][bj][m][1]); } }
            return;
        }
        const int pn = u.pn;
        float rsv[2][4];
#pragma unroll
        for (int ai = 0; ai < 2; ++ai)
#pragma unroll
            for (int m = 0; m < 4; ++m) rsv[ai][m] = row_rstd_lds(pf, ai * 128 + wr * 64 + m * 16 + fr, 1.0f / DM);
#pragma unroll
        for (int ai = 0; ai < 2; ++ai)
#pragma unroll
            for (int m = 0; m < 4; ++m) {
                const int row = row0 + ai * 128 + m * 16;
                const float rs = rsv[ai][m];
                float sq = 0.f;
#pragma unroll
                for (int bj = 0; bj < 2; ++bj) {
                    const int col = pn * 256 + bj * 128 + wc * 32 + 8 * fq;
                    f32x4 v0 = acc[ai][bj][m][0] * rs, v1 = acc[ai][bj][m][1] * rs;
                    if (pn >= 4 && pn < 8) {
                        float* zp = zf + (size_t)row * 1024 + (col - PC_F);
                        *(f32x4*)zp = v0; *(f32x4*)(zp + 4) = v1;
                    } else {
                        if (pn >= 16 && pn < 20) sq += (v0[0] * v0[0] + v0[1] * v0[1]) + (v0[2] * v0[2] + v0[3] * v0[3]) + (v1[0] * v1[0] + v1[1] * v1[1]) + (v1[2] * v1[2] + v1[3] * v1[3]);
                        if (pn == 20 && bj == 0 && wc < 2) {
                            const int j0 = (wc * 32 + 8 * fq) >> 1;
                            const f32x4 cs = *(const f32x4*)(cosT + (size_t)row * 32 + j0), sn = *(const f32x4*)(sinT + (size_t)row * 32 + j0);
                            f32x4 r0, r1;
                            r0[0] = v0[0] * cs[0] - v0[1] * sn[0]; r0[1] = v0[1] * cs[0] + v0[0] * sn[0];
                            r0[2] = v0[2] * cs[1] - v0[3] * sn[1]; r0[3] = v0[3] * cs[1] + v0[2] * sn[1];
                            r1[0] = v1[0] * cs[2] - v1[1] * sn[2]; r1[1] = v1[1] * cs[2] + v1[0] * sn[2];
                            r1[2] = v1[2] * cs[3] - v1[3] * sn[3]; r1[3] = v1[3] * cs[3] + v1[2] * sn[3];
                            v0 = r0; v1 = r1;
                        }
                        if (pn >= 25) {
#pragma unroll
                            for (int j = 0; j < 4; ++j) { v0[j] = EPI_SIGMOID(v0[j]); v1[j] = EPI_SIGMOID(v1[j]); }
                        }
                        *(u32x4*)(proj + (size_t)row * DINP + col) = pack8(v0, v1);
                    }
                }
                if (do_ssq && pn >= 16 && pn < 18) ssq_atomic(ssq_cq, row, sq, fr, fq);
                if (do_ssq && pn >= 18 && pn < 20) ssq_atomic(ssq_ckv, row, sq, fr, fq);
            }
    }
};

struct EpiGateLogit {
    static constexpr bool INPLACE = false, PF = true;
    unsigned char* ws; int l;
    __device__ __forceinline__ unsigned pf_off(const Unit& u) const { return (unsigned)(l == 0 ? WS_SSQA0 : CB_SSQ + (size_t)SSQ_A1 * NTOK * 8) + (unsigned)u.pm * 2048u; }
    __device__ __forceinline__ void operator()(const Acc& acc, const Unit& u, int wr, int wc, int fr, int fq, const LAS u64* pf) const {
        EPI_ROWS(u, wr, fr);
        bf16* proj = (bf16*)(ws + WS_PROJ);
        const u64* ssq_h = l == 0 ? (const u64*)(ws + WS_SSQA0) : (const u64*)(ws + CB_SSQ) + SSQ_A1 * NTOK;
        float rsv[2][4];
#pragma unroll
        for (int ai = 0; ai < 2; ++ai)
#pragma unroll
            for (int m = 0; m < 4; ++m) rsv[ai][m] = row_rstd_lds(pf, ai * 128 + wr * 64 + m * 16 + fr, 1.0f / DM) * (1.0f / (F8_H * F8_WIN));
#pragma unroll
        for (int ai = 0; ai < 2; ++ai)
#pragma unroll
            for (int m = 0; m < 4; ++m) {
                const int row = row0 + ai * 128 + m * 16;
                const float rsl = rsv[ai][m] * -1.4426950408889634f;
#pragma unroll
                for (int bj = 0; bj < 2; ++bj) {
                    const int col = u.pn * 256 + bj * 128 + wc * 32 + 8 * fq;
                    f32x4 v0, v1;
#pragma unroll
                    for (int j = 0; j < 4; ++j) { v0[j] = __builtin_amdgcn_rcpf(1.0f + __builtin_amdgcn_exp2f(acc[ai][bj][m][0][j] * rsl)); v1[j] = __builtin_amdgcn_rcpf(1.0f + __builtin_amdgcn_exp2f(acc[ai][bj][m][1][j] * rsl)); }
                    *(u32x4*)(proj + (size_t)row * DINP + PC_GATE + col) = pack8(v0, v1);
                }
            }
    }
};

struct EpiUp {
    static constexpr bool INPLACE = false, PF = true;
    unsigned char* ws; int l;
    __device__ __forceinline__ unsigned pf_off(const Unit& u) const { return (unsigned)(CB_SSQ + (size_t)(u.kind == 0 ? (l == 0 ? SSQ_CQ0 : SSQ_CQ1) : (l == 0 ? SSQ_CKV0 : SSQ_CKV1)) * NTOK * 8) + (unsigned)u.pm * 2048u; }
    __device__ __forceinline__ void operator()(const Acc& acc, const Unit& u, int wr, int wc, int fr, int fq, const LAS u64* pf) const {
        EPI_ROWS(u, wr, fr);
        bf16* qmla = (bf16*)(ws + WS_QMLA); bf16* kvb = (bf16*)(ws + WS_KVB);
        const u64* ssq_cq = (const u64*)(ws + CB_SSQ) + (l == 0 ? SSQ_CQ0 : SSQ_CQ1) * NTOK; const u64* ssq_ckv = (const u64*)(ws + CB_SSQ) + (l == 0 ? SSQ_CKV0 : SSQ_CKV1) * NTOK;
        const float* cosT = (const float*)(ws + WS_COS); const float* sinT = (const float*)(ws + WS_SIN);
        const bool isq = (u.kind == 0);
        float rsv[2][4];
#pragma unroll
        for (int ai = 0; ai < 2; ++ai)
#pragma unroll
            for (int m = 0; m < 4; ++m) rsv[ai][m] = row_rstd_lds(pf, ai * 128 + wr * 64 + m * 16 + fr, 1.0f / 512.0f);
#pragma unroll
        for (int ai = 0; ai < 2; ++ai)
#pragma unroll
            for (int m = 0; m < 4; ++m) {
                const int row = row0 + ai * 128 + m * 16;
                const float rs = rsv[ai][m];
#pragma unroll
                for (int bj = 0; bj < 2; ++bj) {
                    const int col = u.pn * 256 + bj * 128 + wc * 32 + 8 * fq;
                    f32x4 v0 = acc[ai][bj][m][0] * rs, v1 = acc[ai][bj][m][1] * rs;
                    if (isq) {
                        const int c192 = col % QKD;
                        if (c192 >= NOPE) {
                            const int j0 = (c192 - NOPE) >> 1;
                            const f32x4 cs = *(const f32x4*)(cosT + (size_t)row * 32 + j0), sn = *(const f32x4*)(sinT + (size_t)row * 32 + j0);
                            f32x4 r0, r1;
                            r0[0] = v0[0] * cs[0] - v0[1] * sn[0]; r0[1] = v0[1] * cs[0] + v0[0] * sn[0];
                            r0[2] = v0[2] * cs[1] - v0[3] * sn[1]; r0[3] = v0[3] * cs[1] + v0[2] * sn[1];
                            r1[0] = v1[0] * cs[2] - v1[1] * sn[2]; r1[1] = v1[1] * cs[2] + v1[0] * sn[2];
                            r1[2] = v1[2] * cs[3] - v1[3] * sn[3]; r1[3] = v1[3] * cs[3] + v1[2] * sn[3];
                            v0 = r0; v1 = r1;
                        }
                        *(u32x4*)(qmla + (size_t)row * 1536 + col) = pack8(v0, v1);
                    } else {
                        *(u32x4*)(kvb + (size_t)row * 2048 + col) = pack8(v0, v1);
                    }
                }
            }
    }
};

struct EpiGate {
    static constexpr bool INPLACE = true, PF = false;
    unsigned char* ws;
    __device__ __forceinline__ bool operator()(Acc& acc, const Unit& u, int wr, int wc, int fr, int fq, const LAS u64* pf) const {
        EPI_ROWS(u, wr, fr);
        const bf16* proj = (const bf16*)(ws + WS_PROJ); bf16* mrgb = (bf16*)(ws + WS_MRGB);
        const int n = u.kind;
#pragma unroll
        for (int ai = 0; ai < 2; ++ai) {
            u32x4 ga[4][2], gb[4][2];
#pragma unroll
            for (int m = 0; m < 4; ++m)
#pragma unroll
                for (int bj = 0; bj < 2; ++bj) { const int row = row0 + ai * 128 + m * 16, col = u.pn * 256 + bj * 128 + wc * 32 + 8 * fq;
                    const bf16* gp = proj + (size_t)row * DINP + PC_GATE + col;
                    ga[m][bj] = *(const u32x4*)(gp + n * DM);
                    if (n < 2) gb[m][bj] = *(const u32x4*)(gp + (n + 1) * DM); }
#pragma unroll
            for (int m = 0; m < 4; ++m)
#pragma unroll
                for (int bj = 0; bj < 2; ++bj) { const int row = row0 + ai * 128 + m * 16, col = u.pn * 256 + bj * 128 + wc * 32 + 8 * fq;
                    const unsigned aw[4] = {ga[m][bj].x, ga[m][bj].y, ga[m][bj].z, ga[m][bj].w}, bw[4] = {gb[m][bj].x, gb[m][bj].y, gb[m][bj].z, gb[m][bj].w};
                    float f[8];
#pragma unroll
                    for (int j = 0; j < 4; ++j) { float n0 = bflo(aw[j]), n1 = bfhi(aw[j]);
                        if (n > 0) { n0 = fmaxf(n0, 1e-6f); n1 = fmaxf(n1, 1e-6f); }
                        if (n < 2) { n0 *= __builtin_amdgcn_rcpf(fmaxf(bflo(bw[j]), 1e-6f)); n1 *= __builtin_amdgcn_rcpf(fmaxf(bfhi(bw[j]), 1e-6f)); }
                        f[2 * j] = n0; f[2 * j + 1] = n1; }
                    f32x4& v0 = acc[ai][bj][m][0]; f32x4& v1 = acc[ai][bj][m][1];
                    v0[0] *= f[0]; v0[1] *= f[1]; v0[2] *= f[2]; v0[3] *= f[3]; v1[0] *= f[4]; v1[1] *= f[5]; v1[2] *= f[6]; v1[3] *= f[7];
                    if (n == 2) *(u32x4*)(mrgb + (size_t)row * DM + col) = pack8(v0, v1); }
        }
        return n == 2;
    }
};

struct EpiRes {
    static constexpr bool INPLACE = false, PF = false;
    unsigned char* ws; int ssq_idx; bool f8copy;
    __device__ __forceinline__ void operator()(const Acc& acc, const Unit& u, int wr, int wc, int fr, int fq, const LAS u64* pf) const {
        EPI_ROWS(u, wr, fr);
        bf16* hb = (bf16*)(ws + WS_HB); u64* ssq = (u64*)(ws + CB_SSQ) + ssq_idx * NTOK;
        u32x4 bv[2][4][2];
#pragma unroll
        for (int ai = 0; ai < 2; ++ai)
#pragma unroll
            for (int m = 0; m < 4; ++m)
#pragma unroll
                for (int bj = 0; bj < 2; ++bj) bv[ai][m][bj] = *(const u32x4*)(hb + (size_t)(row0 + ai * 128 + m * 16) * DM + u.pn * 256 + bj * 128 + wc * 32 + 8 * fq);
#pragma unroll
        for (int ai = 0; ai < 2; ++ai)
#pragma unroll
            for (int m = 0; m < 4; ++m) {
                const int row = row0 + ai * 128 + m * 16;
                float sq = 0.f;
#pragma unroll
                for (int bj = 0; bj < 2; ++bj) {
                    const int col = u.pn * 256 + bj * 128 + wc * 32 + 8 * fq;
                    const u32x4 b = bv[ai][m][bj];
                    const f32x4 v0 = acc[ai][bj][m][0] + (f32x4){bflo(b.x), bfhi(b.x), bflo(b.y), bfhi(b.y)}, v1 = acc[ai][bj][m][1] + (f32x4){bflo(b.z), bfhi(b.z), bflo(b.w), bfhi(b.w)};
                    *(u32x4*)(hb + (size_t)row * DM + col) = pack8(v0, v1);
                    if (f8copy) *(u32x2*)(ws + WS_HB8 + (size_t)row * DM + col) = pack8_f8(v0 * F8_H, v1 * F8_H);
                    sq += (v0[0] * v0[0] + v0[1] * v0[1]) + (v0[2] * v0[2] + v0[3] * v0[3]) + (v1[0] * v1[0] + v1[1] * v1[1]) + (v1[2] * v1[2] + v1[3] * v1[3]);
                }
                ssq_atomic(ssq, row, sq, fr, fq);
            }
    }
};

template <bool RSTD> struct EpiSwiglu {
    static constexpr bool INPLACE = false, PF = RSTD;
    unsigned char* ws; unsigned act_off; int ldc; int ssq_idx;
    __device__ __forceinline__ unsigned pf_off(const Unit& u) const { return (unsigned)(CB_SSQ + (size_t)ssq_idx * NTOK * 8) + (unsigned)u.pm * 2048u; }
    __device__ __forceinline__ void operator()(const Acc& acc, const Unit& u, int wr, int wc, int fr, int fq, const LAS u64* pf) const {
        EPI_ROWS(u, wr, fr);
        bf16* act = (bf16*)(ws + act_off); const u64* ssq = (const u64*)(ws + CB_SSQ) + ssq_idx * NTOK;
        float rsv[2][4];
#pragma unroll
        for (int ai = 0; ai < 2; ++ai)
#pragma unroll
            for (int m = 0; m < 4; ++m) rsv[ai][m] = RSTD ? row_rstd_lds(pf, ai * 128 + wr * 64 + m * 16 + fr, 1.0f / DM) : 1.0f;
#pragma unroll
        for (int ai = 0; ai < 2; ++ai)
#pragma unroll
            for (int m = 0; m < 4; ++m) {
                const int row = row0 + ai * 128 + m * 16;
                const float rs = rsv[ai][m], rsl = rs * -1.4426950408889634f, rs2 = rs * rs;
                f32x4 o[2];
#pragma unroll
                for (int n = 0; n < 2; ++n)
#pragma unroll
                    for (int j = 0; j < 4; ++j) { const float ag = acc[ai][0][m][n][j];
                        o[n][j] = ag * __builtin_amdgcn_rcpf(1.0f + __builtin_amdgcn_exp2f(ag * rsl)) * acc[ai][1][m][n][j] * rs2; }
                if (MK_PROBE_MODE == 9 && act_off == 1u) { const u32x4 pk = pack8(o[0], o[1]); asm volatile("" :: "v"(pk)); } else
                *(u32x4*)(act + (size_t)row * ldc + u.pn * 128 + wc * 32 + 8 * fq) = pack8(o[0], o[1]);
            }
    }
};

struct EpiNull {
    static constexpr bool INPLACE = false, PF = false;
    unsigned char* ws;
    __device__ __forceinline__ void operator()(const Acc& acc, const Unit& u, int wr, int wc, int fr, int fq, const LAS u64* pf) const {
#pragma unroll
        for (int ai = 0; ai < 2; ++ai)
#pragma unroll
            for (int bj = 0; bj < 2; ++bj)
#pragma unroll
                for (int m = 0; m < 4; ++m) { asm volatile("" :: "v"(acc[ai][bj][m][0])); asm volatile("" :: "v"(acc[ai][bj][m][1])); }
    }
};

struct EpiSwigluF8 {
    static constexpr bool INPLACE = false, PF = false;
    unsigned char* ws;
    __device__ __forceinline__ void operator()(const Acc& acc, const Unit& u, int wr, int wc, int fr, int fq, const LAS u64* pf) const {
        EPI_ROWS(u, wr, fr);
        unsigned char* act = ws + WS_ACTE; constexpr int ldc = FFE;
        const float inv = 1.0f / (F8_XS * F8_WGU);
#pragma unroll
        for (int ai = 0; ai < 2; ++ai)
#pragma unroll
            for (int m = 0; m < 4; ++m) {
                const int row = row0 + ai * 128 + m * 16;
                f32x4 o[2];
#pragma unroll
                for (int n = 0; n < 2; ++n)
#pragma unroll
                    for (int j = 0; j < 4; ++j) { const float ag = acc[ai][0][m][n][j];
                        o[n][j] = ag * __builtin_amdgcn_rcpf(1.0f + __builtin_amdgcn_exp2f(ag * (inv * -1.4426950408889634f))) * acc[ai][1][m][n][j] * (inv * inv * F8_ACT); }
                *(u32x2*)(act + (size_t)row * ldc + u.pn * 128 + wc * 32 + 8 * fq) = pack8_f8(o[0], o[1]);
            }
    }
};
struct EpiMoeDown {
    static constexpr bool INPLACE = false, PF = true;
    unsigned char* ws; float oscale;
    __device__ __forceinline__ unsigned pf_off(const Unit& u) const { return (unsigned)WS_RASS + (unsigned)u.pm * 2048u; }
    __device__ __forceinline__ void operator()(const Acc& acc, const Unit& u, int wr, int wc, int fr, int fq, const LAS u64* pf) const {
        EPI_ROWS(u, wr, fr);
        bf16* ys = (bf16*)(ws + WS_YS); const int* rass = (const int*)(ws + WS_RASS); const float* topw = (const float*)(ws + WS_TOPW);
        int rav[2][4]; float wv[2][4];
#pragma unroll
        for (int ai = 0; ai < 2; ++ai)
#pragma unroll
            for (int m = 0; m < 4; ++m) { const u64 v = pf[ai * 128 + wr * 64 + m * 16 + fr]; rav[ai][m] = (int)(unsigned)v; wv[ai][m] = __uint_as_float((unsigned)(v >> 32)) * oscale; }
#pragma unroll
        for (int ai = 0; ai < 2; ++ai)
#pragma unroll
            for (int m = 0; m < 4; ++m) {
                const int ra = rav[ai][m];
                if (ra >= 0) {
                    const float w = wv[ai][m];
#pragma unroll
                    for (int bj = 0; bj < 2; ++bj) {
                        const int col = u.pn * 256 + bj * 128 + wc * 32 + 8 * fq;
                        bf16* dst = u.aux ? (bf16*)(ws + WS_YSQ) + ((size_t)(u.aux - 1) * 2048 + (size_t)(row0 + ai * 128 + m * 16 - 64 * 256)) * DM + col : ys + (size_t)ra * DM + col;
                        *(u32x4*)dst = pack8(acc[ai][bj][m][0] * w, acc[ai][bj][m][1] * w);
                    }
                }
            }
    }
};

struct SchedPlain {
    unsigned A, B; int nM, nN, G, c; unsigned a_tile, b_tile;
    __device__ __forceinline__ bool next(int i, Unit& u) const {
        const int total = nM * nN; const int L = i * G + c; if (L >= total) return false;
        int pm, pn; pg8::tile_decode(pg8::xcd_remap(L, total), nM, nN, pm, pn);
        u.pm = pm; u.pn = pn; u.kind = 0; u.aux = 0; u.A = A + (unsigned)pm * a_tile; u.B = B + (unsigned)pn * b_tile; return true;
    }
};
struct SchedIn {
    unsigned hb, win, memn, wmkv; int G, c, nN1; bool memkv;
    __device__ __forceinline__ bool next(int i, Unit& u) const {
        const int T0 = 32 * nN1, TOT = memkv ? T0 + 32 : T0; const int L = i * G + c; if (L >= TOT) return false;
        const int w = pg8::xcd_remap(L, TOT); int pm, pn;
        if (w < T0) { pg8::tile_decode(w, 32, nN1, pm, pn); u.kind = 0; u.A = hb + (unsigned)pm * 256u * DM * 2u; u.B = win + (unsigned)pn * 256u * DM * 2u; }
        else { pg8::tile_decode(w - T0, 4, 8, pm, pn); u.kind = 1; u.A = memn + (unsigned)pm * 256u * DM * 2u; u.B = wmkv + (unsigned)pn * 256u * DM * 2u; }
        u.pm = pm; u.pn = pn; u.aux = 0; return true;
    }
};
struct SchedIn2 {
    unsigned hb, win, memn, wmkv; int G, c, pnx;
    __device__ __forceinline__ bool next(int i, Unit& u) const {
        const int L = c - (G - 64); if (i != 0 || L < 0) return false;
        if (L < 32) { u.kind = 0; u.pm = L; u.pn = pnx; u.A = hb + (unsigned)L * 256u * DM * 2u; u.B = win + (unsigned)pnx * 256u * DM * 2u; }
        else { const int t = L - 32; u.kind = 1; u.pm = t & 3; u.pn = t >> 2; u.A = memn + (unsigned)(t & 3) * 256u * DM * 2u; u.B = wmkv + (unsigned)(t >> 2) * 256u * DM * 2u; }
        u.aux = 0; return true;
    }
};
struct SchedUp {
    unsigned proj, wq, wkv; int G, c;
    __device__ __forceinline__ bool next(int i, Unit& u) const {
        constexpr int T0 = 32 * 6, TOT = T0 + 32 * 8; const int L = i * G + c; if (L >= TOT) return false;
        const int w = pg8::xcd_remap(L, TOT); int pm, pn;
        if (w < T0) { pg8::tile_decode(w, 32, 6, pm, pn); u.kind = 0; u.A = proj + ((unsigned)pm * 256u * DINP + PC_CQ) * 2u; u.B = wq + (unsigned)pn * 256u * 512u * 2u; }
        else { pg8::tile_decode(w - T0, 32, 8, pm, pn); u.kind = 1; u.A = proj + ((unsigned)pm * 256u * DINP + PC_CKV) * 2u; u.B = wkv + (unsigned)pn * 256u * 512u * 2u; }
        u.pm = pm; u.pn = pn; u.aux = 0; return true;
    }
};
struct SchedGate {
    unsigned y, wbr; int G, c;
    __device__ __forceinline__ bool next(int i, Unit& u) const {
        const int ti = i / 3, n = i - 3 * ti; const int L = ti * G + c; if (L >= 256) return false;
        int pm, pn; pg8::tile_decode(pg8::xcd_remap(L, 256), 32, 8, pm, pn);
        u.pm = pm; u.pn = pn; u.kind = n; u.aux = 0;
        u.A = y + ((unsigned)pm * 256u * 3072u + n * 1024u) * 2u; u.B = wbr + ((unsigned)n * 2048u + pn * 256u) * 1024u * 2u; return true;
    }
};
struct SchedMoe {
    unsigned A, B; const unsigned char* ws; int nrt, nN, G, c; unsigned a_tile, b_tile, b_exp;
    __device__ __forceinline__ bool next(int i, Unit& u) const {
        const int total = nrt * nN; const int L = i * G + c; if (L >= total) return false;
        int pm, pn; pg8::tile_decode(pg8::xcd_remap(L, total), nrt, nN, pm, pn);
        const int e = __builtin_amdgcn_readfirstlane(__hip_atomic_load((const int*)(ws + WS_TEXP) + pm, __ATOMIC_RELAXED, __HIP_MEMORY_SCOPE_AGENT));
        u.pm = pm; u.pn = pn; u.kind = e; u.aux = 0; u.A = A + (unsigned)pm * a_tile; u.B = B + (unsigned)e * b_exp + (unsigned)pn * b_tile; return true;
    }
};

struct SchedMoeTail {
    unsigned A, B; const unsigned char* ws; int nrt, G, c; unsigned a_tile, b_tile, b_exp, kq_bytes;
    __device__ __forceinline__ bool next(int i, Unit& u) const {
        const int total = (nrt - 64) * 8 * 4; const int L = i * G + c; if (L >= total) return false;
        const int kq = L & 3, tile = L >> 2, pm = 64 + (tile >> 3), pn = tile & 7;
        const int e = __builtin_amdgcn_readfirstlane(__hip_atomic_load((const int*)(ws + WS_TEXP) + pm, __ATOMIC_RELAXED, __HIP_MEMORY_SCOPE_AGENT));
        u.pm = pm; u.pn = pn; u.kind = e; u.aux = kq + 1; u.A = A + (unsigned)pm * a_tile + (unsigned)kq * kq_bytes; u.B = B + (unsigned)e * b_exp + (unsigned)pn * b_tile + (unsigned)kq * kq_bytes; return true;
    }
};

namespace att {
__device__ __forceinline__ int crow(int r, int hi) { return (r & 3) + 8 * (r >> 2) + 4 * hi; }
__device__ __forceinline__ int v_st(int k, int c) { const int kk = (k & ~0xC) | ((k & 4) << 1) | ((k & 8) >> 1); return ((kk >> 3) * 4 + (c >> 5)) * 512 + ((kk & 7) * 32 + (c & 31)) * 2; }
__device__ __forceinline__ int v_rd_base(int lane) { return ((lane & 3) << 3) | (((lane >> 2) & 3) << 6) | (((lane >> 4) & 1) << 5) | (((lane >> 5) & 1) << 8); }
constexpr int v_rd_off(int d0, int ks, int half) { return d0 * 512 + ks * 4096 + half * 2048; }
template <int OFF> __device__ __forceinline__ s16x4 tr_read(unsigned vb) {
    s16x4 r; asm volatile("ds_read_b64_tr_b16 %0, %1 offset:%2" : "=&v"(r) : "v"(vb), "i"(OFF) : "memory"); return r;
}
template <int D0> __device__ __forceinline__ void pv_one(f32x16& od, unsigned vb, bf16x8 pa0, bf16x8 pa1, bf16x8 pa2, bf16x8 pa3) {
    const s16x4 l0 = tr_read<v_rd_off(D0, 0, 0)>(vb), h0 = tr_read<v_rd_off(D0, 0, 1)>(vb), l1 = tr_read<v_rd_off(D0, 1, 0)>(vb), h1 = tr_read<v_rd_off(D0, 1, 1)>(vb);
    const s16x4 l2 = tr_read<v_rd_off(D0, 2, 0)>(vb), h2 = tr_read<v_rd_off(D0, 2, 1)>(vb), l3 = tr_read<v_rd_off(D0, 3, 0)>(vb), h3 = tr_read<v_rd_off(D0, 3, 1)>(vb);
    asm volatile("s_waitcnt lgkmcnt(0)" ::: "memory"); SBAR();
#define ATT_PK(L, H) (bf16x8){L[0], L[1], L[2], L[3], H[0], H[1], H[2], H[3]}
    od = __builtin_amdgcn_mfma_f32_32x32x16_bf16(pa0, ATT_PK(l0, h0), od, 0, 0, 0);
    od = __builtin_amdgcn_mfma_f32_32x32x16_bf16(pa1, ATT_PK(l1, h1), od, 0, 0, 0);
    od = __builtin_amdgcn_mfma_f32_32x32x16_bf16(pa2, ATT_PK(l2, h2), od, 0, 0, 0);
    od = __builtin_amdgcn_mfma_f32_32x32x16_bf16(pa3, ATT_PK(l3, h3), od, 0, 0, 0);
#undef ATT_PK
}

template <int DK, int K1DIM, bool CAUSAL>
__device__ __forceinline__ void attn_unit(LAS unsigned char* lds, const int tid, const bf16* __restrict__ Qb, int ldq, const bf16* __restrict__ K1, int ldk1, const bf16* __restrict__ K2, int ldk2,
                                          const bf16* __restrict__ Vp, int ldv, bf16* __restrict__ Ob, int ldo, int NT, int q0, float C) {
    constexpr int NKS = DK / 16, KROWB = DK * 2 + 16  , SHM_K = 64 * KROWB, SHM_V = 64 * 128 * 2;
    constexpr int NC1 = K1DIM / 8, NC2 = (DK - K1DIM) / 8, KC1 = NC1 / 8, KC2 = NC2 / 8;
    static_assert(NC2 == 0 || NC2 == 8, "K2 part is 0 or 64 wide");
    const int wid = tid >> 6, lane = tid & 63, r32 = lane & 31, hi = lane >> 5;
    LAS unsigned char* V_lds = lds; LAS unsigned char* K_lds = lds + 3 * SHM_V;
    LAS float* wsp = (LAS float*)(lds + 3 * SHM_V + 2 * SHM_K) + wid * 64;
    static_assert(3 * SHM_V + 2 * SHM_K + 8 * 64 * 4 <= RING_BYTES, "attention LDS");
    const bool grpB = wid >= 4; LAS float* li_l = wsp; LAS float* al_l = wsp + 32;
    float m_reg = -1e30f, l_reg = 0.f; f32x16 o[4] = {}; bf16x8 qr[NKS];
    { const bf16* Qw = Qb + (unsigned)((wid * 32 + r32) * ldq + hi * 8);
#pragma unroll
      for (int d0 = 0; d0 < NKS; ++d0) qr[d0] = *(const bf16x8*)(Qw + d0 * 16); }
    const int sr = tid >> 4, sc = (tid & 15) * 8, vst0 = v_st(sr, sc), vst1 = v_st(32 + sr, sc);
    const unsigned vb0 = (unsigned)(uintptr_t)V_lds + v_rd_base(lane);
    const unsigned voffv = (unsigned)(sr * ldv + sc);
    unsigned koff1[KC1], kw1[KC1];
#pragma unroll
    for (int i = 0; i < KC1; ++i) { const int c = tid + 512 * i, row = c / NC1, cc = (c % NC1) * 8; koff1[i] = (unsigned)(row * ldk1 + cc); kw1[i] = (unsigned)(row * KROWB + cc * 2); }
    const unsigned koff2 = (unsigned)((tid >> 3) * ldk2 + (tid & 7) * 8), kw2 = (unsigned)((tid >> 3) * KROWB + (K1DIM + (tid & 7) * 8) * 2);
    const unsigned kr0 = (unsigned)(r32 * KROWB + hi * 16);
    bf16x8 ks1[KC1], ks2, vs0, vs1;
#define ATT_SLOAD(k0) do { const bf16* kb_ = K1 + (size_t)(k0) * ldk1; _Pragma("unroll") for (int i_ = 0; i_ < KC1; ++i_) ks1[i_] = *(const bf16x8*)(kb_ + koff1[i_]); \
        if (KC2) { const bf16* k2_ = K2 + (size_t)(k0) * ldk2; ks2 = *(const bf16x8*)(k2_ + koff2); } \
        const bf16* vb_ = Vp + (size_t)(k0) * ldv; vs0 = *(const bf16x8*)(vb_ + voffv); vs1 = *(const bf16x8*)(vb_ + (size_t)32 * ldv + voffv); } while (0)
#define ATT_SWRITE(b, vbuf) do { _Pragma("unroll") for (int i_ = 0; i_ < KC1; ++i_) *(LAS bf16x8*)(K_lds + (b) * SHM_K + kw1[i_]) = ks1[i_]; \
        if (KC2) *(LAS bf16x8*)(K_lds + (b) * SHM_K + kw2) = ks2; \
        *(LAS bf16x8*)(V_lds + (vbuf) * SHM_V + vst0) = vs0; *(LAS bf16x8*)(V_lds + (vbuf) * SHM_V + vst1) = vs1; } while (0)
#define ATT_PV(vbuf) do { const unsigned vb = vb0 + (vbuf) * SHM_V; \
          pv_one<0>(o[0], vb, pa0, pa1, pa2, pa3); pv_one<1>(o[1], vb, pa0, pa1, pa2, pa3); pv_one<2>(o[2], vb, pa0, pa1, pa2, pa3); pv_one<3>(o[3], vb, pa0, pa1, pa2, pa3); } while (0)
    __syncthreads();
    ATT_SLOAD(0); ATT_SWRITE(0, 0); __syncthreads();
    bf16x8 pa0 = {}, pa1 = {}, pa2 = {}, pa3 = {};
    int vcur = 0, vprev = 0;
#pragma unroll 1
    for (int j = 0; j < NT; ++j) {
        const int bsel = j & 1;
        if (grpB && j > 0) ATT_PV(vprev);
        if (j + 1 < NT) ATT_SLOAD((j + 1) * 64);
        f32x16 p0 = {}, p1 = {};
        { const LAS unsigned char* Kb = K_lds + bsel * SHM_K + kr0;
#pragma unroll
          for (int d0 = 0; d0 < NKS; ++d0) {
            const bf16x8 b0 = *(const LAS bf16x8*)(Kb + d0 * 32);
            const bf16x8 b1 = *(const LAS bf16x8*)(Kb + 32 * KROWB + d0 * 32);
            p0 = __builtin_amdgcn_mfma_f32_32x32x16_bf16(b0, qr[d0], p0, 0, 0, 0);
            p1 = __builtin_amdgcn_mfma_f32_32x32x16_bf16(b1, qr[d0], p1, 0, 0, 0); } }
        if (CAUSAL && j >= NT - 4) {
            const int qpos = q0 + wid * 32 + r32, kb = j * 64;
#pragma unroll
            for (int r = 0; r < 16; ++r) { const int kp = kb + crow(r, hi); p0[r] = (kp <= qpos) ? p0[r] : -1e30f; p1[r] = (kp + 32 <= qpos) ? p1[r] : -1e30f; }
        }
        float pmax = p0[0];
#pragma unroll
        for (int r = 1; r < 16; ++r) pmax = fmaxf(pmax, p0[r]);
#pragma unroll
        for (int r = 0; r < 16; ++r) pmax = fmaxf(pmax, p1[r]);
        { auto rr = __builtin_amdgcn_permlane32_swap(__float_as_uint(pmax), __float_as_uint(pmax), false, false); pmax = fmaxf(__uint_as_float(rr[0]), __uint_as_float(rr[1])); }
        if (!__all(pmax <= m_reg)) {
            const float mn = fmaxf(m_reg, pmax), alpha = __builtin_amdgcn_exp2f((m_reg - mn) * C); m_reg = mn; l_reg *= alpha;
            if (hi == 0) al_l[r32] = alpha;
            asm volatile("s_waitcnt lgkmcnt(0)" ::: "memory");
#pragma unroll
            for (int r = 0; r < 16; ++r) { const float a = al_l[crow(r, hi)];
#pragma unroll
                for (int d = 0; d < 4; ++d) o[d][r] *= a; }
        }
        const float mnC = -m_reg * C; float ps = 0.f;
#pragma unroll
        for (int r = 0; r < 16; ++r) { p0[r] = __builtin_amdgcn_exp2f(fmaf(p0[r], C, mnC)); p1[r] = __builtin_amdgcn_exp2f(fmaf(p1[r], C, mnC)); ps += p0[r] + p1[r]; }
        { auto rr = __builtin_amdgcn_permlane32_swap(__float_as_uint(ps), __float_as_uint(ps), false, false); ps = __uint_as_float(rr[0]) + __uint_as_float(rr[1]); }
        l_reg += ps;
#define ATT_PK4(P, BASE, OUT) do { unsigned a0 = cvt_pk_bf16(P[BASE + 0], P[BASE + 1]), a1 = cvt_pk_bf16(P[BASE + 2], P[BASE + 3]); \
        unsigned b0_ = cvt_pk_bf16(P[BASE + 4], P[BASE + 5]), b1_ = cvt_pk_bf16(P[BASE + 6], P[BASE + 7]); \
        auto r0_ = __builtin_amdgcn_permlane32_swap(a0, b0_, false, false); auto r1_ = __builtin_amdgcn_permlane32_swap(a1, b1_, false, false); \
        u32x4 w_ = {r0_[0], r1_[0], r0_[1], r1_[1]}; OUT = *reinterpret_cast<bf16x8*>(&w_); } while (0)
        ATT_PK4(p0, 0, pa0); ATT_PK4(p0, 8, pa1); ATT_PK4(p1, 0, pa2); ATT_PK4(p1, 8, pa3);
#undef ATT_PK4
        if (!grpB) ATT_PV(vcur);
        const int vnext = vcur == 2 ? 0 : vcur + 1;
        if (j + 1 < NT) ATT_SWRITE(bsel ^ 1, vnext);
        vprev = vcur; vcur = vnext;
        __syncthreads();
    }
    if (grpB) ATT_PV(vprev);
    if (hi == 0) li_l[r32] = l_reg;
    asm volatile("s_waitcnt lgkmcnt(0)" ::: "memory");
    int ldo_o = ldo, hi_o = hi; asm volatile("" : "+v"(hi_o), "+s"(ldo_o));
    bf16* Ow = Ob + (unsigned)((wid * 32) * ldo_o + r32);
#pragma unroll
    for (int r = 0; r < 16; ++r) { const int orow = crow(r, hi_o); const float rl = __builtin_amdgcn_rcpf(li_l[orow]);
        bf16* op = Ow + (unsigned)(orow * ldo_o);
#pragma unroll
        for (int d0 = 0; d0 < 4; ++d0) op[d0 * 32] = f2bf(o[d0][r] * rl); }
#undef ATT_SLOAD
#undef ATT_SWRITE
#undef ATT_PV
}
}

namespace hg {
__device__ __forceinline__ int crow(int r, int hi) { return (r & 3) + 8 * (r >> 2) + 4 * hi; }
__device__ __forceinline__ void mma32(f32x16& acc, const LAS bf16* A, int lda, const LAS bf16* Bt, int ldb, int K, int r32, int hi) {
    for (int k0 = 0; k0 < K; k0 += 16) {
        const bf16x8 a = *(const LAS bf16x8*)(A + r32 * lda + k0 + hi * 8);
        const bf16x8 b = *(const LAS bf16x8*)(Bt + r32 * ldb + k0 + hi * 8);
        acc = __builtin_amdgcn_mfma_f32_32x32x16_bf16(a, b, acc, 0, 0, 0);
    }
}
constexpr int LD_D = 136, LD_S = 72, LD_O = 132;
constexpr int L_TOT = 0;
constexpr int L_VT = 2048;
constexpr int L_KT = L_VT + 128 * LD_S * 2;
constexpr int L_QT = L_KT + 128 * LD_S * 2;
constexpr int L_QH = L_QT + 64 * LD_D * 2;
constexpr int L_P = L_QH + 64 * LD_D * 2;
constexpr int L_O = L_P + 64 * LD_S * 2;
constexpr int L_END = L_O + 64 * LD_O * 4;
static_assert(L_END <= RING_BYTES, "hgrn LDS");

__device__ __forceinline__ void gate_scan(LAS unsigned char* lds, const float (&z)[16], float lb, int d, int jq, float (&kk)[16], float (&bl)[16], float& bref, float& b63) {
    LAS float* tot = (LAS float*)(lds + L_TOT);
    float run = 0.f;
#pragma unroll
    for (int i = 0; i < 16; ++i) {
        const float f = lb + (1.0f - lb) * HG_SIGMOID(z[i]);
        run += __logf(fmaxf(f, 1e-20f)); bl[i] = run; kk[i] = 1.0f - f;
    }
    tot[jq * 128 + d] = run;
    __syncthreads();
    const float t0 = tot[d], t1 = tot[128 + d], t2 = tot[256 + d], t3 = tot[384 + d];
    const float off = (jq > 0 ? t0 : 0.f) + (jq > 1 ? t1 : 0.f) + (jq > 2 ? t2 : 0.f);
#pragma unroll
    for (int i = 0; i < 16; ++i) bl[i] += off;
    bref = t0 + t1; b63 = (t0 + t1) + (t2 + t3);
}
__device__ __forceinline__ void stage_vt(LAS unsigned char* lds, const bf16x8 (&vch)[2], int tid) {
    LAS bf16* VT = (LAS bf16*)(lds + L_VT);
#pragma unroll
    for (int i = 0; i < 2; ++i) { const int id = tid + 512 * i, s = id >> 4, e8 = (id & 15) * 8;
#pragma unroll
        for (int q = 0; q < 8; ++q) VT[(e8 + q) * LD_S + s] = (bf16)vch[i][q]; }
}
__device__ __forceinline__ void pass1_unit(LAS unsigned char* lds, const int tid, int unit, const float* zf, const bf16* proj, const float* lbv, float* hu, float* hdec) {
    const int wid = tid >> 6, lane = tid & 63, r32 = lane & 31, hi = lane >> 5;
    const int bh = unit >> 5, c = unit & 31, b = bh >> 3, hh = bh & 7, tok0 = b * SEQ + c * CHUNK;
    const int d = tid & 127, jq = tid >> 7;
    float z[16], kk[16], bl[16], bref, b63; bf16x8 vch[2];
    const float lb = lbv[hh * 128 + d];
#pragma unroll
    for (int i = 0; i < 16; ++i) z[i] = zf[(size_t)(tok0 + jq * 16 + i) * 1024 + hh * 128 + d];
#pragma unroll
    for (int i = 0; i < 2; ++i) { const int id = tid + 512 * i, s = id >> 4, e8 = (id & 15) * 8; vch[i] = *(const bf16x8*)(proj + (size_t)(tok0 + s) * DINP + PC_I + hh * 128 + e8); }
    __syncthreads();
    gate_scan(lds, z, lb, d, jq, kk, bl, bref, b63);
    LAS bf16* KT = (LAS bf16*)(lds + L_KT);
#pragma unroll
    for (int i = 0; i < 16; ++i) KT[d * LD_S + jq * 16 + i] = f2bf(kk[i] * __expf(b63 - bl[i]));
    stage_vt(lds, vch, tid);
    if (jq == 0) hdec[(size_t)unit * 128 + d] = __expf(b63);
    __syncthreads();
    const LAS bf16* VT = (const LAS bf16*)(lds + L_VT);
    const int eb = wid >> 1;
#pragma unroll
    for (int q = 0; q < 2; ++q) { const int db = (wid & 1) * 2 + q; f32x16 acc = {};
        mma32(acc, VT + eb * 32 * LD_S, LD_S, KT + db * 32 * LD_S, LD_S, 64, r32, hi);
#pragma unroll
        for (int r = 0; r < 16; ++r) hu[(size_t)unit * 16384 + (size_t)(eb * 32 + crow(r, hi)) * 128 + db * 32 + r32] = acc[r]; }
}
__device__ __forceinline__ void pass2_task(int task, const float* hu, const float* hdec, bf16* hs) {
    const int bh = task >> 12, g = task & 4095, d4 = (g & 31) * 4;
    f32x4 st = {0.f, 0.f, 0.f, 0.f};
    const float* p = hu + (size_t)bh * 32 * 16384 + (size_t)g * 4;
    bf16* q = hs + (size_t)bh * 32 * 16384 + (size_t)g * 4;
    const float* dp = hdec + (size_t)bh * 32 * 128 + d4;
#pragma unroll 8
    for (int c = 0; c < 32; ++c) { const f32x4 u = *(const f32x4*)(p + (size_t)c * 16384); const f32x4 dv = *(const f32x4*)(dp + c * 128);
        u32x2 o; o.x = cvt_pk_bf16(st[0], st[1]); o.y = cvt_pk_bf16(st[2], st[3]); *(u32x2*)(q + (size_t)c * 16384) = o; st = dv * st + u; }
}
struct P3In { float z[16]; bf16 qraw[16]; bf16x8 vch[2]; float lb; };
__device__ __forceinline__ void pass3_load(P3In& R, const int tid, int unit, const float* zf, const bf16* proj, const float* lbv, const bf16* hs) {
    const int bh = unit >> 5, c = unit & 31, b = bh >> 3, hh = bh & 7, tok0 = b * SEQ + c * CHUNK;
    const unsigned d = tid & 127, jq = tid >> 7;
    const float* zb = zf + (size_t)tok0 * 1024 + hh * 128; const unsigned zo = jq * 16u * 1024u + d;
    const bf16* qb = proj + (size_t)tok0 * DINP + PC_Q + hh * 128; const unsigned qo = jq * 16u * (unsigned)DINP + d;
    const bf16* vb = proj + (size_t)tok0 * DINP + PC_I + hh * 128; const unsigned vo = ((unsigned)tid >> 4) * (unsigned)DINP + ((unsigned)tid & 15u) * 8u;
    R.lb = (lbv + hh * 128)[d];
#pragma unroll
    for (int i = 0; i < 16; ++i) R.z[i] = (zb + i * 1024)[zo];
#pragma unroll
    for (int i = 0; i < 16; ++i) R.qraw[i] = (qb + i * DINP)[qo];
#pragma unroll
    for (int i = 0; i < 2; ++i) R.vch[i] = *(const bf16x8*)((vb + 32 * i * DINP) + vo);
}
__device__ __forceinline__ void pass3_compute(LAS unsigned char* lds, const int tid, int unit, P3In& R, int next_unit, const float* zf, const bf16* proj, const float* lbv, const bf16* hs, const float* hgn, bf16* y) {
    const int wid = tid >> 6, lane = tid & 63, r32 = lane & 31, hi = lane >> 5;
    const int bh = unit >> 5, c = unit & 31, b = bh >> 3, hh = bh & 7, tok0 = b * SEQ + c * CHUNK;
    const int d = tid & 127, jq = tid >> 7;
    const int tb = wid >> 2, eb = wid & 3;
    const int tn = tid >> 3, part = tid & 7;
    float kk[16], bl[16], bref, b63;
    const float (&z)[16] = R.z; const bf16 (&qraw)[16] = R.qraw; const bf16x8 (&vch)[2] = R.vch; const float lb = R.lb;
    bf16x8 st[8]; u32x4 g0, g1;
    { const bf16* sp = hs + (size_t)unit * 16384 + (size_t)(eb * 32 + r32) * 128 + hi * 8;
#pragma unroll
      for (int k = 0; k < 8; ++k) st[k] = *(const bf16x8*)(sp + 16 * k); }
    { const bf16* gp = proj + (size_t)(tok0 + tn) * DINP + PC_G + hh * 128 + part * 16; g0 = *(const u32x4*)gp; g1 = *(const u32x4*)(gp + 8); }
    __syncthreads();
    gate_scan(lds, z, lb, d, jq, kk, bl, bref, b63);
    LAS bf16* KT = (LAS bf16*)(lds + L_KT); LAS bf16* QT = (LAS bf16*)(lds + L_QT); LAS bf16* QH = (LAS bf16*)(lds + L_QH);
    const float eref = __expf(bref);
#pragma unroll
    for (int i = 0; i < 16; ++i) { const int t = jq * 16 + i;
        const float qv = bf2f(qraw[i]), er = __expf(bl[i] - bref);
        QT[t * LD_D + d] = f2bf(qv * er);
        QH[t * LD_D + d] = f2bf(qv * (er * eref));
        KT[t * LD_D + d] = f2bf(kk[i] * __builtin_amdgcn_rcpf(er)); }
    stage_vt(lds, vch, tid);
    if (next_unit >= 0) pass3_load(R, tid, next_unit, zf, proj, lbv, hs);
    __syncthreads();
    LAS bf16* PL = (LAS bf16*)(lds + L_P);
    if (wid < 4) {
        const int tb2 = wid >> 1, sb = wid & 1; f32x16 acc = {};
        if (!(tb2 == 0 && sb == 1)) mma32(acc, QT + tb2 * 32 * LD_D, LD_D, KT + sb * 32 * LD_D, LD_D, 128, r32, hi);
#pragma unroll
        for (int r = 0; r < 16; ++r) { const int t = tb2 * 32 + crow(r, hi), s2 = sb * 32 + r32; PL[t * LD_S + s2] = f2bf(s2 <= t ? acc[r] : 0.f); }
    }
    __syncthreads();
    {
        f32x16 acc = {};
        mma32(acc, PL + tb * 32 * LD_S, LD_S, (const LAS bf16*)(lds + L_VT) + eb * 32 * LD_S, LD_S, 64, r32, hi);
#pragma unroll
        for (int k = 0; k < 8; ++k) {
            const bf16x8 a = *(const LAS bf16x8*)(QH + (tb * 32 + r32) * LD_D + 16 * k + hi * 8);
            acc = __builtin_amdgcn_mfma_f32_32x32x16_bf16(a, st[k], acc, 0, 0, 0);
        }
        LAS float* OL = (LAS float*)(lds + L_O);
#pragma unroll
        for (int r = 0; r < 16; ++r) OL[(tb * 32 + crow(r, hi)) * LD_O + eb * 32 + r32] = acc[r];
    }
    __syncthreads();
    {
        const LAS float* orow = (const LAS float*)(lds + L_O) + tn * LD_O + part * 16;
        float v[16]; float ss = 0.f;
#pragma unroll
        for (int i = 0; i < 16; ++i) { v[i] = orow[i]; ss += v[i] * v[i]; }
        ss += shflx(ss, 1, lane); ss += shflx(ss, 2, lane); ss += shflx(ss, 4, lane);
        const float rs = rsqrtf(ss * (1.0f / 128.0f) + EPS);
        const unsigned gw[8] = {g0.x, g0.y, g0.z, g0.w, g1.x, g1.y, g1.z, g1.w};
        float ov[16];
#pragma unroll
        for (int i = 0; i < 8; ++i) { const float ga = bflo(gw[i]), gb = bfhi(gw[i]);
            ov[2 * i] = v[2 * i] * rs * hgn[part * 16 + 2 * i] * (ga * HG_SIGMOID(ga));
            ov[2 * i + 1] = v[2 * i + 1] * rs * hgn[part * 16 + 2 * i + 1] * (gb * HG_SIGMOID(gb)); }
        bf16* yp = y + (size_t)(tok0 + tn) * 3072 + hh * 128 + part * 16;
        u32x4 w0, w1;
        w0.x = cvt_pk_bf16(ov[0], ov[1]); w0.y = cvt_pk_bf16(ov[2], ov[3]); w0.z = cvt_pk_bf16(ov[4], ov[5]); w0.w = cvt_pk_bf16(ov[6], ov[7]);
        w1.x = cvt_pk_bf16(ov[8], ov[9]); w1.y = cvt_pk_bf16(ov[10], ov[11]); w1.z = cvt_pk_bf16(ov[12], ov[13]); w1.w = cvt_pk_bf16(ov[14], ov[15]);
        *(u32x4*)yp = w0; *(u32x4*)(yp + 8) = w1;
    }
}
__device__ __forceinline__ void pass3_unit(LAS unsigned char* lds, const int tid, int unit, const float* zf, const bf16* proj, const float* lbv, const bf16* hs, const float* hgn, bf16* y) {
    P3In R; pass3_load(R, tid, unit, zf, proj, lbv, hs); pass3_compute(lds, tid, unit, R, -1, zf, proj, lbv, hs, hgn, y);
}
}

struct TDesc { const float* src; bf16* dst; const float* gain; size_t sstride, dstride; int gstride, nbatch, K, ld, Ndst, map; float f8scale; };
enum { MAP_ID = 0, MAP_WIN = 1, MAP_QUP = 2, MAP_GU_D = 3, MAP_GU_E = 4, MAP_GATE = 5 };
__device__ __forceinline__ int src_col(int map, int n) {
    switch (map) {
    case MAP_WIN:
        if (n < PC_KR) return n;
        if (n < PC_KR + 64) { const int p = n - PC_KR; return 5120 + (p & 1) * 32 + (p >> 1); }
        if (n < PC_QM) return -1;
        return n - 192;
    case MAP_QUP: { const int hd = n / QKD, c = n % QKD; if (c < NOPE) return n; const int p = c - NOPE; return hd * QKD + NOPE + (p & 1) * 32 + (p >> 1); }
    case MAP_GU_D: { const int t = n >> 8, r = n & 255; return r < 128 ? 128 * t + r : FF + 128 * t + (r - 128); }
    case MAP_GATE: return n + 6208;
    case MAP_GU_E: { const int t = n >> 8, r = n & 255; return r < 128 ? 128 * t + r : FFE + 128 * t + (r - 128); }
    default: return n;
    }
}
__device__ __forceinline__ void transpose_item(const TDesc& D, int item, LAS float* scr, int lane) {
    const int nblk = D.Ndst / 32, per = (D.K / 64) * nblk, bt = item / per, r = item % per, kb = r / nblk, nb = r % nblk, k0 = 64 * kb, n0 = 32 * nb;
    const float* W = D.src + (size_t)bt * D.sstride; bf16* WT = D.dst + (size_t)bt * D.dstride; const float* gn = D.gain ? D.gain + (size_t)bt * D.gstride : nullptr;
    const int sc = src_col(D.map, n0 + (lane & 31));
    const float msk = sc < 0 ? 0.f : 1.f;
    const float* wp = W + (size_t)(k0 + (lane >> 5)) * D.ld + (sc < 0 ? 0 : sc);
    float v[32];
#pragma unroll
    for (int i = 0; i < 32; ++i) v[i] = __builtin_nontemporal_load(wp + (size_t)(2 * i) * D.ld);
#pragma unroll
    for (int i = 0; i < 32; ++i) scr[(2 * i + (lane >> 5)) * 33 + (lane & 31)] = v[i] * msk;
    LDS_WAIT(); asm volatile("" ::: "memory");
    const int c = lane & 7;
    f32x4 g0 = {1.f, 1.f, 1.f, 1.f}, g1 = g0;
    if (gn) { g0 = *(const f32x4*)(gn + k0 + 8 * c); g1 = *(const f32x4*)(gn + k0 + 8 * c + 4); }
    if (D.f8scale != 0.f) {
        g0 = g0 * D.f8scale; g1 = g1 * D.f8scale; unsigned char* W8 = (unsigned char*)D.dst + (size_t)bt * D.dstride;
#pragma unroll
        for (int j = 0; j < 4; ++j) { const int n = (lane >> 3) + 8 * j; const LAS float* s = scr + (8 * c) * 33 + n;
            const f32x4 a = {s[0 * 33] * g0[0], s[1 * 33] * g0[1], s[2 * 33] * g0[2], s[3 * 33] * g0[3]}, b = {s[4 * 33] * g1[0], s[5 * 33] * g1[1], s[6 * 33] * g1[2], s[7 * 33] * g1[3]};
            *(u32x2*)(W8 + (size_t)(n0 + n) * D.K + k0 + 8 * c) = pack8_f8(a, b); }
    } else {
#pragma unroll
    for (int j = 0; j < 4; ++j) { const int n = (lane >> 3) + 8 * j; const LAS float* s = scr + (8 * c) * 33 + n;
        u32x4 o; o.x = cvt_pk_bf16(s[0 * 33] * g0[0], s[1 * 33] * g0[1]); o.y = cvt_pk_bf16(s[2 * 33] * g0[2], s[3 * 33] * g0[3]);
        o.z = cvt_pk_bf16(s[4 * 33] * g1[0], s[5 * 33] * g1[1]); o.w = cvt_pk_bf16(s[6 * 33] * g1[2], s[7 * 33] * g1[3]);
        *(u32x4*)(WT + (size_t)(n0 + n) * D.K + k0 + 8 * c) = o; }
    }
    LDS_WAIT(); asm volatile("" ::: "memory");
}
constexpr int TL_LD = 260, TL_K = 128, TL_RW = TL_K / 8;
__device__ __forceinline__ void tl_decode(const TDesc& D, int tile, int& bt, int& k0, int& n0) {
    const int nblk = D.Ndst / 256, per = (D.K / TL_K) * nblk; bt = tile / per; const int r = tile % per; k0 = TL_K * (r / nblk); n0 = 256 * (r % nblk);
}
__device__ __forceinline__ void tl_load(const TDesc& D, int tile, f32x4 (&v)[TL_RW], int wave, int lane) {
    int bt, k0, n0; tl_decode(D, tile, bt, k0, n0);
    const int sc = src_col(D.map, n0 + 4 * lane);
    const float* wp = D.src + (size_t)bt * D.sstride + (size_t)(k0 + wave * TL_RW) * D.ld + sc;
#pragma unroll
    for (int i = 0; i < TL_RW; ++i) v[i] = __builtin_nontemporal_load((const f32x4*)(wp + (size_t)i * D.ld));
}
__device__ __forceinline__ void tl_store(const TDesc& D, int tile, const f32x4 (&v)[TL_RW], LAS float* scr, int tid, int wave, int lane) {
    int bt, k0, n0; tl_decode(D, tile, bt, k0, n0);
#pragma unroll
    for (int i = 0; i < TL_RW; ++i) *(LAS f32x4*)(scr + (wave * TL_RW + i) * TL_LD + 4 * lane) = v[i];
    __syncthreads();
    constexpr int HK = TL_K / 2;
    const int n = tid >> 1, h = tid & 1; const LAS float* s = scr + (HK * h) * TL_LD + n;
    const float* gn = D.gain ? D.gain + (size_t)bt * D.gstride + k0 + HK * h : nullptr;
    const float sc = D.f8scale != 0.f ? D.f8scale : 1.0f;
#pragma unroll
    for (int p = 0; p < HK / 16; ++p) {
        f32x4 x[4];
#pragma unroll
        for (int q = 0; q < 4; ++q) { f32x4 g = {sc, sc, sc, sc}; if (gn) g = g * *(const f32x4*)(gn + 16 * p + 4 * q);
            const LAS float* sq = s + (16 * p + 4 * q) * TL_LD;
            x[q] = (f32x4){sq[0] * g[0], sq[TL_LD] * g[1], sq[2 * TL_LD] * g[2], sq[3 * TL_LD] * g[3]}; }
        if (D.f8scale != 0.f) {
            unsigned char* W8 = (unsigned char*)D.dst + (size_t)bt * D.dstride + (size_t)(n0 + n) * D.K + k0 + HK * h + 16 * p;
            const u32x2 a = pack8_f8(x[0], x[1]), b = pack8_f8(x[2], x[3]);
            *(u32x4*)W8 = (u32x4){a.x, a.y, b.x, b.y};
        } else {
            bf16* WT = D.dst + (size_t)bt * D.dstride + (size_t)(n0 + n) * D.K + k0 + HK * h + 16 * p;
            *(u32x4*)WT = pack8(x[0], x[1]); *(u32x4*)(WT + 8) = pack8(x[2], x[3]);
        }
    }
    __syncthreads();
}
__device__ __forceinline__ float row_to_bf16(const float* xrow, bf16* orow, const float* gain, bool normalize, int lane, unsigned char* o8 = nullptr) {
    f32x4 v[8]; float s = 0.f;
#pragma unroll
    for (int j = 0; j < 8; ++j) { v[j] = *(const f32x4*)(xrow + 4 * lane + 256 * j); s += (v[j][0] * v[j][0] + v[j][1] * v[j][1]) + (v[j][2] * v[j][2] + v[j][3] * v[j][3]); }
    s = wave_sum(s, lane);
    const float rs = normalize ? rsqrtf(s * (1.0f / DM) + EPS) : 1.0f;
#pragma unroll
    for (int j = 0; j < 8; ++j) { f32x4 w = v[j] * rs; if (gain) w = w * *(const f32x4*)(gain + 4 * lane + 256 * j);
        u32x2 o; o.x = cvt_pk_bf16(w[0], w[1]); o.y = cvt_pk_bf16(w[2], w[3]); *(u32x2*)(orow + 4 * lane + 256 * j) = o;
        if (o8) { const f32x4 z = w * F8_H; int q = 0; q = __builtin_amdgcn_cvt_pk_fp8_f32(clamp448(z[0]), clamp448(z[1]), q, false); q = __builtin_amdgcn_cvt_pk_fp8_f32(clamp448(z[2]), clamp448(z[3]), q, true); *(int*)(o8 + 4 * lane + 256 * j) = q; } }
    return s;
}

struct Args { const void* in[22]; float* out; unsigned char* ws; int ph_lo, ph_hi; };
static_assert(sizeof(Args) == 200 && offsetof(Args, out) == 176 && offsetof(Args, ws) == 184, "Args layout");
constexpr int PH_FINAL = 19, N_PHASES = 20;

__global__ void __launch_bounds__(NTHR, 2) trunk_fwd(Args args) {
    extern __shared__ __attribute__((aligned(16))) unsigned char lds_raw[];
    LAS unsigned char* lds = (LAS unsigned char*)lds_raw;
    const int wave0 = __builtin_amdgcn_readfirstlane((int)threadIdx.x >> 6);
#define PHASE_IDS int tid = wave0 * 64 + lane_id(); const CAS char* kargs = (const CAS char*)__builtin_amdgcn_kernarg_segment_ptr(); asm volatile("" : "+s"(kargs)); \
    GAS unsigned char* wsg = *(GAS unsigned char* const CAS*)(kargs + 184); int G = gridDim.x, bx = blockIdx.x; asm volatile("" : "+v"(tid), "+s"(wsg), "+s"(G), "+s"(bx)); unsigned char* wsl = (unsigned char*)wsg; const int lane = tid & 63, wave = __builtin_amdgcn_readfirstlane(tid >> 6); (void)lane; (void)wave
    unsigned* ctl = (unsigned*)(args.ws + WS_CTL);
    XcdBarrier bar; bar.bar = ctl + CW_BAR; bar.x = 0; bar.st = nullptr; bar.nloc = 0u; bar.nx = 0u;
    const int lo = args.ph_lo, hi = args.ph_hi;
    const bool multi = (hi - lo) > 1;
    if (multi) bar = xcd_barrier_post(ctl + CW_BAR, nullptr, wave0 * 64 + lane_id());
#define IN(k) (lo <= (k) && (k) < hi && ((k) <= MK_LAST_PHASE || (k) == PH_FINAL))
#ifndef MK_KIND_MASK
#define MK_KIND_MASK 0xFFFFFFFFu
#endif
#define KIND(k) ((MK_KIND_MASK >> (k)) & 1u)
#ifndef MK_PROBE_MFMA
#define MK_PROBE_MFMA 0
#endif
#ifndef MK_REPEAT_MASK
#define MK_REPEAT_MASK (MK_PROBE_MODE >= 0 ? (1u << 7) : 0u)
#endif
#define NREP(k) (((MK_REPEAT_MASK >> (k)) & 1u) ? 2 : 1)
#define SEAM(k) do { if (IN(k) && (k) + 1 < hi) xcd_barrier(bar, wave0 * 64 + lane_id()); } while (0)

#define X_IN ((const float*)(*(const GAS float* const CAS*)(kargs + 0)))
#define MEM_IN ((const float*)(*(const GAS float* const CAS*)(kargs + 8)))
#define positions ((const int*)(*(const GAS int* const CAS*)(kargs + 16)))
#define hg_lb ((const float*)(*(const GAS float* const CAS*)(kargs + 24)))
#define attn_norm ((const float*)(*(const GAS float* const CAS*)(kargs + 32)))
#define w_in ((const float*)(*(const GAS float* const CAS*)(kargs + 40)))
#define hg_norm ((const float*)(*(const GAS float* const CAS*)(kargs + 48)))
#define mla_q_norm ((const float*)(*(const GAS float* const CAS*)(kargs + 56)))
#define w_q_up ((const float*)(*(const GAS float* const CAS*)(kargs + 64)))
#define mla_kv_norm ((const float*)(*(const GAS float* const CAS*)(kargs + 72)))
#define w_kv_up ((const float*)(*(const GAS float* const CAS*)(kargs + 80)))
#define mem_norm ((const float*)(*(const GAS float* const CAS*)(kargs + 88)))
#define w_mem_kv ((const float*)(*(const GAS float* const CAS*)(kargs + 96)))
#define w_branch ((const float*)(*(const GAS float* const CAS*)(kargs + 104)))
#define w_o ((const float*)(*(const GAS float* const CAS*)(kargs + 112)))
#define ffn_norm ((const float*)(*(const GAS float* const CAS*)(kargs + 120)))
#define w_dense_gu ((const float*)(*(const GAS float* const CAS*)(kargs + 128)))
#define w_dense_down ((const float*)(*(const GAS float* const CAS*)(kargs + 136)))
#define w_router ((const float*)(*(const GAS float* const CAS*)(kargs + 144)))
#define w_expert_gu ((const float*)(*(const GAS float* const CAS*)(kargs + 152)))
#define w_expert_down ((const float*)(*(const GAS float* const CAS*)(kargs + 160)))
#define final_norm ((const float*)(*(const GAS float* const CAS*)(kargs + 168)))
#define RSRC wsl
#define WIN ((bf16*)(wsl + WS_WIN))
#define WMKV ((bf16*)(wsl + WS_WMKV))
#define WQUP ((bf16*)(wsl + WS_WQUP))
#define WKVUP ((bf16*)(wsl + WS_WKVUP))
#define WBR ((bf16*)(wsl + WS_WBR))
#define WO ((bf16*)(wsl + WS_WO))
#define WGU ((bf16*)(wsl + WS_WGU))
#define WDN ((bf16*)(wsl + WS_WDN))
#define WEGU ((bf16*)(wsl + WS_WEGU))
#define WEDN ((bf16*)(wsl + WS_WEDN))
#define H ((float*)(wsl + WS_H))
#define HB ((bf16*)(wsl + WS_HB))
#define PROJ ((bf16*)(wsl + WS_PROJ))
#define ZF ((float*)(wsl + WS_ZF))
#define MEMN ((bf16*)(wsl + WS_MEMN))
#define MKV ((bf16*)(wsl + WS_MKV))
#define QMLA ((bf16*)(wsl + WS_QMLA))
#define KVB ((bf16*)(wsl + WS_KVB))
#define Y ((bf16*)(wsl + WS_Y))
#define HU ((float*)(wsl + WS_HU))
#define HDEC ((float*)(wsl + WS_HDEC))
#define MRG ((float*)(wsl + WS_MRG))
#define MRGB ((bf16*)(wsl + WS_MRGB))
#define ACT ((bf16*)(wsl + WS_ACT))
#define XS ((bf16*)(wsl + WS_XS))
#define ACTE ((bf16*)(wsl + WS_ACTE))
#define YS ((float*)(wsl + WS_YS))
#define COS ((float*)(wsl + WS_COS))
#define SIN ((float*)(wsl + WS_SIN))
#define LB ((float*)(wsl + WS_LB))
#define SSQA0 ((u64*)(wsl + WS_SSQA0))
#define TOPI ((int*)(wsl + WS_TOPI))
#define TOPW ((float*)(wsl + WS_TOPW))
#define RASS ((int*)(wsl + WS_RASS))
#define TEXP ((int*)(wsl + WS_TEXP))
#define SSQ ((u64*)(wsl + CB_SSQ))
#define BLKCNT ((int*)(wsl + CB_BLKCNT))

    if (KIND(0) && IN(0)) for (int rep = 0; rep < NREP(0); ++rep) { PHASE_IDS;
        LAS float* scr = (LAS float*)(lds + wave * 16384);
        const int gw = bx * NWAVES + wave, NGW = G * NWAVES;
#define TDESC(i) ((i) == 0 ? TDesc{w_in, WIN, attn_norm, (size_t)DM * DIN, (size_t)DINP * DM, DM, 2, DM, DIN, MK_GATE_F8 ? 6400 : DINP, MAP_WIN, 0.f} : \
                  (i) == 1 ? TDesc{w_mem_kv, WMKV, nullptr, (size_t)DM * 2048, (size_t)2048 * DM, 0, 2, DM, 2048, 2048, MAP_ID, 0.f} : \
                  (i) == 2 ? TDesc{w_q_up, WQUP, mla_q_norm, (size_t)512 * 1536, (size_t)1536 * 512, 512, 2, 512, 1536, 1536, MAP_QUP, 0.f} : \
                  (i) == 3 ? TDesc{w_kv_up, WKVUP, mla_kv_norm, (size_t)512 * 2048, (size_t)2048 * 512, 512, 2, 512, 2048, 2048, MAP_ID, 0.f} : \
                  (i) == 4 ? TDesc{w_branch, WBR, nullptr, (size_t)1024 * 2048, (size_t)2048 * 1024, 0, 6, 1024, 2048, 2048, MAP_ID, 0.f} : \
                  (i) == 5 ? TDesc{w_o, WO, nullptr, (size_t)DM * DM, (size_t)DM * DM, 0, 2, DM, DM, DM, MAP_ID, 0.f} : \
                  (i) == 6 ? TDesc{w_dense_gu, WGU, ffn_norm, 0, 0, 0, 1, DM, 2 * FF, 2 * FF, MAP_GU_D, 0.f} : \
                  (i) == 7 ? TDesc{w_dense_down, WDN, nullptr, 0, 0, 0, 1, FF, DM, DM, MAP_ID, 0.f} : \
                  (i) == 8 ? TDesc{w_expert_gu, WEGU, ffn_norm + DM, (size_t)DM * 2 * FFE, (size_t)2 * FFE * DM, 0, 8, DM, 2 * FFE, 2 * FFE, MAP_GU_E, MK_MOE_F8 ? F8_WGU : 0.f} : \
                             TDesc{w_expert_down, WEDN, nullptr, (size_t)FFE * DM, (size_t)DM * FFE, 0, 8, FFE, DM, DM, MAP_ID, MK_MOE_F8 ? F8_WDN : 0.f})
        constexpr int F8K = 64;
        constexpr int cnt[10] = {2 * (DM / 64) * ((MK_GATE_F8 ? 6400 : DINP) / 32), 2 * (DM / 64) * (2048 / 32), 2 * (512 / 64) * (1536 / 32), 2 * (512 / 64) * (2048 / 32), 6 * (1024 / 64) * (2048 / 32), 2 * (DM / 64) * (DM / 32),
                                 (DM / 64) * (2 * FF / 32), (FF / 64) * (DM / 32), 8 * (DM / F8K) * (2 * FFE / 32), 8 * (FFE / F8K) * (DM / 32)};
        int total = 0;
#pragma unroll
        for (int i = 0; i < 8; ++i) total += cnt[i];
        for (int it = gw; it < total; it += NGW) {
            int r = it;
#pragma unroll
            for (int i = 0; i < 8; ++i) { if (r >= 0 && r < cnt[i]) { const TDesc D = TDESC(i); transpose_item(D, r, scr, lane); r = -1; } else if (r >= 0) r -= cnt[i]; }
        }
        __syncthreads();
        {
            LAS float* tscr = (LAS float*)lds;
            constexpr int NT8 = 8 * (DM / TL_K) * (2 * FFE / 256), NT9 = 8 * (FFE / TL_K) * (DM / 256) + (MK_GATE_F8 ? 2 * (DM / TL_K) * (6144 / 256) : 0);
            constexpr int NT9E = 8 * (FFE / TL_K) * (DM / 256);
            const TDesc D8 = TDESC(8), D9e = TDESC(9);
            const TDesc DG = TDesc{w_in, (bf16*)(wsl + WS_WIN8), attn_norm, (size_t)DM * DIN, (size_t)6144 * DM, DM, 2, DM, DIN, 6144, MAP_GATE, F8_WIN};
            f32x4 va[TL_RW], vb[TL_RW];
            constexpr int NTT = NT8 + NT9;
#define TL_LOAD(tt, buf) do { if ((tt) < NTT) { if ((tt) < NT8) tl_load(D8, (tt), buf, wave, lane); else if ((tt) < NT8 + NT9E) tl_load(D9e, (tt) - NT8, buf, wave, lane); else tl_load(DG, (tt) - NT8 - NT9E, buf, wave, lane); } } while (0)
#define TL_STORE(tt, buf) do { if ((tt) < NTT) { if ((tt) < NT8) tl_store(D8, (tt), buf, tscr, tid, wave, lane); else if ((tt) < NT8 + NT9E) tl_store(D9e, (tt) - NT8, buf, tscr, tid, wave, lane); else tl_store(DG, (tt) - NT8 - NT9E, buf, tscr, tid, wave, lane); } } while (0)
            int t = bx;
            TL_LOAD(t, va);
            for (; t < NTT; t += 2 * G) {
                TL_LOAD(t + G, vb); TL_STORE(t, va);
                TL_LOAD(t + 2 * G, va); TL_STORE(t + G, vb);
            }
#undef TL_LOAD
#undef TL_STORE
        }
        for (int m0 = gw; m0 < NTOK; m0 += 4 * NGW) {
            f32x4 xv[4][8];
#pragma unroll
            for (int r = 0; r < 4; ++r) { const int m = m0 + r * NGW; if (m < NTOK) {
#pragma unroll
                for (int j = 0; j < 8; ++j) xv[r][j] = __builtin_nontemporal_load((const f32x4*)(X_IN + (size_t)m * DM + 4 * lane + 256 * j)); } }
#pragma unroll
            for (int r = 0; r < 4; ++r) { const int m = m0 + r * NGW; if (m < NTOK) { float sx = 0.f;
#pragma unroll
                for (int j = 0; j < 8; ++j) { const f32x4 w = xv[r][j]; sx += (w[0] * w[0] + w[1] * w[1]) + (w[2] * w[2] + w[3] * w[3]);
                    u32x2 o; o.x = cvt_pk_bf16(w[0], w[1]); o.y = cvt_pk_bf16(w[2], w[3]); *(u32x2*)(HB + (size_t)m * DM + 4 * lane + 256 * j) = o;
                    if (MK_GATE_F8) { const f32x4 z = w * F8_H; int q = 0; q = __builtin_amdgcn_cvt_pk_fp8_f32(clamp448(z[0]), clamp448(z[1]), q, false); q = __builtin_amdgcn_cvt_pk_fp8_f32(clamp448(z[2]), clamp448(z[3]), q, true); *(int*)(wsl + WS_HB8 + (size_t)m * DM + 4 * lane + 256 * j) = q; } }
                sx = wave_sum(sx, lane); if (lane == 0) SSQA0[m] = ssq_fix(sx); } }
        }
        for (int m = gw; m < NBATCH * NMEM; m += NGW) (void)row_to_bf16(MEM_IN + (size_t)m * DM, MEMN + (size_t)m * DM, mem_norm, true, lane);
        for (int i = bx * NTHR + tid; i < NTOK * 32; i += G * NTHR) { const int tok = i >> 5, j = i & 31;
            const float inv = powf(10000.0f, -((float)j / 32.0f)); const float ang = (float)positions[tok] * inv; COS[i] = cosf(ang); SIN[i] = sinf(ang); }
        for (int i = bx * NTHR + tid; i < 1024; i += G * NTHR) { const float l0 = hg_lb[i], l1 = hg_lb[1024 + i], mx = fmaxf(l0, l1), e0 = expf(l0 - mx), e1 = expf(l1 - mx);
            const float s0 = e0 / (e0 + e1), s1 = e1 / (e0 + e1); LB[i] = 0.f; LB[1024 + i] = fminf(fmaxf((s0 + s1) - s0, 0.f), 1.f); }
    }
    SEAM(0);

    for (int l = 0; l < 2; ++l) {
        const int pb = 1 + 8 * l;
#define ssq_attn ((l == 0) ? SSQA0 : SSQ + SSQ_A1 * NTOK)
#define ssq_cq (SSQ + (l == 0 ? SSQ_CQ0 : SSQ_CQ1) * NTOK)
#define ssq_ckv (SSQ + (l == 0 ? SSQ_CKV0 : SSQ_CKV1) * NTOK)
#define ssq_ffn (SSQ + (l == 0 ? SSQ_F0 : SSQ_F1) * NTOK)
#define lbv (LB + l * 1024)
        if (KIND(1) && IN(pb + 0)) for (int rep = 0; rep < NREP(1); ++rep) { PHASE_IDS;
            const bool deal = (G == 256);
            if (MK_GATE_F8) {
                SchedIn S{(unsigned)WS_HB, (unsigned)(WS_WIN + (size_t)l * DINP * DM * 2), (unsigned)WS_MEMN, (unsigned)(WS_WMKV + (size_t)l * 2048 * DM * 2), G, bx, deal ? 24 : 25, !deal};
                EpiIn E{wsl, l, rep == 0};
                pg8::gemm_run<EpiIn, SchedIn>(lds, tid, RSRC, DM, DM, DM, S, E);
                SchedPlain S8{(unsigned)WS_HB8, (unsigned)(WS_WIN8 + (size_t)l * 6144 * DM), 32, 24, G, bx, 256u * DM, 256u * DM};
                EpiGateLogit E8{wsl, l};
                pg8::gemm_run<EpiGateLogit, SchedPlain, true, true>(lds, tid, RSRC, DM / 2, DM / 2, DM / 2, S8, E8);
            } else {
                SchedIn S{(unsigned)WS_HB, (unsigned)(WS_WIN + (size_t)l * DINP * DM * 2), (unsigned)WS_MEMN, (unsigned)(WS_WMKV + (size_t)l * 2048 * DM * 2), G, bx, deal ? 48 : 49, !deal};
                EpiIn E{wsl, l, rep == 0};
                pg8::gemm_run<EpiIn, SchedIn>(lds, tid, RSRC, DM, DM, DM, S, E);
            }
        }
        SEAM(pb + 0);
        if (KIND(2) && IN(pb + 1)) for (int rep = 0; rep < NREP(2); ++rep) { PHASE_IDS;
            SchedUp S{(unsigned)WS_PROJ, (unsigned)(WS_WQUP + (size_t)l * 1536 * 512 * 2), (unsigned)(WS_WKVUP + (size_t)l * 2048 * 512 * 2), G, bx};
            EpiUp E{wsl, l};
            pg8::gemm_run<EpiUp, SchedUp>(lds, tid, RSRC, 512, DINP, 512, S, E);
            if (G == 256) {
                SchedIn2 S2{(unsigned)WS_HB, (unsigned)(WS_WIN + (size_t)l * DINP * DM * 2), (unsigned)WS_MEMN, (unsigned)(WS_WMKV + (size_t)l * 2048 * DM * 2), G, bx, MK_GATE_F8 ? 24 : 48};
                EpiIn E2{wsl, l, false};
                pg8::gemm_run<EpiIn, SchedIn2>(lds, tid, RSRC, DM, DM, DM, S2, E2);
                if (bx >= 192) hg::pass1_unit(lds, tid, bx - 192, ZF, PROJ, lbv, HU, HDEC);
                else for (int j = 0; j < 5; ++j) hg::pass1_unit(lds, tid, 64 + bx + 192 * j, ZF, PROJ, lbv, HU, HDEC);
            } else for (int u = (G - 1 - bx); u < 1024; u += G) hg::pass1_unit(lds, tid, u, ZF, PROJ, lbv, HU, HDEC);
        }
        SEAM(pb + 1);
        if (KIND(3) && IN(pb + 2)) for (int rep = 0; rep < NREP(3); ++rep) { PHASE_IDS;
            const float c_mla = 0.07216878364870322f * 1.4426950408889634f, c_mem = 0.0625f * 1.4426950408889634f;
            for (int vc = bx; vc < 256; vc += G) {
                int nm = 0, q_a = 0, q_b = 0, bh = 0;
                if (vc < 32) { nm = 1; bh = vc; q_a = 7; }
                else if (vc < 64) { nm = 1; bh = vc - 32; q_a = 6; }
                else if (vc < 96) { nm = 2; bh = vc - 64; q_a = 5; q_b = 1; }
                else if (vc < 128) { nm = 2; bh = vc - 96; q_a = 4; q_b = 2; }
                else if (vc < 160) { nm = 2; bh = vc - 128; q_a = 3; q_b = 0; }
#ifndef NO_MLA
                for (int k = 0; k < nm; ++k) { const int b = bh >> 3, h = bh & 7, qb = k ? q_b : q_a; const size_t t0 = (size_t)b * SEQ;
                    att::attn_unit<QKD, NOPE, true>(lds, tid, QMLA + (t0 + qb * 256) * 1536 + h * QKD, 1536, KVB + t0 * 2048 + h * 256, 2048, PROJ + t0 * DINP + PC_KR, DINP,
                                                    KVB + t0 * 2048 + h * 256 + 128, 2048, Y + (t0 + qb * 256) * 3072 + 1024 + h * 128, 3072, 4 * (qb + 1), qb * 256, c_mla); }
#endif
            }
            { int tid2 = tid; asm volatile("" : "+v"(tid2));
            for (int vc = bx; vc < 256; vc += G) {
                int nx = 0, x_a = 0, x_b = 0;
                if (vc >= 32 && vc < 64) { nx = 1; x_a = vc - 32; }
                else if (vc >= 128 && vc < 160) { nx = 2; x_a = 32 + 2 * (vc - 128); x_b = x_a + 1; }
                else if (vc >= 160) { const int j = vc - 160; nx = (j < 64) ? 2 : 1; x_a = 96 + j; x_b = 192 + j; }
#ifndef NO_MEM
                for (int k = 0; k < nx; ++k) { const int uu = k ? x_b : x_a, half = uu & 1, qb = (uu >> 1) & 7, bh = uu >> 4, b = bh >> 2, h = bh & 3; const size_t t0 = (size_t)b * SEQ;
                    att::attn_unit<MEMD, MEMD, false>(lds, tid2, PROJ + (t0 + qb * 256) * DINP + PC_QM + h * 256, DINP, MKV + (size_t)b * 256 * 2048 + h * 256, 2048, nullptr, 0,
                                                      MKV + (size_t)b * 256 * 2048 + 1024 + h * 256 + half * 128, 2048, Y + (t0 + qb * 256) * 3072 + 2048 + h * 256 + half * 128, 3072, 4, 0, c_mem); }
#endif
            } }
#ifndef NO_P2
            if (rep == 0) { int tid3 = tid; asm volatile("" : "+v"(tid3));
            for (int vc = bx; vc < 256; vc += G) if (vc >= 160) { for (int task = (vc - 160) * NTHR + tid3; task < 32 * 4096; task += 96 * NTHR) hg::pass2_task(task, HU, HDEC, (bf16*)(wsl + WS_HS)); } }
#endif
        }
        SEAM(pb + 2);
        if (KIND(4) && IN(pb + 3)) { PHASE_IDS; const int NU = 1024 * NREP(4);
            hg::P3In ra; int u = bx;
            hg::pass3_load(ra, tid, u & 1023, ZF, PROJ, lbv, (const bf16*)(wsl + WS_HS));
            for (; u < NU; u += G) { int tid_u = tid; asm volatile("" : "+v"(tid_u));
                hg::pass3_compute(lds, tid_u, u & 1023, ra, (u + G < NU) ? ((u + G) & 1023) : -1, ZF, PROJ, lbv, (const bf16*)(wsl + WS_HS), hg_norm + l * 128, Y); } }
        SEAM(pb + 3);
        if (KIND(5) && IN(pb + 4)) for (int rep = 0; rep < NREP(5); ++rep) { PHASE_IDS;
            SchedGate S{(unsigned)WS_Y, (unsigned)(WS_WBR + (size_t)l * 3 * 2048 * 1024 * 2), G, bx};
            EpiGate E{wsl};
            pg8::gemm_run<EpiGate, SchedGate>(lds, tid, RSRC, 1024, 3072, 1024, S, E);
        }
        SEAM(pb + 4);
        if (KIND(6) && IN(pb + 5)) { PHASE_IDS;
            SchedPlain S{(unsigned)WS_MRGB, (unsigned)(WS_WO + (size_t)l * DM * DM * 2), 32, 8, G, bx, 256u * DM * 2u, 256u * DM * 2u};
            EpiRes E{wsl, l == 0 ? SSQ_F0 : SSQ_F1, false};
            pg8::gemm_run<EpiRes, SchedPlain>(lds, tid, RSRC, DM, DM, DM, S, E);
        }
        SEAM(pb + 5);
        if (l == 0) {
            if (KIND(7) && IN(7)) for (int rep = 0; rep < NREP(7); ++rep) { PHASE_IDS;
                SchedPlain S{(unsigned)WS_HB, (unsigned)WS_WGU, 32, 44, G, bx, 256u * DM * 2u, 256u * DM * 2u};
                EpiSwiglu<true> E{wsl, (unsigned)WS_ACT, FF, SSQ_F0};
                if (MK_PROBE_MODE == 8 && rep == 0) { EpiSwiglu<false> EN{wsl, (unsigned)WS_ACT, FF, SSQ_F0}; pg8::gemm_run<EpiSwiglu<false>, SchedPlain, true, false, 0>(lds, tid, RSRC, 128, DM, DM, S, EN); }
                else if (MK_PROBE_MODE == 9 && rep == 0) { EpiSwiglu<true> EN{wsl, 1u, FF, SSQ_F0}; pg8::gemm_run<EpiSwiglu<true>, SchedPlain, true, false, 0>(lds, tid, RSRC, 128, DM, DM, S, EN); }
                else if (MK_PROBE_MODE == 6 && rep == 0) { EpiNull EN{wsl}; pg8::gemm_run<EpiNull, SchedPlain, true, false, 0>(lds, tid, RSRC, 128, DM, DM, S, EN); }
                else if (MK_PROBE_MODE == 7 && rep == 0) { EpiNull EN{wsl}; pg8::gemm_run<EpiNull, SchedPlain, true, false, 0>(lds, tid, RSRC, DM, DM, DM, S, EN); }
                else if (MK_PROBE_MODE == 5 && rep == 0) pg8::gemm_run<EpiSwiglu<true>, SchedPlain, true, false, 0>(lds, tid, RSRC, 128, DM, DM, S, E);
                else if (MK_PROBE_MODE > 0 && MK_PROBE_MODE < 5 && rep == 0) pg8::gemm_run<EpiSwiglu<true>, SchedPlain, true, false, MK_PROBE_MODE % 5>(lds, tid, RSRC, DM, DM, DM, S, E);
                else pg8::gemm_run<EpiSwiglu<true>, SchedPlain>(lds, tid, RSRC, DM, DM, DM, S, E);
            }
            SEAM(7);
            if (KIND(8) && IN(8)) { PHASE_IDS;
                SchedPlain S{(unsigned)WS_ACT, (unsigned)WS_WDN, 32, 8, G, bx, 256u * FF * 2u, 256u * FF * 2u};
                EpiRes E{wsl, SSQ_A1, MK_GATE_F8 != 0};
                pg8::gemm_run<EpiRes, SchedPlain>(lds, tid, RSRC, FF, FF, FF, S, E);
#if MK_PROBE_MFMA
                { f32x4 pa[16]; bf16x8 px, py;
#pragma unroll
                  for (int j = 0; j < 8; ++j) { px[j] = (__bf16)(float)(tid + j); py[j] = (__bf16)(float)(tid - j); }
#pragma unroll
                  for (int j = 0; j < 16; ++j) pa[j] = (f32x4){0.f, 0.f, 0.f, 0.f};
                  for (int it = 0; it < 352; ++it) {
#pragma unroll
                      for (int j = 0; j < 16; ++j) pa[j] = __builtin_amdgcn_mfma_f32_16x16x32_bf16(px, py, pa[j], 0, 0, 0);
                  }
#pragma unroll
                  for (int j = 0; j < 16; ++j) asm volatile("" :: "v"(pa[j]));
                }
#endif
            }
            SEAM(8);
        }
    }
    if (KIND(15) && IN(15)) for (int rep = 0; rep < NREP(15); ++rep) { PHASE_IDS;
        LAS float* wr = (LAS float*)lds;
        LAS int* lcnt = (LAS int*)(lds + 65536);
        const u64* ssq = SSQ + SSQ_F1 * NTOK;
        for (int i = tid; i < DM * 8; i += NTHR) wr[i] = w_router[i] * ffn_norm[DM + (i >> 3)];
        for (int vc = bx; vc < 256; vc += G) {
            if (tid < 8) lcnt[tid] = 0;
            __syncthreads();
            u32x2 hrow[4][8]; float rsq[4];
#pragma unroll
            for (int q = 0; q < 4; ++q) { const int t = vc * 32 + wave * 4 + q;
#pragma unroll
                for (int j = 0; j < 8; ++j) hrow[q][j] = *(const u32x2*)(HB + (size_t)t * DM + 4 * lane + 256 * j); }
#pragma unroll
            for (int q = 0; q < 4; ++q) rsq[q] = row_rstd(ssq, vc * 32 + wave * 4 + q, 1.0f / DM);
#pragma unroll
            for (int q = 0; q < 4; ++q) {
                const int t = vc * 32 + wave * 4 + q;
                float a[8] = {0.f, 0.f, 0.f, 0.f, 0.f, 0.f, 0.f, 0.f};
#pragma unroll
                for (int j = 0; j < 8; ++j) { const int k = 4 * lane + 256 * j; const u32x2 hw = hrow[q][j]; const f32x4 hv = (f32x4){bflo(hw.x), bfhi(hw.x), bflo(hw.y), bfhi(hw.y)};
#pragma unroll
                    for (int kk = 0; kk < 4; ++kk) { const f32x4 w0 = *(const LAS f32x4*)(wr + (k + kk) * 8), w1 = *(const LAS f32x4*)(wr + (k + kk) * 8 + 4);
                        a[0] += hv[kk] * w0[0]; a[1] += hv[kk] * w0[1]; a[2] += hv[kk] * w0[2]; a[3] += hv[kk] * w0[3];
                        a[4] += hv[kk] * w1[0]; a[5] += hv[kk] * w1[1]; a[6] += hv[kk] * w1[2]; a[7] += hv[kk] * w1[3]; } }
                const float rs = rsq[q];
#pragma unroll
                for (int e = 0; e < 8; ++e) a[e] = wave_sum(a[e], lane) * rs;
                int i0 = 0; float l0 = a[0];
#pragma unroll
                for (int e = 1; e < 8; ++e) if (a[e] > l0) { l0 = a[e]; i0 = e; }
                int i1 = -1; float l1 = -3.0e38f;
#pragma unroll
                for (int e = 0; e < 8; ++e) if (e != i0 && a[e] > l1) { l1 = a[e]; i1 = e; }
                if (lane == 0) { const float ex = expf(l1 - l0), w0 = 1.0f / (1.0f + ex); TOPI[2 * t] = i0; TOPI[2 * t + 1] = i1; TOPW[2 * t] = w0; TOPW[2 * t + 1] = ex * w0;
                    __hip_atomic_fetch_add(&lcnt[i0], 1, __ATOMIC_RELAXED, __HIP_MEMORY_SCOPE_WORKGROUP); __hip_atomic_fetch_add(&lcnt[i1], 1, __ATOMIC_RELAXED, __HIP_MEMORY_SCOPE_WORKGROUP); }
            }
            __syncthreads();
            if (tid < 8) BLKCNT[vc * 8 + tid] = lcnt[tid];
            __syncthreads();
        }
    }
    SEAM(15);
    if (KIND(16) && IN(16)) for (int rep = 0; rep < NREP(16); ++rep) { PHASE_IDS;
        LAS int* bc = (LAS int*)lds;
        LAS int* pst = (LAS int*)(lds + 8192);
        LAS int* posl = (LAS int*)(lds + 8192 + 256);
        const u64* ssq = SSQ + SSQ_F1 * NTOK;
        for (int i = tid; i < 2048; i += NTHR) bc[i] = BLKCNT[i];
        __syncthreads();
        for (int vc = bx; vc < 256; vc += G) {
            {
                const int e = wave; int part = 0, mine = 0;
#pragma unroll
                for (int q = 0; q < 4; ++q) { const int i = 4 * lane + q, v = bc[i * 8 + e]; part += v; if (i < vc) mine += v; }
                float tf = wave_sum((float)part, lane), mf = wave_sum((float)mine, lane);
                if (lane == 0) { pst[8 + e] = (int)tf; pst[16 + e] = (int)mf; }
            }
            __syncthreads();
            if (tid == 0) { int s = 0; for (int e = 0; e < 8; ++e) { pst[e] = s; s += (pst[8 + e] + 255) / 256 * 256; }
                if (vc == 0) { int rt = 0; for (int e = 0; e < 8; ++e) { const int n = (pst[8 + e] + 255) / 256; for (int k = 0; k < n; ++k) TEXP[rt++] = e; } TEXP[100] = rt; } }
            __syncthreads();
            if (wave == 0) {
                const int t = vc * 32 + (lane >> 1), e = TOPI[2 * t + (lane & 1)];
                int rank = 0;
#pragma unroll
                for (int ee = 0; ee < 8; ++ee) { const unsigned long long mk = __ballot(e == ee); if (e == ee) rank = __popcll(mk & ((1ull << lane) - 1ull)); }
                const int pos = pst[e] + pst[16 + e] + rank;
                posl[lane] = pos; *(u32x2*)(RASS + 2 * pos) = (u32x2){(unsigned)(2 * t + (lane & 1)), __float_as_uint(TOPW[2 * t + (lane & 1)])}; ((int*)(wsl + WS_POS))[2 * t + (lane & 1)] = pos;
            }
            if (vc < 8 && wave == 1) { const int e = vc, s = pst[e] + pst[8 + e], en = pst[e] + (pst[8 + e] + 255) / 256 * 256; for (int p = s + lane; p < en; p += 64) *(u32x2*)(RASS + 2 * p) = (u32x2){0xffffffffu, 0u}; }
            if (vc < 8 && wave >= 2) { const int e = vc, s = pst[e] + pst[8 + e], en = pst[e] + (pst[8 + e] + 255) / 256 * 256;
                for (int p = s + (wave - 2); p < en; p += 6) for (int j = 0; j < 8; ++j) { if (MK_MOE_F8) *(int*)((unsigned char*)XS + (size_t)p * DM + 4 * lane + 256 * j) = 0; else *(u32x2*)(XS + (size_t)p * DM + 4 * lane + 256 * j) = (u32x2){0u, 0u}; } }
            __syncthreads();
            {
                u32x2 hv[4][8]; float rsv[4];
#pragma unroll
                for (int i4 = 0; i4 < 4; ++i4) { const int t = vc * 32 + wave * 4 + i4;
#pragma unroll
                    for (int j = 0; j < 8; ++j) hv[i4][j] = *(const u32x2*)(HB + (size_t)t * DM + 4 * lane + 256 * j); }
#pragma unroll
                for (int i4 = 0; i4 < 4; ++i4) rsv[i4] = row_rstd(ssq, vc * 32 + wave * 4 + i4, 1.0f / DM);
#pragma unroll
                for (int i4 = 0; i4 < 4; ++i4) { const int p0 = posl[wave * 8 + 2 * i4], p1 = posl[wave * 8 + 2 * i4 + 1]; const float rs = rsv[i4];
#pragma unroll
                    for (int j = 0; j < 8; ++j) { const u32x2 hw = hv[i4][j]; const f32x4 v = (f32x4){bflo(hw.x), bfhi(hw.x), bflo(hw.y), bfhi(hw.y)} * rs;
                        if (MK_MOE_F8) { const f32x4 w = v * F8_XS; int q = 0; q = __builtin_amdgcn_cvt_pk_fp8_f32(clamp448(w[0]), clamp448(w[1]), q, false); q = __builtin_amdgcn_cvt_pk_fp8_f32(clamp448(w[2]), clamp448(w[3]), q, true);
                            *(int*)((unsigned char*)XS + (size_t)p0 * DM + 4 * lane + 256 * j) = q; *(int*)((unsigned char*)XS + (size_t)p1 * DM + 4 * lane + 256 * j) = q; }
                        else { u32x2 o; o.x = cvt_pk_bf16(v[0], v[1]); o.y = cvt_pk_bf16(v[2], v[3]); *(u32x2*)(XS + (size_t)p0 * DM + 4 * lane + 256 * j) = o; *(u32x2*)(XS + (size_t)p1 * DM + 4 * lane + 256 * j) = o; } } }
            }
            __syncthreads();
        }
    }
    SEAM(16);
    if (KIND(17) && IN(17)) for (int rep = 0; rep < NREP(17); ++rep) { PHASE_IDS;
        const int nrt = __builtin_amdgcn_readfirstlane(__hip_atomic_load(TEXP + 100, __ATOMIC_RELAXED, __HIP_MEMORY_SCOPE_AGENT));
        if (MK_MOE_F8) {
            SchedMoe S{(unsigned)WS_XS, (unsigned)WS_WEGU, wsl, nrt, 56, G, bx, 256u * DM, 256u * DM, 2u * FFE * DM};
            EpiSwigluF8 E{wsl};
            pg8::gemm_run<EpiSwigluF8, SchedMoe, true, true>(lds, tid, RSRC, DM / 2, DM / 2, DM / 2, S, E);
        } else {
            SchedMoe S{(unsigned)WS_XS, (unsigned)WS_WEGU, wsl, nrt, 56, G, bx, 256u * DM * 2u, 256u * DM * 2u, 2u * FFE * DM * 2u};
            EpiSwiglu<false> E{wsl, (unsigned)WS_ACTE, FFE, 0};
            pg8::gemm_run<EpiSwiglu<false>, SchedMoe>(lds, tid, RSRC, DM, DM, DM, S, E);
        }
    }
    SEAM(17);
    if (KIND(18) && IN(18)) for (int rep = 0; rep < NREP(18); ++rep) { PHASE_IDS;
        const int nrt = __builtin_amdgcn_readfirstlane(__hip_atomic_load(TEXP + 100, __ATOMIC_RELAXED, __HIP_MEMORY_SCOPE_AGENT));
        if (MK_MOE_F8) {
            SchedMoe S{(unsigned)WS_ACTE, (unsigned)WS_WEDN, wsl, 64, 8, G, bx, 256u * FFE, 256u * FFE, (unsigned)DM * FFE};
            EpiMoeDown E{wsl, 1.0f / (F8_ACT * F8_WDN)};
            pg8::gemm_run<EpiMoeDown, SchedMoe, true, true>(lds, tid, RSRC, FFE / 2, FFE / 2, FFE / 2, S, E);
            SchedMoeTail ST{(unsigned)WS_ACTE, (unsigned)WS_WEDN, wsl, nrt, G, bx, 256u * FFE, 256u * FFE, (unsigned)DM * FFE, (unsigned)FFE / 4};
            const int tid_t = wave0 * 64 + lane_id();
            pg8::gemm_run<EpiMoeDown, SchedMoeTail, true, true>(lds, tid_t, RSRC, FFE / 8, FFE / 2, FFE / 2, ST, E);
        } else {
            SchedMoe S{(unsigned)WS_ACTE, (unsigned)WS_WEDN, wsl, nrt, 8, G, bx, 256u * FFE * 2u, 256u * FFE * 2u, (unsigned)DM * FFE * 2u};
            EpiMoeDown E{wsl, 1.0f};
            pg8::gemm_run<EpiMoeDown, SchedMoe>(lds, tid, RSRC, FFE, FFE, FFE, S, E);
        }
    }
    SEAM(18);
    if (IN(PH_FINAL)) { PHASE_IDS;
        const int gw = bx * NWAVES + wave, NGW = G * NWAVES;
        const bool have_moe = (MK_LAST_PHASE >= 18), have_h = (MK_LAST_PHASE >= 6); float* out_p = (float*)*(GAS float* const CAS*)(kargs + 176);
        for (int m0 = gw; m0 < NTOK; m0 += 2 * NGW) {
            int pos[2][2];
#pragma unroll
            for (int r = 0; r < 2; ++r) { const int m = m0 + r * NGW;
#pragma unroll
                for (int kk = 0; kk < 2; ++kk) pos[r][kk] = (have_moe && m < NTOK) ? __hip_atomic_load((const int*)(wsl + WS_POS) + 2 * m + kk, __ATOMIC_RELAXED, __HIP_MEMORY_SCOPE_AGENT) : 0; }
#pragma unroll
            for (int r = 0; r < 2; ++r)
#pragma unroll
                for (int kk = 0; kk < 2; ++kk) pos[r][kk] = __builtin_amdgcn_readfirstlane(pos[r][kk]);
            u32x2 hbv[2][8], yv[2][2][8];
#pragma unroll
            for (int r = 0; r < 2; ++r) { const int m = m0 + r * NGW; if (m < NTOK) {
#pragma unroll
                for (int j = 0; j < 8; ++j) { const int k = 4 * lane + 256 * j; hbv[r][j] = *(const u32x2*)(HB + (size_t)m * DM + k);
#pragma unroll
                    for (int kk = 0; kk < 2; ++kk) { const bool tl = MK_MOE_F8 && pos[r][kk] >= 64 * 256;
                        const bf16* yp = tl ? (const bf16*)(wsl + WS_YSQ) + (size_t)(pos[r][kk] - 64 * 256) * DM : (const bf16*)YS + (size_t)(2 * m + kk) * DM;
                        yv[r][kk][j] = have_moe ? *(const u32x2*)(yp + k) : (u32x2){0u, 0u}; } } } }
#pragma unroll
            for (int r = 0; r < 2; ++r) { const int m = m0 + r * NGW; if (m < NTOK) {
                f32x4 v[8]; float sx = 0.f;
#pragma unroll
                for (int j = 0; j < 8; ++j) { const int k = 4 * lane + 256 * j; const u32x2 hw = hbv[r][j];
                    v[j] = have_h ? (f32x4){bflo(hw.x), bfhi(hw.x), bflo(hw.y), bfhi(hw.y)} : *(const f32x4*)(X_IN + (size_t)m * DM + k);
#pragma unroll
                    for (int kk = 0; kk < 2; ++kk) { const u32x2 ya = yv[r][kk][j]; v[j][0] += bflo(ya.x); v[j][1] += bfhi(ya.x); v[j][2] += bflo(ya.y); v[j][3] += bfhi(ya.y);
                        if (MK_MOE_F8 && have_moe && pos[r][kk] >= 64 * 256) {
#pragma unroll
                            for (int q = 1; q < 4; ++q) { const u32x2 yb = *(const u32x2*)((const bf16*)(wsl + WS_YSQ) + ((size_t)q * 2048 + (pos[r][kk] - 64 * 256)) * DM + k);
                                v[j][0] += bflo(yb.x); v[j][1] += bfhi(yb.x); v[j][2] += bflo(yb.y); v[j][3] += bfhi(yb.y); } } }
                    sx += (v[j][0] * v[j][0] + v[j][1] * v[j][1]) + (v[j][2] * v[j][2] + v[j][3] * v[j][3]); }
                const float rs = rsqrtf(wave_sum(sx, lane) * (1.0f / DM) + EPS);
#pragma unroll
                for (int j = 0; j < 8; ++j) { const int k = 4 * lane + 256 * j; *(f32x4*)(out_p + (size_t)m * DM + k) = v[j] * rs * *(const f32x4*)(final_norm + k); }
            } }
        }
    }
#undef IN
#undef SEAM
}

extern "C" void kernel_launch(void* const* d_in, const int* in_sizes, int n_in, void* d_out, int out_size, void* d_ws, size_t ws_size, hipStream_t stream) {
    static int grid = 0;
    if (grid == 0) {
        if (n_in != 22 || out_size != NTOK * DM || ws_size < WS_END) { fprintf(stderr, "kernel_launch: unexpected shapes (n_in %d, out %d, ws %zu < %zu); nothing launched\n", n_in, out_size, ws_size, (size_t)WS_END); grid = -1; return; }
        int dev = 0, cus = 0, per_cu = 0;
        if (hipGetDevice(&dev) != hipSuccess || hipDeviceGetAttribute(&cus, hipDeviceAttributeMultiprocessorCount, dev) != hipSuccess) { grid = -1; return; }
        if (hipFuncSetAttribute((const void*)trunk_fwd, hipFuncAttributeMaxDynamicSharedMemorySize, LDS_BYTES) != hipSuccess) { fprintf(stderr, "kernel_launch: hipFuncSetAttribute failed\n"); grid = -1; return; }
        if (hipOccupancyMaxActiveBlocksPerMultiprocessor(&per_cu, (const void*)trunk_fwd, NTHR, LDS_BYTES) != hipSuccess || per_cu < 1) fprintf(stderr, "kernel_launch: occupancy query reports %d\n", per_cu);
        (void)hipGetLastError();
        grid = cus;
    }
    if (grid < 0) return;
    (void)hipMemsetAsync((char*)d_ws + WS_CTL, 0, CTL_BYTES, stream);
    Args a{};
    for (int i = 0; i < 22; ++i) a.in[i] = d_in[i];
    a.out = (float*)d_out; a.ws = (unsigned char*)d_ws;
    if (MK_N_LAUNCHES == 1) { a.ph_lo = 0; a.ph_hi = N_PHASES; hipLaunchKernelGGL(trunk_fwd, dim3(grid), dim3(NTHR), LDS_BYTES, stream, a); }
    else { for (int p = 0; p < N_PHASES; ++p) { if (p > MK_LAST_PHASE && p != PH_FINAL) continue; a.ph_lo = p; a.ph_hi = p + 1; hipLaunchKernelGGL(trunk_fwd, dim3(grid), dim3(NTHR), LDS_BYTES, stream, a); } }
    const hipError_t le = hipPeekAtLastError();
    if (le != hipSuccess) fprintf(stderr, "kernel_launch: launch failed: %s\n", hipGetErrorName(le));
}
```

```cpp
#include <hip/hip_runtime.h>
#ifndef MK_PROBE_MODE
#define MK_PROBE_MODE -1
#endif
#include <cstdio>
#include <cstdint>
#include <cstddef>

#ifndef MK_N_LAUNCHES
#define MK_N_LAUNCHES 1
#endif
#ifndef MK_MOE_F8
#define MK_MOE_F8 1
#endif
#ifndef MK_GATE_F8
#define MK_GATE_F8 1
#endif
#ifndef MK_LAST_PHASE
#define MK_LAST_PHASE 99
#endif
#ifndef MK_P7_F8
#define MK_P7_F8 0
#endif
#ifndef MK_P8_F8
#define MK_P8_F8 1
#endif

#define GAS __attribute__((address_space(1)))
#define LAS __attribute__((address_space(3)))
#define CAS __attribute__((address_space(4)))
#ifndef HG_SIGMOID
#define HG_SIGMOID fast_sigmoid
#endif
#ifndef EPI_SIGMOID
#define EPI_SIGMOID fast_sigmoid
#endif
typedef unsigned short bf16;
typedef short bf16x8 __attribute__((ext_vector_type(8)));
typedef short s16x4 __attribute__((ext_vector_type(4)));
typedef float f32x2 __attribute__((ext_vector_type(2)));
typedef float f32x4 __attribute__((ext_vector_type(4)));
typedef float f32x16 __attribute__((ext_vector_type(16)));
typedef unsigned u32x2 __attribute__((ext_vector_type(2)));
typedef unsigned u32x4 __attribute__((ext_vector_type(4)));

constexpr int DM = 2048, NBATCH = 4, SEQ = 2048, NTOK = NBATCH * SEQ, NMEM = 256;
constexpr int HGH = 8, HGD = 128, CHUNK = 64, NCHUNK = SEQ / CHUNK;
constexpr int MLAH = 8, QRANK = 512, KVRANK = 512, NOPE = 128, ROPE = 64, QKD = NOPE + ROPE, MLAV = 128;
constexpr int MEMH = 4, MEMD = 256;
constexpr int DIN = 12352, DINP = 12544;
constexpr int FF = 5632, NEXP = 8, FFE = 7168;
constexpr float EPS = 1e-6f;
constexpr int PC_Q = 0, PC_F = 1024, PC_I = 2048, PC_G = 3072, PC_CQ = 4096, PC_CKV = 4608, PC_KR = 5120, PC_QM = 5376, PC_GATE = 6400;
constexpr int MAXRT = 72;

constexpr size_t MiB = 1u << 20;
constexpr size_t WS_CTL = 0, CTL_BYTES = 1 * MiB;
constexpr int CW_BAR = 4096;
constexpr size_t CB_SSQ = 65536;
constexpr int SSQ_F0 = 0, SSQ_A1 = 1, SSQ_F1 = 2, SSQ_CQ0 = 3, SSQ_CKV0 = 4, SSQ_CQ1 = 5, SSQ_CKV1 = 6;
constexpr size_t CB_BLKCNT = 65536 + 7 * 65536;
constexpr size_t W0 = 1 * MiB;
constexpr size_t WS_WIN = W0;
constexpr size_t WS_WMKV = WS_WIN + 2ull * DINP * 2048 * 2;
constexpr size_t WS_WQUP = WS_WMKV + 2ull * 2048 * 2048 * 2;
constexpr size_t WS_WKVUP = WS_WQUP + 2ull * 1536 * 512 * 2;
constexpr size_t WS_WBR = WS_WKVUP + 2ull * 2048 * 512 * 2;
constexpr size_t WS_WO = WS_WBR + 6ull * 2048 * 1024 * 2;
constexpr size_t WS_WGU = WS_WO + 2ull * 2048 * 2048 * 2;
constexpr size_t WS_WDN = WS_WGU + 11264ull * 2048 * 2;
constexpr size_t WS_WEGU = WS_WDN + 2048ull * 5632 * 2;
constexpr size_t WS_WEDN = WS_WEGU + 8ull * 14336 * 2048 * 2;
constexpr size_t WS_WEND = WS_WEDN + 8ull * 2048 * 7168 * 2;
constexpr size_t A0 = (WS_WEND + MiB - 1) / MiB * MiB;
constexpr size_t WS_H = A0;
constexpr size_t WS_HB = WS_H + (size_t)NTOK * DM * 4;
constexpr size_t WS_PROJ = WS_HB + (size_t)NTOK * DM * 2;
constexpr size_t WS_ZF = WS_PROJ + (size_t)NTOK * DINP * 2;
constexpr size_t WS_MEMN = WS_ZF + (size_t)NTOK * 1024 * 4;
constexpr size_t WS_MKV = WS_MEMN + 1024ull * 2048 * 2;
constexpr size_t WS_QMLA = WS_MKV + 1024ull * 2048 * 2;
constexpr size_t WS_KVB = WS_QMLA + (size_t)NTOK * 1536 * 2;
constexpr size_t WS_Y = WS_KVB + (size_t)NTOK * 2048 * 2;
constexpr size_t WS_HU = WS_Y + (size_t)NTOK * 3072 * 2;
constexpr size_t WS_HDEC = WS_HU + 1024ull * 128 * 128 * 4;
constexpr size_t WS_MRG = WS_HDEC + 1024ull * 128 * 4;
constexpr size_t WS_MRGB = WS_MRG + (size_t)NTOK * DM * 4;
constexpr size_t WS_ACT = WS_MRGB + (size_t)NTOK * DM * 2;
constexpr size_t WS_XS = WS_ACT + (size_t)NTOK * FF * 2;
constexpr size_t WS_ACTE = WS_XS + (size_t)MAXRT * 256 * DM * 2;
constexpr size_t WS_YS = WS_ACTE + (size_t)MAXRT * 256 * FFE * 2;
constexpr size_t WS_COS = WS_YS + 2ull * NTOK * DM * 4;
constexpr size_t WS_SIN = WS_COS + (size_t)NTOK * 32 * 4;
constexpr size_t WS_LB = WS_SIN + (size_t)NTOK * 32 * 4;
constexpr size_t WS_SSQA0 = WS_LB + 2 * 1024 * 4;
constexpr size_t WS_TOPI = WS_SSQA0 + (size_t)NTOK * 8;
constexpr size_t WS_TOPW = WS_TOPI + (size_t)NTOK * 8;
constexpr size_t WS_RASS = WS_TOPW + (size_t)NTOK * 8;
constexpr size_t WS_TEXP = WS_RASS + (size_t)MAXRT * 256 * 8;
constexpr size_t WS_POS = WS_TEXP + 512;
constexpr size_t WS_YSQ = WS_POS + 2ull * NTOK * 4;
constexpr size_t WS_HS = WS_YSQ + 4ull * 2048 * DM * 2;
constexpr size_t WS_HB8 = WS_HS + 1024ull * 128 * 128 * 2;
constexpr size_t WS_WIN8 = WS_HB8 + (size_t)NTOK * DM;
constexpr size_t WS_END = WS_WIN8 + 2ull * 6144 * DM;

constexpr int RING_BYTES = 131072;
constexpr int MISC_OFF = RING_BYTES;
constexpr int LDS_BYTES = 163840;
constexpr int NWAVES = 8, NTHR = 512;

#define RLX_AGENT __ATOMIC_RELAXED, __HIP_MEMORY_SCOPE_AGENT
#define LDS_WAIT() asm volatile("s_waitcnt lgkmcnt(0)" ::: "memory")
#define VM_WAIT() asm volatile("s_waitcnt vmcnt(0)" ::: "memory")
#define SBAR() __builtin_amdgcn_sched_barrier(0)
__device__ __forceinline__ unsigned cvt_pk_bf16(float lo, float hi) { unsigned r; asm volatile("s_nop 0\n\tv_cvt_pk_bf16_f32 %0, %1, %2" : "=v"(r) : "v"(lo), "v"(hi)); return r; }
__device__ __forceinline__ bf16 f2bf(float f) { return (bf16)(cvt_pk_bf16(f, 0.f) & 0xffffu); }
__device__ __forceinline__ float bf2f(bf16 b) { return __uint_as_float(((unsigned)b) << 16); }
__device__ __forceinline__ float bflo(unsigned w) { return __uint_as_float(w << 16); }
__device__ __forceinline__ float bfhi(unsigned w) { return __uint_as_float(w & 0xffff0000u); }
__device__ __forceinline__ f32x4 ld4h(const bf16* p) { const u32x2 w = *(const u32x2*)p; return (f32x4){bflo(w.x), bfhi(w.x), bflo(w.y), bfhi(w.y)}; }
__device__ __forceinline__ float fast_sigmoid(float x) { return __builtin_amdgcn_rcpf(1.0f + __builtin_amdgcn_exp2f(x * -1.4426950408889634f)); }
__device__ __forceinline__ float ieee_sigmoid(float x) { return 1.0f / (1.0f + __expf(-x)); }
__device__ __forceinline__ int lane_id() { int r; asm volatile("v_mbcnt_lo_u32_b32 %0, -1, 0\n\tv_mbcnt_hi_u32_b32 %0, -1, %0" : "=v"(r)); return r; }
__device__ __forceinline__ float shflx(float v, int mask, int lane) { return __int_as_float(__builtin_amdgcn_ds_bpermute((lane ^ mask) << 2, __float_as_int(v))); }
__device__ __forceinline__ float wave_sum(float v, int lane) {
#pragma unroll
    for (int o = 1; o < 64; o <<= 1) v += shflx(v, o, lane);
    return v;
}
constexpr float F8_XS = 32.0f, F8_WGU = 1024.0f, F8_ACT = 8.0f, F8_WDN = 2048.0f, F8_H = 32.0f, F8_WIN = 1024.0f;
typedef int i32x8 __attribute__((ext_vector_type(8)));
__device__ __forceinline__ float clamp448(float v) { return fminf(fmaxf(v, -448.0f), 448.0f); }
__device__ __forceinline__ u32x2 pack8_f8(const f32x4& a, const f32x4& b) {
    int w0 = 0, w1 = 0;
    w0 = __builtin_amdgcn_cvt_pk_fp8_f32(clamp448(a[0]), clamp448(a[1]), w0, false); w0 = __builtin_amdgcn_cvt_pk_fp8_f32(clamp448(a[2]), clamp448(a[3]), w0, true);
    w1 = __builtin_amdgcn_cvt_pk_fp8_f32(clamp448(b[0]), clamp448(b[1]), w1, false); w1 = __builtin_amdgcn_cvt_pk_fp8_f32(clamp448(b[2]), clamp448(b[3]), w1, true);
    u32x2 r; r.x = (unsigned)w0; r.y = (unsigned)w1; return r;
}
__device__ __forceinline__ u32x4 pack8(const f32x4& a, const f32x4& b) {
    u32x4 w; w.x = cvt_pk_bf16(a[0], a[1]); w.y = cvt_pk_bf16(a[2], a[3]); w.z = cvt_pk_bf16(b[0], b[1]); w.w = cvt_pk_bf16(b[2], b[3]); return w;
}

#define XB_TMO      128
#define XB_XCNT(j)  (256  + 64 * (j))
#define XB_XSUB(j)  (1280 + 64 * (j))
#define XB_XGEN(j)  (2304 + 64 * (j))
#define XB_TOP      3328
#define XB_TOPGEN   3392
#define XCD_BAR_WORDS 3456
#define XB_SPIN_CAP (1u << 18)
__device__ __forceinline__ unsigned xb_ld(unsigned* p)              { return __hip_atomic_load(p, __ATOMIC_RELAXED, __HIP_MEMORY_SCOPE_AGENT); }
__device__ __forceinline__ unsigned xb_add(unsigned* p, unsigned v) { return __hip_atomic_fetch_add(p, v, __ATOMIC_RELAXED, __HIP_MEMORY_SCOPE_AGENT); }
__device__ __forceinline__ unsigned xb_xcc_id() { return (unsigned)__builtin_amdgcn_s_getreg((3 << 11) | 20) & 0xFu; }
#define XB_SPIN(cond, bar) do { unsigned _sp = 0; while (cond) { __builtin_amdgcn_s_sleep(1); \
    if ((++_sp & 255u) == 0u) { if (xb_ld(&(bar)[XB_TMO])) break; if (_sp > XB_SPIN_CAP) { atomicAdd(&(bar)[XB_TMO], 1u); break; } } } } while (0)
struct XcdBarrier { unsigned* bar; unsigned x; volatile LAS unsigned* st; unsigned nloc, nx; };
__device__ __forceinline__ XcdBarrier xcd_barrier_post(unsigned* bar, volatile LAS unsigned* st, int tid) {
    XcdBarrier b; b.bar = bar; b.x = xb_xcc_id(); b.st = st; b.nloc = 0u; b.nx = 0u;
    if (tid == 0) (void)xb_add(&bar[XB_XCNT(b.x)], 1u);
    return b;
}
__device__ __forceinline__ void xcd_barrier_complete(unsigned* bar, unsigned x, unsigned& nloc, unsigned& nx) {
    const unsigned G = gridDim.x * gridDim.y * gridDim.z;
    unsigned sum, cnt, mine, sp = 0u;
    for (;;) {
        sum = 0u; cnt = 0u; mine = 0u;
#pragma unroll
        for (unsigned j = 0; j < 16; ++j) { const unsigned c = xb_ld(&bar[XB_XCNT(j)]); sum += c; cnt += (c > 0u) ? 1u : 0u; mine = (j == x) ? c : mine; }
        if (sum == G) break;
        __builtin_amdgcn_s_sleep(1);
        if ((++sp & 255u) == 0u) { if (xb_ld(&bar[XB_TMO])) break; if (sp > XB_SPIN_CAP) { atomicAdd(&bar[XB_TMO], 1u); break; } }
    }
    nloc = mine > 0u ? mine : 1u; nx = cnt > 0u ? cnt : 1u;
}
__device__ __forceinline__ void xcd_barrier(XcdBarrier& b, int tid) {
    asm volatile("s_waitcnt vmcnt(0)" ::: "memory");
    __syncthreads();
    unsigned nloc_new = b.nloc, nx_new = b.nx;
    if (tid == 0) {
        unsigned* bar = b.bar; unsigned bxx = b.x; asm volatile("" : "+s"(bar), "+s"(bxx));
        __builtin_amdgcn_s_waitcnt(0);
        unsigned nloc = b.nloc, nx = b.nx;
        if (nloc == 0u) { xcd_barrier_complete(bar, bxx, nloc, nx); nloc_new = nloc; nx_new = nx; }
        const unsigned old = xb_add(&bar[XB_XSUB(bxx)], 1u);
        const unsigned gen = old / nloc;
        if (old + 1u == (gen + 1u) * nloc) {
            __builtin_amdgcn_fence(__ATOMIC_RELEASE, "agent");
            asm volatile("s_waitcnt vmcnt(0)" ::: "memory");
            const unsigned og = xb_add(&bar[XB_TOP], 1u);
            const unsigned tg = og / nx;
            if (og + 1u != (tg + 1u) * nx) XB_SPIN(xb_ld(&bar[XB_TOP]) < (tg + 1u) * nx, bar);
            __builtin_amdgcn_fence(__ATOMIC_ACQUIRE, "agent");
            xb_add(&bar[XB_XGEN(bxx)], 1u);
            asm volatile("s_waitcnt vmcnt(0)" ::: "memory");
        } else {
            XB_SPIN(xb_ld(&bar[XB_XGEN(bxx)]) == gen, bar);
            __builtin_amdgcn_fence(__ATOMIC_ACQUIRE, "agent");
            asm volatile("s_waitcnt vmcnt(0)" ::: "memory");
        }
    }
    b.nloc = __builtin_amdgcn_readfirstlane(nloc_new); b.nx = __builtin_amdgcn_readfirstlane(nx_new);
    __syncthreads();
}

typedef unsigned long long u64;
namespace pg8 {
typedef int i32x4v __attribute__((ext_vector_type(4)));
constexpr int BM = 256, BK = 64, HALF = 128, HTB = HALF * BK * 2, STAGE_BYTES = 8 * HTB, NXCD = 8, WGM = 8;
__device__ __forceinline__ int lds_byte(int r, int c) { const int st = (r >> 4) * 2 + (c >> 5), rr = r & 15, cc = c & 31, ob = rr * 64 + cc * 2; return st * 1024 + (ob ^ (((ob >> 9) & 1) << 5)); }
__device__ __forceinline__ void stage_rc(int b, int& R, int& C) { const int st = b / 1024, sb = b % 1024, swz = sb ^ (((sb >> 9) & 1) << 5); R = (st >> 1) * 16 + swz / 64; C = (st & 1) * 32 + (swz % 64) / 2; }
__device__ __forceinline__ int perm32(int rho) { const int n = rho >> 4, i = rho & 15; return 8 * (i >> 2) + 4 * n + (i & 3); }

struct Unit { unsigned A, B; int pm, pn, kind, aux; };

__device__ __forceinline__ int xcd_remap(int L, int nwg) { const int q = nwg / NXCD, r = nwg % NXCD, xcd = L % NXCD, off = L / NXCD; return (xcd < r ? xcd * (q + 1) : r * (q + 1) + (xcd - r) * q) + off; }
__device__ __forceinline__ void tile_decode(int wgid, int nM, int nN, int& pm, int& pn) {
    const int nig = WGM * nN, gid = wgid / nig, fm = gid * WGM, gsz = (nM - fm) < WGM ? (nM - fm) : WGM;
    pm = fm + ((wgid % nig) % gsz); pn = (wgid % nig) / gsz;
}

template <class Epi, class Sched, bool ALIGN_EPI = true, bool F8 = false, int PM = 0>
__device__ __forceinline__ void gemm_run(LAS unsigned char* lds, const int tid, const unsigned char* wsbase, const int K, const int lda, const int ldb, const Sched& S, const Epi& E) {
    const int wid = __builtin_amdgcn_readfirstlane(tid >> 6), lane = tid & 63, wr = wid >> 2, wc = wid & 3, fr = lane & 15, fq = lane >> 4;
    const int nt = K / BK;
    const unsigned long long wsb = (unsigned long long)wsbase; const unsigned wlo = __builtin_amdgcn_readfirstlane((unsigned)wsb), whi = __builtin_amdgcn_readfirstlane((unsigned)(wsb >> 32));
    const __amdgpu_buffer_rsrc_t rsrc = __builtin_amdgcn_make_buffer_rsrc((void*)(((unsigned long long)whi << 32) | wlo), 0, 0xFFFFF000u, 0x00020000);
    unsigned voffA, voffB;
    { int R, C; stage_rc(tid * 16, R, C); const int Rb = (R & ~31) + perm32(R & 31); voffA = (unsigned)(R * lda + C) * 2u; voffB = (unsigned)(Rb * ldb + C) * 2u; }
    const unsigned pieceA = 64u * lda * 2u, pieceB = 64u * ldb * 2u;
    const unsigned kstep = BK * 2;
    const unsigned hstepA = (unsigned)HALF * lda * 2u, hstepB = (unsigned)HALF * ldb * 2u;
    const unsigned ldsw = (unsigned)wid * 1024u;
    const int aoff = lds_byte(wr * 64 + fr, fq * 8), boff = lds_byte(wc * 32 + fr, fq * 8);
#define PG8_SA(b, h) (((b) * 2 + (h)) * HTB)
#define PG8_SB(b, h) ((4 + (b) * 2 + (h)) * HTB)
#define PG8_STAGE(bufoff, goff, voff) do { if constexpr (PM == 2) break; \
        __builtin_amdgcn_raw_ptr_buffer_load_lds(rsrc, (LAS void*)(lds + (bufoff) + ldsw), 16, (int)(voff), (int)(goff), 0, 0); \
        __builtin_amdgcn_raw_ptr_buffer_load_lds(rsrc, (LAS void*)(lds + (bufoff) + ldsw + 8192), 16, (int)(voff), (int)((goff) + piece##voff), 0, 0); } while (0)
#define piecevoffA pieceA
#define piecevoffB pieceB
#define PG8_LDA(dst, b, h) do { if constexpr (PM == 1) break; _Pragma("unroll") for (int m = 0; m < 4; ++m) _Pragma("unroll") for (int k = 0; k < 2; ++k) dst[m][k] = *(const LAS bf16x8*)(lds + PG8_SA(b, h) + aoff + m * 2048 + k * 1024); } while (0)
#define PG8_LDB(dst, b, h) do { if constexpr (PM == 1) break; _Pragma("unroll") for (int n = 0; n < 2; ++n) _Pragma("unroll") for (int k = 0; k < 2; ++k) dst[n][k] = *(const LAS bf16x8*)(lds + PG8_SB(b, h) + boff + n * 2048 + k * 1024); } while (0)
#define PG8_CAT(lo, hi) __builtin_shufflevector(__builtin_bit_cast(i32x4v, lo), __builtin_bit_cast(i32x4v, hi), 0, 1, 2, 3, 4, 5, 6, 7)
#define PG8_MMA(ai, bj, At, Bt) do { if constexpr (PM == 3) break; __builtin_amdgcn_s_setprio(1); if constexpr (F8) { _Pragma("unroll") for (int m = 0; m < 4; ++m) _Pragma("unroll") for (int n = 0; n < 2; ++n) \
        acc[ai][bj][m][n] = __builtin_amdgcn_mfma_scale_f32_16x16x128_f8f6f4(PG8_CAT(Bt[n][0], Bt[n][1]), PG8_CAT(At[m][0], At[m][1]), acc[ai][bj][m][n], 0, 0, 0, 0x7F7F7F7F, 0, 0x7F7F7F7F); } \
      else { _Pragma("unroll") for (int m = 0; m < 4; ++m) _Pragma("unroll") for (int n = 0; n < 2; ++n) _Pragma("unroll") for (int k = 0; k < 2; ++k) \
        acc[ai][bj][m][n] = __builtin_amdgcn_mfma_f32_16x16x32_bf16(Bt[n][k], At[m][k], acc[ai][bj][m][n], 0, 0, 0); } __builtin_amdgcn_s_setprio(0); } while (0)
#define PG8_WAIT_V(n) asm volatile("s_waitcnt vmcnt(" #n ")" ::: "memory")
#define PG8_WAIT_L(n) asm volatile("s_waitcnt lgkmcnt(" #n ")" ::: "memory")
#define PG8_BAR __builtin_amdgcn_s_barrier()
#define PG8_SCHED __builtin_amdgcn_sched_barrier(0)
    Unit cur, nxt; int ui = 0;
    if (!S.next(0, cur)) return;
    LAS unsigned char* pfslot = lds + STAGE_BYTES + ldsw * 2u;
#define PG8_PF(unit) do { if constexpr (Epi::PF) { const int po = __builtin_amdgcn_readfirstlane((int)E.pf_off(unit)); \
        __builtin_amdgcn_raw_ptr_buffer_load_lds(rsrc, (LAS void*)pfslot, 16, lane * 16, po, 0, 0); \
        __builtin_amdgcn_raw_ptr_buffer_load_lds(rsrc, (LAS void*)(pfslot + 1024), 16, lane * 16, po + 1024, 0, 0); } } while (0)
    PG8_PF(cur);
    f32x4 acc[2][2][4][2];
#pragma unroll
    for (int a = 0; a < 2; ++a)
#pragma unroll
        for (int b = 0; b < 2; ++b)
#pragma unroll
            for (int m = 0; m < 4; ++m)
#pragma unroll
                for (int n = 0; n < 2; ++n) acc[a][b][m][n] = (f32x4){0.f, 0.f, 0.f, 0.f};
    bf16x8 At[4][2], B0[2][2], B1[2][2];
    if constexpr (PM == 1) {
#pragma unroll
        for (int m = 0; m < 4; ++m) { asm volatile("" : "=v"(At[m][0])); asm volatile("" : "=v"(At[m][1])); }
#pragma unroll
        for (int m = 0; m < 2; ++m) { asm volatile("" : "=v"(B0[m][0])); asm volatile("" : "=v"(B0[m][1])); asm volatile("" : "=v"(B1[m][0])); asm volatile("" : "=v"(B1[m][1])); }
    }
    unsigned cA = cur.A, cB = cur.B;
    PG8_STAGE(PG8_SB(0, 0), cB, voffB); PG8_STAGE(PG8_SB(0, 1), cB + hstepB, voffB); PG8_STAGE(PG8_SA(0, 0), cA, voffA); PG8_STAGE(PG8_SA(0, 1), cA + hstepA, voffA);
    if (wr == 1) PG8_BAR;
    PG8_WAIT_V(2); PG8_BAR;
    PG8_STAGE(PG8_SB(1, 0), cB + kstep, voffB); PG8_STAGE(PG8_SA(1, 0), cA + kstep, voffA); PG8_STAGE(PG8_SB(1, 1), cB + hstepB + kstep, voffB);
    PG8_WAIT_V(6); PG8_BAR;
    for (;;) {
        const bool has_next = S.next(ui + 1, nxt);
        const unsigned nA = has_next ? nxt.A : cA, nB = has_next ? nxt.B : cB;
        for (int t = 0; t < nt; t += 2) {
            const bool last = (t == nt - 2);
            const unsigned a1 = cA + (unsigned)(t + 1) * kstep;
            const unsigned a2 = last ? nA : cA + (unsigned)(t + 2) * kstep, b2 = last ? nB : cB + (unsigned)(t + 2) * kstep;
            const unsigned a3 = a2 + kstep, b3 = b2 + kstep;
            PG8_LDB(B0, 0, 0); PG8_LDB(B1, 0, 1); PG8_SCHED; PG8_LDA(At, 0, 0); PG8_STAGE(PG8_SA(1, 1), a1 + hstepA, voffA);
            PG8_WAIT_V(8); PG8_WAIT_L(0); PG8_BAR; PG8_MMA(0, 0, At, B0); PG8_MMA(0, 1, At, B1); PG8_BAR; PG8_SCHED;
            PG8_LDA(At, 0, 1); PG8_STAGE(PG8_SB(0, 0), b2, voffB); PG8_STAGE(PG8_SB(0, 1), b2 + hstepB, voffB); PG8_STAGE(PG8_SA(0, 0), a2, voffA);
            PG8_WAIT_V(8); PG8_WAIT_L(0); PG8_BAR; PG8_MMA(1, 0, At, B0); PG8_MMA(1, 1, At, B1); PG8_BAR; PG8_SCHED;
            PG8_LDB(B0, 1, 0); PG8_LDB(B1, 1, 1); PG8_SCHED; PG8_LDA(At, 1, 0); PG8_STAGE(PG8_SA(0, 1), a2 + hstepA, voffA);
            PG8_WAIT_V(8); PG8_WAIT_L(0); PG8_BAR; PG8_MMA(0, 0, At, B0); PG8_MMA(0, 1, At, B1); PG8_BAR; PG8_SCHED;
            PG8_LDA(At, 1, 1); PG8_STAGE(PG8_SB(1, 0), b3, voffB); PG8_STAGE(PG8_SB(1, 1), b3 + hstepB, voffB); PG8_STAGE(PG8_SA(1, 0), a3, voffA);
            PG8_WAIT_V(8); PG8_WAIT_L(0); PG8_BAR; PG8_MMA(1, 0, At, B0); PG8_MMA(1, 1, At, B1); PG8_BAR; PG8_SCHED;
        }
        if constexpr (ALIGN_EPI) { if (wr == 0) PG8_BAR; }
        bool zero_acc = true;
        { Unit eu = cur; asm volatile("" : "+s"(eu.pm), "+s"(eu.pn));
          const int lane_o = lane_id(); if constexpr (Epi::INPLACE) zero_acc = E(acc, eu, wr, wc, lane_o & 15, lane_o >> 4, (const LAS u64*)pfslot); else E(acc, eu, wr, wc, lane_o & 15, lane_o >> 4, (const LAS u64*)pfslot); }
        if (!has_next) break;
        PG8_SCHED; PG8_PF(nxt); PG8_SCHED;
        if (zero_acc) {
#pragma unroll
        for (int a = 0; a < 2; ++a)
#pragma unroll
            for (int b = 0; b < 2; ++b)
#pragma unroll
                for (int m = 0; m < 4; ++m)
#pragma unroll
                    for (int n = 0; n < 2; ++n) acc[a][b][m][n] = (f32x4){0.f, 0.f, 0.f, 0.f};
        }
        cur = nxt; cA = nA; cB = nB; ++ui;
        if constexpr (ALIGN_EPI) { if (wr == 1) PG8_BAR; }
    }
    PG8_WAIT_V(0);
    if constexpr (!ALIGN_EPI) { if (wr == 0) PG8_BAR; }
    PG8_BAR;
#undef PG8_PF
#undef PG8_SA
#undef PG8_SB
#undef PG8_STAGE
#undef piecevoffA
#undef piecevoffB
#undef PG8_LDA
#undef PG8_LDB
#undef PG8_MMA
#undef PG8_CAT
#undef PG8_WAIT_V
#undef PG8_WAIT_L
#undef PG8_BAR
#undef PG8_SCHED
}
}
using pg8::Unit;

typedef f32x4 Acc[2][2][4][2];
#define EPI_ROWS(u, wr, fr) const int row0 = (u).pm * 256 + (wr) * 64 + (fr)

__device__ __forceinline__ float ssq_val(const u64* ssq, int row) { return (float)ssq[row] * 2.3283064365386963e-10f; }
__device__ __forceinline__ u64 ssq_fix(float s) { return (u64)(s * 4294967296.0f); }
__device__ __forceinline__ float row_rstd_lds(const LAS u64* pf, int lrow, float invn) { return rsqrtf((float)pf[lrow] * 2.3283064365386963e-10f * invn + EPS); }
__device__ __forceinline__ float row_rstd(const u64* ssq, int row, float invn) { return rsqrtf(ssq_val(ssq, row) * invn + EPS); }
__device__ __forceinline__ void ssq_atomic(u64* ssq, int row, float s, int fr, int fq) {
    const int lane = fr + 16 * fq; s += shflx(s, 16, lane); s += shflx(s, 32, lane);
    if (fq == 0) atomicAdd(ssq + row, ssq_fix(s));
}

struct EpiIn {
    static constexpr bool INPLACE = false, PF = true;
    unsigned char* ws; int l; bool do_ssq;
    __device__ __forceinline__ unsigned pf_off(const Unit& u) const { return (unsigned)(l == 0 ? WS_SSQA0 : CB_SSQ + (size_t)SSQ_A1 * NTOK * 8) + (u.kind == 1 ? 0u : (unsigned)u.pm * 2048u); }
    __device__ __forceinline__ void operator()(const Acc& acc, const Unit& u, int wr, int wc, int fr, int fq, const LAS u64* pf) const {
        EPI_ROWS(u, wr, fr);
        bf16* proj = (bf16*)(ws + WS_PROJ); float* zf = (float*)(ws + WS_ZF); bf16* mkv = (bf16*)(ws + WS_MKV);
        const u64* ssq_h = l == 0 ? (const u64*)(ws + WS_SSQA0) : (const u64*)(ws + CB_SSQ) + SSQ_A1 * NTOK;
        u64* ssq_cq = (u64*)(ws + CB_SSQ) + (l == 0 ? SSQ_CQ0 : SSQ_CQ1) * NTOK; u64* ssq_ckv = (u64*)(ws + CB_SSQ) + (l == 0 ? SSQ_CKV0 : SSQ_CKV1) * NTOK;
        const float* cosT = (const float*)(ws + WS_COS); const float* sinT = (const float*)(ws + WS_SIN);
        if (u.kind == 1) {
#pragma unroll
            for (int ai = 0; ai < 2; ++ai)
#pragma unroll
                for (int m = 0; m < 4; ++m) { const int row = row0 + ai * 128 + m * 16;
#pragma unroll
                    for (int bj = 0; bj < 2; ++bj) { const int col = u.pn * 256 + bj * 128 + wc * 32 + 8 * fq;
                        *(u32x4*)(mkv + (size_t)row * 2048 + col) = pack8(acc[ai][bj][m][0], acc[ai][bj][m][1]); } }
            return;
        }
        const int pn = u.pn;
        float rsv[2][4];
#pragma unroll
        for (int ai = 0; ai < 2; ++ai)
#pragma unroll
            for (int m = 0; m < 4; ++m) rsv[ai][m] = row_rstd_lds(pf, ai * 128 + wr * 64 + m * 16 + fr, 1.0f / DM);
#pragma unroll
        for (int ai = 0; ai < 2; ++ai)
#pragma unroll
            for (int m = 0; m < 4; ++m) {
                const int row = row0 + ai * 128 + m * 16;
                const float rs = rsv[ai][m];
                float sq = 0.f;
#pragma unroll
                for (int bj = 0; bj < 2; ++bj) {
                    const int col = pn * 256 + bj * 128 + wc * 32 + 8 * fq;
                    f32x4 v0 = acc[ai][bj][m][0] * rs, v1 = acc[ai][bj][m][1] * rs;
                    if (pn >= 4 && pn < 8) {
                        float* zp = zf + (size_t)row * 1024 + (col - PC_F);
                        *(f32x4*)zp = v0; *(f32x4*)(zp + 4) = v1;
                    } else {
                        if (pn >= 16 && pn < 20) sq += (v0[0] * v0[0] + v0[1] * v0[1]) + (v0[2] * v0[2] + v0[3] * v0[3]) + (v1[0] * v1[0] + v1[1] * v1[1]) + (v1[2] * v1[2] + v1[3] * v1[3]);
                        if (pn == 20 && bj == 0 && wc < 2) {
                            const int j0 = (wc * 32 + 8 * fq) >> 1;
                            const f32x4 cs = *(const f32x4*)(cosT + (size_t)row * 32 + j0), sn = *(const f32x4*)(sinT + (size_t)row * 32 + j0);
                            f32x4 r0, r1;
                            r0[0] = v0[0] * cs[0] - v0[1] * sn[0]; r0[1] = v0[1] * cs[0] + v0[0] * sn[0];
                            r0[2] = v0[2] * cs[1] - v0[3] * sn[1]; r0[3] = v0[3] * cs[1] + v0[2] * sn[1];
                            r1[0] = v1[0] * cs[2] - v1[1] * sn[2]; r1[1] = v1[1] * cs[2] + v1[0] * sn[2];
                            r1[2] = v1[2] * cs[3] - v1[3] * sn[3]; r1[3] = v1[3] * cs[3] + v1[2] * sn[3];
                            v0 = r0; v1 = r1;
                        }
                        if (pn >= 25) {
#pragma unroll
                            for (int j = 0; j < 4; ++j) { v0[j] = EPI_SIGMOID(v0[j]); v1[j] = EPI_SIGMOID(v1[j]); }
                        }
                        *(u32x4*)(proj + (size_t)row * DINP + col) = pack8(v0, v1);
                    }
                }
                if (do_ssq && pn >= 16 && pn < 18) ssq_atomic(ssq_cq, row, sq, fr, fq);
                if (do_ssq && pn >= 18 && pn < 20) ssq_atomic(ssq_ckv, row, sq, fr, fq);
            }
    }
};

struct EpiGateLogit {
    static constexpr bool INPLACE = false, PF = true;
    unsigned char* ws; int l;
    __device__ __forceinline__ unsigned pf_off(const Unit& u) const { return (unsigned)(l == 0 ? WS_SSQA0 : CB_SSQ + (size_t)SSQ_A1 * NTOK * 8) + (unsigned)u.pm * 2048u; }
    __device__ __forceinline__ void operator()(const Acc& acc, const Unit& u, int wr, int wc, int fr, int fq, const LAS u64* pf) const {
        EPI_ROWS(u, wr, fr);
        bf16* proj = (bf16*)(ws + WS_PROJ);
        const u64* ssq_h = l == 0 ? (const u64*)(ws + WS_SSQA0) : (const u64*)(ws + CB_SSQ) + SSQ_A1 * NTOK;
        float rsv[2][4];
#pragma unroll
        for (int ai = 0; ai < 2; ++ai)
#pragma unroll
            for (int m = 0; m < 4; ++m) rsv[ai][m] = row_rstd_lds(pf, ai * 128 + wr * 64 + m * 16 + fr, 1.0f / DM) * (1.0f / (F8_H * F8_WIN));
#pragma unroll
        for (int ai = 0; ai < 2; ++ai)
#pragma unroll
            for (int m = 0; m < 4; ++m) {
                const int row = row0 + ai * 128 + m * 16;
                const float rsl = rsv[ai][m] * -1.4426950408889634f;
#pragma unroll
                for (int bj = 0; bj < 2; ++bj) {
                    const int col = u.pn * 256 + bj * 128 + wc * 32 + 8 * fq;
                    f32x4 v0, v1;
#pragma unroll
                    for (int j = 0; j < 4; ++j) { v0[j] = __builtin_amdgcn_rcpf(1.0f + __builtin_amdgcn_exp2f(acc[ai][bj][m][0][j] * rsl)); v1[j] = __builtin_amdgcn_rcpf(1.0f + __builtin_amdgcn_exp2f(acc[ai][bj][m][1][j] * rsl)); }
                    *(u32x4*)(proj + (size_t)row * DINP + PC_GATE + col) = pack8(v0, v1);
                }
            }
    }
};

struct EpiUp {
    static constexpr bool INPLACE = false, PF = true;
    unsigned char* ws; int l;
    __device__ __forceinline__ unsigned pf_off(const Unit& u) const { return (unsigned)(CB_SSQ + (size_t)(u.kind == 0 ? (l == 0 ? SSQ_CQ0 : SSQ_CQ1) : (l == 0 ? SSQ_CKV0 : SSQ_CKV1)) * NTOK * 8) + (unsigned)u.pm * 2048u; }
    __device__ __forceinline__ void operator()(const Acc& acc, const Unit& u, int wr, int wc, int fr, int fq, const LAS u64* pf) const {
        EPI_ROWS(u, wr, fr);
        bf16* qmla = (bf16*)(ws + WS_QMLA); bf16* kvb = (bf16*)(ws + WS_KVB);
        const u64* ssq_cq = (const u64*)(ws + CB_SSQ) + (l == 0 ? SSQ_CQ0 : SSQ_CQ1) * NTOK; const u64* ssq_ckv = (const u64*)(ws + CB_SSQ) + (l == 0 ? SSQ_CKV0 : SSQ_CKV1) * NTOK;
        const float* cosT = (const float*)(ws + WS_COS); const float* sinT = (const float*)(ws + WS_SIN);
        const bool isq = (u.kind == 0);
        float rsv[2][4];
#pragma unroll
        for (int ai = 0; ai < 2; ++ai)
#pragma unroll
            for (int m = 0; m < 4; ++m) rsv[ai][m] = row_rstd_lds(pf, ai * 128 + wr * 64 + m * 16 + fr, 1.0f / 512.0f);
#pragma unroll
        for (int ai = 0; ai < 2; ++ai)
#pragma unroll
            for (int m = 0; m < 4; ++m) {
                const int row = row0 + ai * 128 + m * 16;
                const float rs = rsv[ai][m];
#pragma unroll
                for (int bj = 0; bj < 2; ++bj) {
                    const int col = u.pn * 256 + bj * 128 + wc * 32 + 8 * fq;
                    f32x4 v0 = acc[ai][bj][m][0] * rs, v1 = acc[ai][bj][m][1] * rs;
                    if (isq) {
                        const int c192 = col % QKD;
                        if (c192 >= NOPE) {
                            const int j0 = (c192 - NOPE) >> 1;
                            const f32x4 cs = *(const f32x4*)(cosT + (size_t)row * 32 + j0), sn = *(const f32x4*)(sinT + (size_t)row * 32 + j0);
                            f32x4 r0, r1;
                            r0[0] = v0[0] * cs[0] - v0[1] * sn[0]; r0[1] = v0[1] * cs[0] + v0[0] * sn[0];
                            r0[2] = v0[2] * cs[1] - v0[3] * sn[1]; r0[3] = v0[3] * cs[1] + v0[2] * sn[1];
                            r1[0] = v1[0] * cs[2] - v1[1] * sn[2]; r1[1] = v1[1] * cs[2] + v1[0] * sn[2];
                            r1[2] = v1[2] * cs[3] - v1[3] * sn[3]; r1[3] = v1[3] * cs[3] + v1[2] * sn[3];
                            v0 = r0; v1 = r1;
                        }
                        *(u32x4*)(qmla + (size_t)row * 1536 + col) = pack8(v0, v1);
                    } else {
                        *(u32x4*)(kvb + (size_t)row * 2048 + col) = pack8(v0, v1);
                    }
                }
            }
    }
};

struct EpiGate {
    static constexpr bool INPLACE = true, PF = false;
    unsigned char* ws;
    __device__ __forceinline__ bool operator()(Acc& acc, const Unit& u, int wr, int wc, int fr, int fq, const LAS u64* pf) const {
        EPI_ROWS(u, wr, fr);
        const bf16* proj = (const bf16*)(ws + WS_PROJ); bf16* mrgb = (bf16*)(ws + WS_MRGB);
        const int n = u.kind;
#pragma unroll
        for (int ai = 0; ai < 2; ++ai) {
            u32x4 ga[4][2], gb[4][2];
#pragma unroll
            for (int m = 0; m < 4; ++m)
#pragma unroll
                for (int bj = 0; bj < 2; ++bj) { const int row = row0 + ai * 128 + m * 16, col = u.pn * 256 + bj * 128 + wc * 32 + 8 * fq;
                    const bf16* gp = proj + (size_t)row * DINP + PC_GATE + col;
                    ga[m][bj] = *(const u32x4*)(gp + n * DM);
                    if (n < 2) gb[m][bj] = *(const u32x4*)(gp + (n + 1) * DM); }
#pragma unroll
            for (int m = 0; m < 4; ++m)
#pragma unroll
                for (int bj = 0; bj < 2; ++bj) { const int row = row0 + ai * 128 + m * 16, col = u.pn * 256 + bj * 128 + wc * 32 + 8 * fq;
                    const unsigned aw[4] = {ga[m][bj].x, ga[m][bj].y, ga[m][bj].z, ga[m][bj].w}, bw[4] = {gb[m][bj].x, gb[m][bj].y, gb[m][bj].z, gb[m][bj].w};
                    float f[8];
#pragma unroll
                    for (int j = 0; j < 4; ++j) { float n0 = bflo(aw[j]), n1 = bfhi(aw[j]);
                        if (n > 0) { n0 = fmaxf(n0, 1e-6f); n1 = fmaxf(n1, 1e-6f); }
                        if (n < 2) { n0 *= __builtin_amdgcn_rcpf(fmaxf(bflo(bw[j]), 1e-6f)); n1 *= __builtin_amdgcn_rcpf(fmaxf(bfhi(bw[j]), 1e-6f)); }
                        f[2 * j] = n0; f[2 * j + 1] = n1; }
                    f32x4& v0 = acc[ai][bj][m][0]; f32x4& v1 = acc[ai][bj][m][1];
                    v0[0] *= f[0]; v0[1] *= f[1]; v0[2] *= f[2]; v0[3] *= f[3]; v1[0] *= f[4]; v1[1] *= f[5]; v1[2] *= f[6]; v1[3] *= f[7];
                    if (n == 2) *(u32x4*)(mrgb + (size_t)row * DM + col) = pack8(v0, v1); }
        }
        return n == 2;
    }
};

template <bool SCALED> struct EpiResT {
    static constexpr bool INPLACE = false, PF = false;
    unsigned char* ws; int ssq_idx; bool f8copy;
    __device__ __forceinline__ void operator()(const Acc& acc, const Unit& u, int wr, int wc, int fr, int fq, const LAS u64* pf) const {
        EPI_ROWS(u, wr, fr);
        bf16* hb = (bf16*)(ws + WS_HB); u64* ssq = (u64*)(ws + CB_SSQ) + ssq_idx * NTOK;
        u32x4 bv[2][4][2];
#pragma unroll
        for (int ai = 0; ai < 2; ++ai)
#pragma unroll
            for (int m = 0; m < 4; ++m)
#pragma unroll
                for (int bj = 0; bj < 2; ++bj) bv[ai][m][bj] = *(const u32x4*)(hb + (size_t)(row0 + ai * 128 + m * 16) * DM + u.pn * 256 + bj * 128 + wc * 32 + 8 * fq);
#pragma unroll
        for (int ai = 0; ai < 2; ++ai)
#pragma unroll
            for (int m = 0; m < 4; ++m) {
                const int row = row0 + ai * 128 + m * 16;
                float sq = 0.f;
#pragma unroll
                for (int bj = 0; bj < 2; ++bj) {
                    const int col = u.pn * 256 + bj * 128 + wc * 32 + 8 * fq;
                    const u32x4 b = bv[ai][m][bj];
                    f32x4 v0 = acc[ai][bj][m][0], v1 = acc[ai][bj][m][1];
                    if (SCALED) {
#pragma unroll
                        for (int j = 0; j < 4; ++j) { v0[j] = __builtin_ldexpf(v0[j], -14); v1[j] = __builtin_ldexpf(v1[j], -14); } }
                    v0 = v0 + (f32x4){bflo(b.x), bfhi(b.x), bflo(b.y), bfhi(b.y)}; v1 = v1 + (f32x4){bflo(b.z), bfhi(b.z), bflo(b.w), bfhi(b.w)};
                    *(u32x4*)(hb + (size_t)row * DM + col) = pack8(v0, v1);
                    if (f8copy) *(u32x2*)(ws + WS_HB8 + (size_t)row * DM + col) = pack8_f8(v0 * F8_H, v1 * F8_H);
                    sq += (v0[0] * v0[0] + v0[1] * v0[1]) + (v0[2] * v0[2] + v0[3] * v0[3]) + (v1[0] * v1[0] + v1[1] * v1[1]) + (v1[2] * v1[2] + v1[3] * v1[3]);
                }
                ssq_atomic(ssq, row, sq, fr, fq);
            }
    }
};

typedef EpiResT<false> EpiRes;
static_assert(F8_ACT * F8_WDN == 16384.0f && F8_H * F8_WGU == 32768.0f, "power-of-two fp8 scales");
template <bool RSTD, bool IN8 = false, bool OUT8 = false> struct EpiSwiglu {
    static constexpr bool INPLACE = false, PF = RSTD;
    unsigned char* ws; unsigned act_off; int ldc; int ssq_idx;
    __device__ __forceinline__ unsigned pf_off(const Unit& u) const { return (unsigned)(CB_SSQ + (size_t)ssq_idx * NTOK * 8) + (unsigned)u.pm * 2048u; }
    __device__ __forceinline__ void operator()(const Acc& acc, const Unit& u, int wr, int wc, int fr, int fq, const LAS u64* pf) const {
        EPI_ROWS(u, wr, fr);
        bf16* act = (bf16*)(ws + act_off); const u64* ssq = (const u64*)(ws + CB_SSQ) + ssq_idx * NTOK;
        float rsv[2][4];
#pragma unroll
        for (int ai = 0; ai < 2; ++ai)
#pragma unroll
            for (int m = 0; m < 4; ++m) { rsv[ai][m] = RSTD ? row_rstd_lds(pf, ai * 128 + wr * 64 + m * 16 + fr, 1.0f / DM) : 1.0f; if (IN8) rsv[ai][m] = __builtin_ldexpf(rsv[ai][m], -15); }
#pragma unroll
        for (int ai = 0; ai < 2; ++ai)
#pragma unroll
            for (int m = 0; m < 4; ++m) {
                const int row = row0 + ai * 128 + m * 16;
                const float rs = rsv[ai][m], rsl = rs * -1.4426950408889634f, rs2 = OUT8 ? __builtin_ldexpf(rs * rs, 3) : rs * rs;
                f32x4 o[2];
#pragma unroll
                for (int n = 0; n < 2; ++n)
#pragma unroll
                    for (int j = 0; j < 4; ++j) { const float ag = acc[ai][0][m][n][j];
                        o[n][j] = ag * __builtin_amdgcn_rcpf(1.0f + __builtin_amdgcn_exp2f(ag * rsl)) * acc[ai][1][m][n][j] * rs2; }
                if (MK_PROBE_MODE == 9 && act_off == 1u) { const u32x4 pk = pack8(o[0], o[1]); asm volatile("" :: "v"(pk)); } else
                if (OUT8) *(u32x2*)((unsigned char*)act + (size_t)row * ldc + u.pn * 128 + wc * 32 + 8 * fq) = pack8_f8(o[0], o[1]); else
                *(u32x4*)(act + (size_t)row * ldc + u.pn * 128 + wc * 32 + 8 * fq) = pack8(o[0], o[1]);
            }
    }
};

struct EpiNull {
    static constexpr bool INPLACE = false, PF = false;
    unsigned char* ws;
    __device__ __forceinline__ void operator()(const Acc& acc, const Unit& u, int wr, int wc, int fr, int fq, const LAS u64* pf) const {
#pragma unroll
        for (int ai = 0; ai < 2; ++ai)
#pragma unroll
            for (int bj = 0; bj < 2; ++bj)
#pragma unroll
                for (int m = 0; m < 4; ++m) { asm volatile("" :: "v"(acc[ai][bj][m][0])); asm volatile("" :: "v"(acc[ai][bj][m][1])); }
    }
};

struct EpiSwigluF8 {
    static constexpr bool INPLACE = false, PF = false;
    unsigned char* ws;
    __device__ __forceinline__ void operator()(const Acc& acc, const Unit& u, int wr, int wc, int fr, int fq, const LAS u64* pf) const {
        EPI_ROWS(u, wr, fr);
        unsigned char* act = ws + WS_ACTE; constexpr int ldc = FFE;
        const float inv = 1.0f / (F8_XS * F8_WGU);
#pragma unroll
        for (int ai = 0; ai < 2; ++ai)
#pragma unroll
            for (int m = 0; m < 4; ++m) {
                const int row = row0 + ai * 128 + m * 16;
                f32x4 o[2];
#pragma unroll
                for (int n = 0; n < 2; ++n)
#pragma unroll
                    for (int j = 0; j < 4; ++j) { const float ag = acc[ai][0][m][n][j];
                        o[n][j] = ag * __builtin_amdgcn_rcpf(1.0f + __builtin_amdgcn_exp2f(ag * (inv * -1.4426950408889634f))) * acc[ai][1][m][n][j] * (inv * inv * F8_ACT); }
                *(u32x2*)(act + (size_t)row * ldc + u.pn * 128 + wc * 32 + 8 * fq) = pack8_f8(o[0], o[1]);
            }
    }
};
struct EpiMoeDown {
    static constexpr bool INPLACE = false, PF = true;
    unsigned char* ws; float oscale;
    __device__ __forceinline__ unsigned pf_off(const Unit& u) const { return (unsigned)WS_RASS + (unsigned)u.pm * 2048u; }
    __device__ __forceinline__ void operator()(const Acc& acc, const Unit& u, int wr, int wc, int fr, int fq, const LAS u64* pf) const {
        EPI_ROWS(u, wr, fr);
        bf16* ys = (bf16*)(ws + WS_YS); const int* rass = (const int*)(ws + WS_RASS); const float* topw = (const float*)(ws + WS_TOPW);
        int rav[2][4]; float wv[2][4];
#pragma unroll
        for (int ai = 0; ai < 2; ++ai)
#pragma unroll
            for (int m = 0; m < 4; ++m) { const u64 v = pf[ai * 128 + wr * 64 + m * 16 + fr]; rav[ai][m] = (int)(unsigned)v; wv[ai][m] = __uint_as_float((unsigned)(v >> 32)) * oscale; }
#pragma unroll
        for (int ai = 0; ai < 2; ++ai)
#pragma unroll
            for (int m = 0; m < 4; ++m) {
                const int ra = rav[ai][m];
                if (ra >= 0) {
                    const float w = wv[ai][m];
#pragma unroll
                    for (int bj = 0; bj < 2; ++bj) {
                        const int col = u.pn * 256 + bj * 128 + wc * 32 + 8 * fq;
                        bf16* dst = u.aux ? (bf16*)(ws + WS_YSQ) + ((size_t)(u.aux - 1) * 2048 + (size_t)(row0 + ai * 128 + m * 16 - 64 * 256)) * DM + col : ys + (size_t)ra * DM + col;
                        *(u32x4*)dst = pack8(acc[ai][bj][m][0] * w, acc[ai][bj][m][1] * w);
                    }
                }
            }
    }
};

struct SchedPlain {
    unsigned A, B; int nM, nN, G, c; unsigned a_tile, b_tile;
    __device__ __forceinline__ bool next(int i, Unit& u) const {
        const int total = nM * nN; const int L = i * G + c; if (L >= total) return false;
        int pm, pn; pg8::tile_decode(pg8::xcd_remap(L, total), nM, nN, pm, pn);
        u.pm = pm; u.pn = pn; u.kind = 0; u.aux = 0; u.A = A + (unsigned)pm * a_tile; u.B = B + (unsigned)pn * b_tile; return true;
    }
};
struct SchedIn {
    unsigned hb, win, memn, wmkv; int G, c, nN1; bool memkv;
    __device__ __forceinline__ bool next(int i, Unit& u) const {
        const int T0 = 32 * nN1, TOT = memkv ? T0 + 32 : T0; const int L = i * G + c; if (L >= TOT) return false;
        const int w = pg8::xcd_remap(L, TOT); int pm, pn;
        if (w < T0) { pg8::tile_decode(w, 32, nN1, pm, pn); u.kind = 0; u.A = hb + (unsigned)pm * 256u * DM * 2u; u.B = win + (unsigned)pn * 256u * DM * 2u; }
        else { pg8::tile_decode(w - T0, 4, 8, pm, pn); u.kind = 1; u.A = memn + (unsigned)pm * 256u * DM * 2u; u.B = wmkv + (unsigned)pn * 256u * DM * 2u; }
        u.pm = pm; u.pn = pn; u.aux = 0; return true;
    }
};
struct SchedIn2 {
    unsigned hb, win, memn, wmkv; int G, c, pnx;
    __device__ __forceinline__ bool next(int i, Unit& u) const {
        const int L = c - (G - 64); if (i != 0 || L < 0) return false;
        if (L < 32) { u.kind = 0; u.pm = L; u.pn = pnx; u.A = hb + (unsigned)L * 256u * DM * 2u; u.B = win + (unsigned)pnx * 256u * DM * 2u; }
        else { const int t = L - 32; u.kind = 1; u.pm = t & 3; u.pn = t >> 2; u.A = memn + (unsigned)(t & 3) * 256u * DM * 2u; u.B = wmkv + (unsigned)(t >> 2) * 256u * DM * 2u; }
        u.aux = 0; return true;
    }
};
struct SchedUp {
    unsigned proj, wq, wkv; int G, c;
    __device__ __forceinline__ bool next(int i, Unit& u) const {
        constexpr int T0 = 32 * 6, TOT = T0 + 32 * 8; const int L = i * G + c; if (L >= TOT) return false;
        const int w = pg8::xcd_remap(L, TOT); int pm, pn;
        if (w < T0) { pg8::tile_decode(w, 32, 6, pm, pn); u.kind = 0; u.A = proj + ((unsigned)pm * 256u * DINP + PC_CQ) * 2u; u.B = wq + (unsigned)pn * 256u * 512u * 2u; }
        else { pg8::tile_decode(w - T0, 32, 8, pm, pn); u.kind = 1; u.A = proj + ((unsigned)pm * 256u * DINP + PC_CKV) * 2u; u.B = wkv + (unsigned)pn * 256u * 512u * 2u; }
        u.pm = pm; u.pn = pn; u.aux = 0; return true;
    }
};
struct SchedGate {
    unsigned y, wbr; int G, c;
    __device__ __forceinline__ bool next(int i, Unit& u) const {
        const int ti = i / 3, n = i - 3 * ti; const int L = ti * G + c; if (L >= 256) return false;
        int pm, pn; pg8::tile_decode(pg8::xcd_remap(L, 256), 32, 8, pm, pn);
        u.pm = pm; u.pn = pn; u.kind = n; u.aux = 0;
        u.A = y + ((unsigned)pm * 256u * 3072u + n * 1024u) * 2u; u.B = wbr + ((unsigned)n * 2048u + pn * 256u) * 1024u * 2u; return true;
    }
};
struct SchedMoe {
    unsigned A, B; const unsigned char* ws; int nrt, nN, G, c; unsigned a_tile, b_tile, b_exp;
    __device__ __forceinline__ bool next(int i, Unit& u) const {
        const int total = nrt * nN; const int L = i * G + c; if (L >= total) return false;
        int pm, pn; pg8::tile_decode(pg8::xcd_remap(L, total), nrt, nN, pm, pn);
        const int e = __builtin_amdgcn_readfirstlane(__hip_atomic_load((const int*)(ws + WS_TEXP) + pm, __ATOMIC_RELAXED, __HIP_MEMORY_SCOPE_AGENT));
        u.pm = pm; u.pn = pn; u.kind = e; u.aux = 0; u.A = A + (unsigned)pm * a_tile; u.B = B + (unsigned)e * b_exp + (unsigned)pn * b_tile; return true;
    }
};

struct SchedMoeTail {
    unsigned A, B; const unsigned char* ws; int nrt, G, c; unsigned a_tile, b_tile, b_exp, kq_bytes;
    __device__ __forceinline__ bool next(int i, Unit& u) const {
        const int total = (nrt - 64) * 8 * 4; const int L = i * G + c; if (L >= total) return false;
        const int kq = L & 3, tile = L >> 2, pm = 64 + (tile >> 3), pn = tile & 7;
        const int e = __builtin_amdgcn_readfirstlane(__hip_atomic_load((const int*)(ws + WS_TEXP) + pm, __ATOMIC_RELAXED, __HIP_MEMORY_SCOPE_AGENT));
        u.pm = pm; u.pn = pn; u.kind = e; u.aux = kq + 1; u.A = A + (unsigned)pm * a_tile + (unsigned)kq * kq_bytes; u.B = B + (unsigned)e * b_exp + (unsigned)pn * b_tile + (unsigned)kq * kq_bytes; return true;
    }
};

namespace att {
__device__ __forceinline__ int crow(int r, int hi) { return (r & 3) + 8 * (r >> 2) + 4 * hi; }
__device__ __forceinline__ int v_st(int k, int c) { const int kk = (k & ~0xC) | ((k & 4) << 1) | ((k & 8) >> 1); return ((kk >> 3) * 4 + (c >> 5)) * 512 + ((kk & 7) * 32 + (c & 31)) * 2; }
__device__ __forceinline__ int v_rd_base(int lane) { return ((lane & 3) << 3) | (((lane >> 2) & 3) << 6) | (((lane >> 4) & 1) << 5) | (((lane >> 5) & 1) << 8); }
constexpr int v_rd_off(int d0, int ks, int half) { return d0 * 512 + ks * 4096 + half * 2048; }
template <int OFF> __device__ __forceinline__ s16x4 tr_read(unsigned vb) {
    s16x4 r; asm volatile("ds_read_b64_tr_b16 %0, %1 offset:%2" : "=&v"(r) : "v"(vb), "i"(OFF) : "memory"); return r;
}
template <int D0> __device__ __forceinline__ void pv_one(f32x16& od, unsigned vb, bf16x8 pa0, bf16x8 pa1, bf16x8 pa2, bf16x8 pa3) {
    const s16x4 l0 = tr_read<v_rd_off(D0, 0, 0)>(vb), h0 = tr_read<v_rd_off(D0, 0, 1)>(vb), l1 = tr_read<v_rd_off(D0, 1, 0)>(vb), h1 = tr_read<v_rd_off(D0, 1, 1)>(vb);
    const s16x4 l2 = tr_read<v_rd_off(D0, 2, 0)>(vb), h2 = tr_read<v_rd_off(D0, 2, 1)>(vb), l3 = tr_read<v_rd_off(D0, 3, 0)>(vb), h3 = tr_read<v_rd_off(D0, 3, 1)>(vb);
    asm volatile("s_waitcnt lgkmcnt(0)" ::: "memory"); SBAR();
#define ATT_PK(L, H) (bf16x8){L[0], L[1], L[2], L[3], H[0], H[1], H[2], H[3]}
    od = __builtin_amdgcn_mfma_f32_32x32x16_bf16(pa0, ATT_PK(l0, h0), od, 0, 0, 0);
    od = __builtin_amdgcn_mfma_f32_32x32x16_bf16(pa1, ATT_PK(l1, h1), od, 0, 0, 0);
    od = __builtin_amdgcn_mfma_f32_32x32x16_bf16(pa2, ATT_PK(l2, h2), od, 0, 0, 0);
    od = __builtin_amdgcn_mfma_f32_32x32x16_bf16(pa3, ATT_PK(l3, h3), od, 0, 0, 0);
#undef ATT_PK
}

template <int DK, int K1DIM, bool CAUSAL>
__device__ __forceinline__ void attn_unit(LAS unsigned char* lds, const int tid, const bf16* __restrict__ Qb, int ldq, const bf16* __restrict__ K1, int ldk1, const bf16* __restrict__ K2, int ldk2,
                                          const bf16* __restrict__ Vp, int ldv, bf16* __restrict__ Ob, int ldo, int NT, int q0, float C) {
    constexpr int NKS = DK / 16, KROWB = DK * 2 + 16  , SHM_K = 64 * KROWB, SHM_V = 64 * 128 * 2;
    constexpr int NC1 = K1DIM / 8, NC2 = (DK - K1DIM) / 8, KC1 = NC1 / 8, KC2 = NC2 / 8;
    static_assert(NC2 == 0 || NC2 == 8, "K2 part is 0 or 64 wide");
    const int wid = tid >> 6, lane = tid & 63, r32 = lane & 31, hi = lane >> 5;
    LAS unsigned char* V_lds = lds; LAS unsigned char* K_lds = lds + 3 * SHM_V;
    LAS float* wsp = (LAS float*)(lds + 3 * SHM_V + 2 * SHM_K) + wid * 64;
    static_assert(3 * SHM_V + 2 * SHM_K + 8 * 64 * 4 <= RING_BYTES, "attention LDS");
    const bool grpB = wid >= 4; LAS float* li_l = wsp; LAS float* al_l = wsp + 32;
    float m_reg = -1e30f, l_reg = 0.f; f32x16 o[4] = {}; bf16x8 qr[NKS];
    { const bf16* Qw = Qb + (unsigned)((wid * 32 + r32) * ldq + hi * 8);
#pragma unroll
      for (int d0 = 0; d0 < NKS; ++d0) qr[d0] = *(const bf16x8*)(Qw + d0 * 16); }
    const int sr = tid >> 4, sc = (tid & 15) * 8, vst0 = v_st(sr, sc), vst1 = v_st(32 + sr, sc);
    const unsigned vb0 = (unsigned)(uintptr_t)V_lds + v_rd_base(lane);
    const unsigned voffv = (unsigned)(sr * ldv + sc);
    unsigned koff1[KC1], kw1[KC1];
#pragma unroll
    for (int i = 0; i < KC1; ++i) { const int c = tid + 512 * i, row = c / NC1, cc = (c % NC1) * 8; koff1[i] = (unsigned)(row * ldk1 + cc); kw1[i] = (unsigned)(row * KROWB + cc * 2); }
    const unsigned koff2 = (unsigned)((tid >> 3) * ldk2 + (tid & 7) * 8), kw2 = (unsigned)((tid >> 3) * KROWB + (K1DIM + (tid & 7) * 8) * 2);
    const unsigned kr0 = (unsigned)(r32 * KROWB + hi * 16);
    bf16x8 ks1[KC1], ks2, vs0, vs1;
#define ATT_SLOAD(k0) do { const bf16* kb_ = K1 + (size_t)(k0) * ldk1; _Pragma("unroll") for (int i_ = 0; i_ < KC1; ++i_) ks1[i_] = *(const bf16x8*)(kb_ + koff1[i_]); \
        if (KC2) { const bf16* k2_ = K2 + (size_t)(k0) * ldk2; ks2 = *(const bf16x8*)(k2_ + koff2); } \
        const bf16* vb_ = Vp + (size_t)(k0) * ldv; vs0 = *(const bf16x8*)(vb_ + voffv); vs1 = *(const bf16x8*)(vb_ + (size_t)32 * ldv + voffv); } while (0)
#define ATT_SWRITE(b, vbuf) do { _Pragma("unroll") for (int i_ = 0; i_ < KC1; ++i_) *(LAS bf16x8*)(K_lds + (b) * SHM_K + kw1[i_]) = ks1[i_]; \
        if (KC2) *(LAS bf16x8*)(K_lds + (b) * SHM_K + kw2) = ks2; \
        *(LAS bf16x8*)(V_lds + (vbuf) * SHM_V + vst0) = vs0; *(LAS bf16x8*)(V_lds + (vbuf) * SHM_V + vst1) = vs1; } while (0)
#define ATT_PV(vbuf) do { const unsigned vb = vb0 + (vbuf) * SHM_V; \
          pv_one<0>(o[0], vb, pa0, pa1, pa2, pa3); pv_one<1>(o[1], vb, pa0, pa1, pa2, pa3); pv_one<2>(o[2], vb, pa0, pa1, pa2, pa3); pv_one<3>(o[3], vb, pa0, pa1, pa2, pa3); } while (0)
    __syncthreads();
    ATT_SLOAD(0); ATT_SWRITE(0, 0); __syncthreads();
    bf16x8 pa0 = {}, pa1 = {}, pa2 = {}, pa3 = {};
    int vcur = 0, vprev = 0;
#pragma unroll 1
    for (int j = 0; j < NT; ++j) {
        const int bsel = j & 1;
        if (grpB && j > 0) ATT_PV(vprev);
        if (j + 1 < NT) ATT_SLOAD((j + 1) * 64);
        f32x16 p0 = {}, p1 = {};
        { const LAS unsigned char* Kb = K_lds + bsel * SHM_K + kr0;
#pragma unroll
          for (int d0 = 0; d0 < NKS; ++d0) {
            const bf16x8 b0 = *(const LAS bf16x8*)(Kb + d0 * 32);
            const bf16x8 b1 = *(const LAS bf16x8*)(Kb + 32 * KROWB + d0 * 32);
            p0 = __builtin_amdgcn_mfma_f32_32x32x16_bf16(b0, qr[d0], p0, 0, 0, 0);
            p1 = __builtin_amdgcn_mfma_f32_32x32x16_bf16(b1, qr[d0], p1, 0, 0, 0); } }
        if (CAUSAL && j >= NT - 4) {
            const int qpos = q0 + wid * 32 + r32, kb = j * 64;
#pragma unroll
            for (int r = 0; r < 16; ++r) { const int kp = kb + crow(r, hi); p0[r] = (kp <= qpos) ? p0[r] : -1e30f; p1[r] = (kp + 32 <= qpos) ? p1[r] : -1e30f; }
        }
        float pmax = p0[0];
#pragma unroll
        for (int r = 1; r < 16; ++r) pmax = fmaxf(pmax, p0[r]);
#pragma unroll
        for (int r = 0; r < 16; ++r) pmax = fmaxf(pmax, p1[r]);
        { auto rr = __builtin_amdgcn_permlane32_swap(__float_as_uint(pmax), __float_as_uint(pmax), false, false); pmax = fmaxf(__uint_as_float(rr[0]), __uint_as_float(rr[1])); }
        if (!__all(pmax <= m_reg)) {
            const float mn = fmaxf(m_reg, pmax), alpha = __builtin_amdgcn_exp2f((m_reg - mn) * C); m_reg = mn; l_reg *= alpha;
            if (hi == 0) al_l[r32] = alpha;
            asm volatile("s_waitcnt lgkmcnt(0)" ::: "memory");
#pragma unroll
            for (int r = 0; r < 16; ++r) { const float a = al_l[crow(r, hi)];
#pragma unroll
                for (int d = 0; d < 4; ++d) o[d][r] *= a; }
        }
        const float mnC = -m_reg * C; float ps = 0.f;
#pragma unroll
        for (int r = 0; r < 16; ++r) { p0[r] = __builtin_amdgcn_exp2f(fmaf(p0[r], C, mnC)); p1[r] = __builtin_amdgcn_exp2f(fmaf(p1[r], C, mnC)); ps += p0[r] + p1[r]; }
        { auto rr = __builtin_amdgcn_permlane32_swap(__float_as_uint(ps), __float_as_uint(ps), false, false); ps = __uint_as_float(rr[0]) + __uint_as_float(rr[1]); }
        l_reg += ps;
#define ATT_PK4(P, BASE, OUT) do { unsigned a0 = cvt_pk_bf16(P[BASE + 0], P[BASE + 1]), a1 = cvt_pk_bf16(P[BASE + 2], P[BASE + 3]); \
        unsigned b0_ = cvt_pk_bf16(P[BASE + 4], P[BASE + 5]), b1_ = cvt_pk_bf16(P[BASE + 6], P[BASE + 7]); \
        auto r0_ = __builtin_amdgcn_permlane32_swap(a0, b0_, false, false); auto r1_ = __builtin_amdgcn_permlane32_swap(a1, b1_, false, false); \
        u32x4 w_ = {r0_[0], r1_[0], r0_[1], r1_[1]}; OUT = *reinterpret_cast<bf16x8*>(&w_); } while (0)
        ATT_PK4(p0, 0, pa0); ATT_PK4(p0, 8, pa1); ATT_PK4(p1, 0, pa2); ATT_PK4(p1, 8, pa3);
#undef ATT_PK4
        if (!grpB) ATT_PV(vcur);
        const int vnext = vcur == 2 ? 0 : vcur + 1;
        if (j + 1 < NT) ATT_SWRITE(bsel ^ 1, vnext);
        vprev = vcur; vcur = vnext;
        __syncthreads();
    }
    if (grpB) ATT_PV(vprev);
    if (hi == 0) li_l[r32] = l_reg;
    asm volatile("s_waitcnt lgkmcnt(0)" ::: "memory");
    int ldo_o = ldo, hi_o = hi; asm volatile("" : "+v"(hi_o), "+s"(ldo_o));
    bf16* Ow = Ob + (unsigned)((wid * 32) * ldo_o + r32);
#pragma unroll
    for (int r = 0; r < 16; ++r) { const int orow = crow(r, hi_o); const float rl = __builtin_amdgcn_rcpf(li_l[orow]);
        bf16* op = Ow + (unsigned)(orow * ldo_o);
#pragma unroll
        for (int d0 = 0; d0 < 4; ++d0) op[d0 * 32] = f2bf(o[d0][r] * rl); }
#undef ATT_SLOAD
#undef ATT_SWRITE
#undef ATT_PV
}
}

namespace hg {
__device__ __forceinline__ int crow(int r, int hi) { return (r & 3) + 8 * (r >> 2) + 4 * hi; }
__device__ __forceinline__ void mma32(f32x16& acc, const LAS bf16* A, int lda, const LAS bf16* Bt, int ldb, int K, int r32, int hi) {
    for (int k0 = 0; k0 < K; k0 += 16) {
        const bf16x8 a = *(const LAS bf16x8*)(A + r32 * lda + k0 + hi * 8);
        const bf16x8 b = *(const LAS bf16x8*)(Bt + r32 * ldb + k0 + hi * 8);
        acc = __builtin_amdgcn_mfma_f32_32x32x16_bf16(a, b, acc, 0, 0, 0);
    }
}
constexpr int LD_D = 136, LD_S = 72, LD_O = 132;
constexpr int L_TOT = 0;
constexpr int L_VT = 2048;
constexpr int L_KT = L_VT + 128 * LD_S * 2;
constexpr int L_QT = L_KT + 128 * LD_S * 2;
constexpr int L_QH = L_QT + 64 * LD_D * 2;
constexpr int L_P = L_QH + 64 * LD_D * 2;
constexpr int L_O = L_P + 64 * LD_S * 2;
constexpr int L_END = L_O + 64 * LD_O * 4;
static_assert(L_END <= RING_BYTES, "hgrn LDS");

__device__ __forceinline__ void gate_scan(LAS unsigned char* lds, const float (&z)[16], float lb, int d, int jq, float (&kk)[16], float (&bl)[16], float& bref, float& b63) {
    LAS float* tot = (LAS float*)(lds + L_TOT);
    float run = 0.f;
#pragma unroll
    for (int i = 0; i < 16; ++i) {
        const float f = lb + (1.0f - lb) * HG_SIGMOID(z[i]);
        run += __logf(fmaxf(f, 1e-20f)); bl[i] = run; kk[i] = 1.0f - f;
    }
    tot[jq * 128 + d] = run;
    __syncthreads();
    const float t0 = tot[d], t1 = tot[128 + d], t2 = tot[256 + d], t3 = tot[384 + d];
    const float off = (jq > 0 ? t0 : 0.f) + (jq > 1 ? t1 : 0.f) + (jq > 2 ? t2 : 0.f);
#pragma unroll
    for (int i = 0; i < 16; ++i) bl[i] += off;
    bref = t0 + t1; b63 = (t0 + t1) + (t2 + t3);
}
__device__ __forceinline__ void stage_vt(LAS unsigned char* lds, const bf16x8 (&vch)[2], int tid) {
    LAS bf16* VT = (LAS bf16*)(lds + L_VT);
#pragma unroll
    for (int i = 0; i < 2; ++i) { const int id = tid + 512 * i, s = id >> 4, e8 = (id & 15) * 8;
#pragma unroll
        for (int q = 0; q < 8; ++q) VT[(e8 + q) * LD_S + s] = (bf16)vch[i][q]; }
}
__device__ __forceinline__ void pass1_unit(LAS unsigned char* lds, const int tid, int unit, const float* zf, const bf16* proj, const float* lbv, float* hu, float* hdec) {
    const int wid = tid >> 6, lane = tid & 63, r32 = lane & 31, hi = lane >> 5;
    const int bh = unit >> 5, c = unit & 31, b = bh >> 3, hh = bh & 7, tok0 = b * SEQ + c * CHUNK;
    const int d = tid & 127, jq = tid >> 7;
    float z[16], kk[16], bl[16], bref, b63; bf16x8 vch[2];
    const float lb = lbv[hh * 128 + d];
#pragma unroll
    for (int i = 0; i < 16; ++i) z[i] = zf[(size_t)(tok0 + jq * 16 + i) * 1024 + hh * 128 + d];
#pragma unroll
    for (int i = 0; i < 2; ++i) { const int id = tid + 512 * i, s = id >> 4, e8 = (id & 15) * 8; vch[i] = *(const bf16x8*)(proj + (size_t)(tok0 + s) * DINP + PC_I + hh * 128 + e8); }
    __syncthreads();
    gate_scan(lds, z, lb, d, jq, kk, bl, bref, b63);
    LAS bf16* KT = (LAS bf16*)(lds + L_KT);
#pragma unroll
    for (int i = 0; i < 16; ++i) KT[d * LD_S + jq * 16 + i] = f2bf(kk[i] * __expf(b63 - bl[i]));
    stage_vt(lds, vch, tid);
    if (jq == 0) hdec[(size_t)unit * 128 + d] = __expf(b63);
    __syncthreads();
    const LAS bf16* VT = (const LAS bf16*)(lds + L_VT);
    const int eb = wid >> 1;
#pragma unroll
    for (int q = 0; q < 2; ++q) { const int db = (wid & 1) * 2 + q; f32x16 acc = {};
        mma32(acc, VT + eb * 32 * LD_S, LD_S, KT + db * 32 * LD_S, LD_S, 64, r32, hi);
#pragma unroll
        for (int r = 0; r < 16; ++r) hu[(size_t)unit * 16384 + (size_t)(eb * 32 + crow(r, hi)) * 128 + db * 32 + r32] = acc[r]; }
}
__device__ __forceinline__ void pass2_task(int task, const float* hu, const float* hdec, bf16* hs) {
    const int bh = task >> 12, g = task & 4095, d4 = (g & 31) * 4;
    f32x4 st = {0.f, 0.f, 0.f, 0.f};
    const float* p = hu + (size_t)bh * 32 * 16384 + (size_t)g * 4;
    bf16* q = hs + (size_t)bh * 32 * 16384 + (size_t)g * 4;
    const float* dp = hdec + (size_t)bh * 32 * 128 + d4;
#pragma unroll 8
    for (int c = 0; c < 32; ++c) { const f32x4 u = *(const f32x4*)(p + (size_t)c * 16384); const f32x4 dv = *(const f32x4*)(dp + c * 128);
        u32x2 o; o.x = cvt_pk_bf16(st[0], st[1]); o.y = cvt_pk_bf16(st[2], st[3]); *(u32x2*)(q + (size_t)c * 16384) = o; st = dv * st + u; }
}
struct P3In { float z[16]; bf16 qraw[16]; bf16x8 vch[2]; float lb; };
__device__ __forceinline__ void pass3_load(P3In& R, const int tid, int unit, const float* zf, const bf16* proj, const float* lbv, const bf16* hs) {
    const int bh = unit >> 5, c = unit & 31, b = bh >> 3, hh = bh & 7, tok0 = b * SEQ + c * CHUNK;
    const unsigned d = tid & 127, jq = tid >> 7;
    const float* zb = zf + (size_t)tok0 * 1024 + hh * 128; const unsigned zo = jq * 16u * 1024u + d;
    const bf16* qb = proj + (size_t)tok0 * DINP + PC_Q + hh * 128; const unsigned qo = jq * 16u * (unsigned)DINP + d;
    const bf16* vb = proj + (size_t)tok0 * DINP + PC_I + hh * 128; const unsigned vo = ((unsigned)tid >> 4) * (unsigned)DINP + ((unsigned)tid & 15u) * 8u;
    R.lb = (lbv + hh * 128)[d];
#pragma unroll
    for (int i = 0; i < 16; ++i) R.z[i] = (zb + i * 1024)[zo];
#pragma unroll
    for (int i = 0; i < 16; ++i) R.qraw[i] = (qb + i * DINP)[qo];
#pragma unroll
    for (int i = 0; i < 2; ++i) R.vch[i] = *(const bf16x8*)((vb + 32 * i * DINP) + vo);
}
__device__ __forceinline__ void pass3_compute(LAS unsigned char* lds, const int tid, int unit, P3In& R, int next_unit, const float* zf, const bf16* proj, const float* lbv, const bf16* hs, const float* hgn, bf16* y) {
    const int wid = tid >> 6, lane = tid & 63, r32 = lane & 31, hi = lane >> 5;
    const int bh = unit >> 5, c = unit & 31, b = bh >> 3, hh = bh & 7, tok0 = b * SEQ + c * CHUNK;
    const int d = tid & 127, jq = tid >> 7;
    const int tb = wid >> 2, eb = wid & 3;
    const int tn = tid >> 3, part = tid & 7;
    float kk[16], bl[16], bref, b63;
    const float (&z)[16] = R.z; const bf16 (&qraw)[16] = R.qraw; const bf16x8 (&vch)[2] = R.vch; const float lb = R.lb;
    bf16x8 st[8]; u32x4 g0, g1;
    { const bf16* sp = hs + (size_t)unit * 16384 + (size_t)(eb * 32 + r32) * 128 + hi * 8;
#pragma unroll
      for (int k = 0; k < 8; ++k) st[k] = *(const bf16x8*)(sp + 16 * k); }
    { const bf16* gp = proj + (size_t)(tok0 + tn) * DINP + PC_G + hh * 128 + part * 16; g0 = *(const u32x4*)gp; g1 = *(const u32x4*)(gp + 8); }
    __syncthreads();
    gate_scan(lds, z, lb, d, jq, kk, bl, bref, b63);
    LAS bf16* KT = (LAS bf16*)(lds + L_KT); LAS bf16* QT = (LAS bf16*)(lds + L_QT); LAS bf16* QH = (LAS bf16*)(lds + L_QH);
    const float eref = __expf(bref);
#pragma unroll
    for (int i = 0; i < 16; ++i) { const int t = jq * 16 + i;
        const float qv = bf2f(qraw[i]), er = __expf(bl[i] - bref);
        QT[t * LD_D + d] = f2bf(qv * er);
        QH[t * LD_D + d] = f2bf(qv * (er * eref));
        KT[t * LD_D + d] = f2bf(kk[i] * __builtin_amdgcn_rcpf(er)); }
    stage_vt(lds, vch, tid);
    if (next_unit >= 0) pass3_load(R, tid, next_unit, zf, proj, lbv, hs);
    __syncthreads();
    LAS bf16* PL = (LAS bf16*)(lds + L_P);
    if (wid < 4) {
        const int tb2 = wid >> 1, sb = wid & 1; f32x16 acc = {};
        if (!(tb2 == 0 && sb == 1)) mma32(acc, QT + tb2 * 32 * LD_D, LD_D, KT + sb * 32 * LD_D, LD_D, 128, r32, hi);
#pragma unroll
        for (int r = 0; r < 16; ++r) { const int t = tb2 * 32 + crow(r, hi), s2 = sb * 32 + r32; PL[t * LD_S + s2] = f2bf(s2 <= t ? acc[r] : 0.f); }
    }
    __syncthreads();
    {
        f32x16 acc = {};
        mma32(acc, PL + tb * 32 * LD_S, LD_S, (const LAS bf16*)(lds + L_VT) + eb * 32 * LD_S, LD_S, 64, r32, hi);
#pragma unroll
        for (int k = 0; k < 8; ++k) {
            const bf16x8 a = *(const LAS bf16x8*)(QH + (tb * 32 + r32) * LD_D + 16 * k + hi * 8);
            acc = __builtin_amdgcn_mfma_f32_32x32x16_bf16(a, st[k], acc, 0, 0, 0);
        }
        LAS float* OL = (LAS float*)(lds + L_O);
#pragma unroll
        for (int r = 0; r < 16; ++r) OL[(tb * 32 + crow(r, hi)) * LD_O + eb * 32 + r32] = acc[r];
    }
    __syncthreads();
    {
        const LAS float* orow = (const LAS float*)(lds + L_O) + tn * LD_O + part * 16;
        float v[16]; float ss = 0.f;
#pragma unroll
        for (int i = 0; i < 16; ++i) { v[i] = orow[i]; ss += v[i] * v[i]; }
        ss += shflx(ss, 1, lane); ss += shflx(ss, 2, lane); ss += shflx(ss, 4, lane);
        const float rs = rsqrtf(ss * (1.0f / 128.0f) + EPS);
        const unsigned gw[8] = {g0.x, g0.y, g0.z, g0.w, g1.x, g1.y, g1.z, g1.w};
        float ov[16];
#pragma unroll
        for (int i = 0; i < 8; ++i) { const float ga = bflo(gw[i]), gb = bfhi(gw[i]);
            ov[2 * i] = v[2 * i] * rs * hgn[part * 16 + 2 * i] * (ga * HG_SIGMOID(ga));
            ov[2 * i + 1] = v[2 * i + 1] * rs * hgn[part * 16 + 2 * i + 1] * (gb * HG_SIGMOID(gb)); }
        bf16* yp = y + (size_t)(tok0 + tn) * 3072 + hh * 128 + part * 16;
        u32x4 w0, w1;
        w0.x = cvt_pk_bf16(ov[0], ov[1]); w0.y = cvt_pk_bf16(ov[2], ov[3]); w0.z = cvt_pk_bf16(ov[4], ov[5]); w0.w = cvt_pk_bf16(ov[6], ov[7]);
        w1.x = cvt_pk_bf16(ov[8], ov[9]); w1.y = cvt_pk_bf16(ov[10], ov[11]); w1.z = cvt_pk_bf16(ov[12], ov[13]); w1.w = cvt_pk_bf16(ov[14], ov[15]);
        *(u32x4*)yp = w0; *(u32x4*)(yp + 8) = w1;
    }
}
__device__ __forceinline__ void pass3_unit(LAS unsigned char* lds, const int tid, int unit, const float* zf, const bf16* proj, const float* lbv, const bf16* hs, const float* hgn, bf16* y) {
    P3In R; pass3_load(R, tid, unit, zf, proj, lbv, hs); pass3_compute(lds, tid, unit, R, -1, zf, proj, lbv, hs, hgn, y);
}
}

struct TDesc { const float* src; bf16* dst; const float* gain; size_t sstride, dstride; int gstride, nbatch, K, ld, Ndst, map; float f8scale; };
enum { MAP_ID = 0, MAP_WIN = 1, MAP_QUP = 2, MAP_GU_D = 3, MAP_GU_E = 4, MAP_GATE = 5 };
__device__ __forceinline__ int src_col(int map, int n) {
    switch (map) {
    case MAP_WIN:
        if (n < PC_KR) return n;
        if (n < PC_KR + 64) { const int p = n - PC_KR; return 5120 + (p & 1) * 32 + (p >> 1); }
        if (n < PC_QM) return -1;
        return n - 192;
    case MAP_QUP: { const int hd = n / QKD, c = n % QKD; if (c < NOPE) return n; const int p = c - NOPE; return hd * QKD + NOPE + (p & 1) * 32 + (p >> 1); }
    case MAP_GU_D: { const int t = n >> 8, r = n & 255; return r < 128 ? 128 * t + r : FF + 128 * t + (r - 128); }
    case MAP_GATE: return n + 6208;
    case MAP_GU_E: { const int t = n >> 8, r = n & 255; return r < 128 ? 128 * t + r : FFE + 128 * t + (r - 128); }
    default: return n;
    }
}
__device__ __forceinline__ void transpose_item(const TDesc& D, int item, LAS float* scr, int lane) {
    const int nblk = D.Ndst / 32, per = (D.K / 64) * nblk, bt = item / per, r = item % per, kb = r / nblk, nb = r % nblk, k0 = 64 * kb, n0 = 32 * nb;
    const float* W = D.src + (size_t)bt * D.sstride; bf16* WT = D.dst + (size_t)bt * D.dstride; const float* gn = D.gain ? D.gain + (size_t)bt * D.gstride : nullptr;
    const int sc = src_col(D.map, n0 + (lane & 31));
    const float msk = sc < 0 ? 0.f : 1.f;
    const float* wp = W + (size_t)(k0 + (lane >> 5)) * D.ld + (sc < 0 ? 0 : sc);
    float v[32];
#pragma unroll
    for (int i = 0; i < 32; ++i) v[i] = __builtin_nontemporal_load(wp + (size_t)(2 * i) * D.ld);
#pragma unroll
    for (int i = 0; i < 32; ++i) scr[(2 * i + (lane >> 5)) * 33 + (lane & 31)] = v[i] * msk;
    LDS_WAIT(); asm volatile("" ::: "memory");
    const int c = lane & 7;
    f32x4 g0 = {1.f, 1.f, 1.f, 1.f}, g1 = g0;
    if (gn) { g0 = *(const f32x4*)(gn + k0 + 8 * c); g1 = *(const f32x4*)(gn + k0 + 8 * c + 4); }
    if (D.f8scale != 0.f) {
        g0 = g0 * D.f8scale; g1 = g1 * D.f8scale; unsigned char* W8 = (unsigned char*)D.dst + (size_t)bt * D.dstride;
#pragma unroll
        for (int j = 0; j < 4; ++j) { const int n = (lane >> 3) + 8 * j; const LAS float* s = scr + (8 * c) * 33 + n;
            const f32x4 a = {s[0 * 33] * g0[0], s[1 * 33] * g0[1], s[2 * 33] * g0[2], s[3 * 33] * g0[3]}, b = {s[4 * 33] * g1[0], s[5 * 33] * g1[1], s[6 * 33] * g1[2], s[7 * 33] * g1[3]};
            *(u32x2*)(W8 + (size_t)(n0 + n) * D.K + k0 + 8 * c) = pack8_f8(a, b); }
    } else {
#pragma unroll
    for (int j = 0; j < 4; ++j) { const int n = (lane >> 3) + 8 * j; const LAS float* s = scr + (8 * c) * 33 + n;
        u32x4 o; o.x = cvt_pk_bf16(s[0 * 33] * g0[0], s[1 * 33] * g0[1]); o.y = cvt_pk_bf16(s[2 * 33] * g0[2], s[3 * 33] * g0[3]);
        o.z = cvt_pk_bf16(s[4 * 33] * g1[0], s[5 * 33] * g1[1]); o.w = cvt_pk_bf16(s[6 * 33] * g1[2], s[7 * 33] * g1[3]);
        *(u32x4*)(WT + (size_t)(n0 + n) * D.K + k0 + 8 * c) = o; }
    }
    LDS_WAIT(); asm volatile("" ::: "memory");
}
constexpr int TL_LD = 260, TL_K = 128, TL_RW = TL_K / 8;
__device__ __forceinline__ void tl_decode(const TDesc& D, int tile, int& bt, int& k0, int& n0) {
    const int nblk = D.Ndst / 256, per = (D.K / TL_K) * nblk; bt = tile / per; const int r = tile % per; k0 = TL_K * (r / nblk); n0 = 256 * (r % nblk);
}
__device__ __forceinline__ void tl_load(const TDesc& D, int tile, f32x4 (&v)[TL_RW], int wave, int lane) {
    int bt, k0, n0; tl_decode(D, tile, bt, k0, n0);
    const int sc = src_col(D.map, n0 + 4 * lane);
    const float* wp = D.src + (size_t)bt * D.sstride + (size_t)(k0 + wave * TL_RW) * D.ld + sc;
#pragma unroll
    for (int i = 0; i < TL_RW; ++i) v[i] = __builtin_nontemporal_load((const f32x4*)(wp + (size_t)i * D.ld));
}
__device__ __forceinline__ void tl_store(const TDesc& D, int tile, const f32x4 (&v)[TL_RW], LAS float* scr, int tid, int wave, int lane) {
    int bt, k0, n0; tl_decode(D, tile, bt, k0, n0);
#pragma unroll
    for (int i = 0; i < TL_RW; ++i) *(LAS f32x4*)(scr + (wave * TL_RW + i) * TL_LD + 4 * lane) = v[i];
    __syncthreads();
    constexpr int HK = TL_K / 2;
    const int n = tid >> 1, h = tid & 1; const LAS float* s = scr + (HK * h) * TL_LD + n;
    const float* gn = D.gain ? D.gain + (size_t)bt * D.gstride + k0 + HK * h : nullptr;
    const float sc = D.f8scale != 0.f ? D.f8scale : 1.0f;
#pragma unroll
    for (int p = 0; p < HK / 16; ++p) {
        f32x4 x[4];
#pragma unroll
        for (int q = 0; q < 4; ++q) { f32x4 g = {sc, sc, sc, sc}; if (gn) g = g * *(const f32x4*)(gn + 16 * p + 4 * q);
            const LAS float* sq = s + (16 * p + 4 * q) * TL_LD;
            x[q] = (f32x4){sq[0] * g[0], sq[TL_LD] * g[1], sq[2 * TL_LD] * g[2], sq[3 * TL_LD] * g[3]}; }
        if (D.f8scale != 0.f) {
            unsigned char* W8 = (unsigned char*)D.dst + (size_t)bt * D.dstride + (size_t)(n0 + n) * D.K + k0 + HK * h + 16 * p;
            const u32x2 a = pack8_f8(x[0], x[1]), b = pack8_f8(x[2], x[3]);
            *(u32x4*)W8 = (u32x4){a.x, a.y, b.x, b.y};
        } else {
            bf16* WT = D.dst + (size_t)bt * D.dstride + (size_t)(n0 + n) * D.K + k0 + HK * h + 16 * p;
            *(u32x4*)WT = pack8(x[0], x[1]); *(u32x4*)(WT + 8) = pack8(x[2], x[3]);
        }
    }
    __syncthreads();
}
__device__ __forceinline__ float row_to_bf16(const float* xrow, bf16* orow, const float* gain, bool normalize, int lane, unsigned char* o8 = nullptr) {
    f32x4 v[8]; float s = 0.f;
#pragma unroll
    for (int j = 0; j < 8; ++j) { v[j] = *(const f32x4*)(xrow + 4 * lane + 256 * j); s += (v[j][0] * v[j][0] + v[j][1] * v[j][1]) + (v[j][2] * v[j][2] + v[j][3] * v[j][3]); }
    s = wave_sum(s, lane);
    const float rs = normalize ? rsqrtf(s * (1.0f / DM) + EPS) : 1.0f;
#pragma unroll
    for (int j = 0; j < 8; ++j) { f32x4 w = v[j] * rs; if (gain) w = w * *(const f32x4*)(gain + 4 * lane + 256 * j);
        u32x2 o; o.x = cvt_pk_bf16(w[0], w[1]); o.y = cvt_pk_bf16(w[2], w[3]); *(u32x2*)(orow + 4 * lane + 256 * j) = o;
        if (o8) { const f32x4 z = w * F8_H; int q = 0; q = __builtin_amdgcn_cvt_pk_fp8_f32(clamp448(z[0]), clamp448(z[1]), q, false); q = __builtin_amdgcn_cvt_pk_fp8_f32(clamp448(z[2]), clamp448(z[3]), q, true); *(int*)(o8 + 4 * lane + 256 * j) = q; } }
    return s;
}

struct Args { const void* in[22]; float* out; unsigned char* ws; int ph_lo, ph_hi; };
static_assert(sizeof(Args) == 200 && offsetof(Args, out) == 176 && offsetof(Args, ws) == 184, "Args layout");
constexpr int PH_FINAL = 19, N_PHASES = 20;

__global__ void __launch_bounds__(NTHR, 2) trunk_fwd(Args args) {
    extern __shared__ __attribute__((aligned(16))) unsigned char lds_raw[];
    LAS unsigned char* lds = (LAS unsigned char*)lds_raw;
    const int wave0 = __builtin_amdgcn_readfirstlane((int)threadIdx.x >> 6);
#define PHASE_IDS int tid = wave0 * 64 + lane_id(); const CAS char* kargs = (const CAS char*)__builtin_amdgcn_kernarg_segment_ptr(); asm volatile("" : "+s"(kargs)); \
    GAS unsigned char* wsg = *(GAS unsigned char* const CAS*)(kargs + 184); int G = gridDim.x, bx = blockIdx.x; asm volatile("" : "+v"(tid), "+s"(wsg), "+s"(G), "+s"(bx)); unsigned char* wsl = (unsigned char*)wsg; const int lane = tid & 63, wave = __builtin_amdgcn_readfirstlane(tid >> 6); (void)lane; (void)wave
    unsigned* ctl = (unsigned*)(args.ws + WS_CTL);
    XcdBarrier bar; bar.bar = ctl + CW_BAR; bar.x = 0; bar.st = nullptr; bar.nloc = 0u; bar.nx = 0u;
    const int lo = args.ph_lo, hi = args.ph_hi;
    const bool multi = (hi - lo) > 1;
    if (multi) bar = xcd_barrier_post(ctl + CW_BAR, nullptr, wave0 * 64 + lane_id());
#define IN(k) (lo <= (k) && (k) < hi && ((k) <= MK_LAST_PHASE || (k) == PH_FINAL))
#ifndef MK_KIND_MASK
#define MK_KIND_MASK 0xFFFFFFFFu
#endif
#define KIND(k) ((MK_KIND_MASK >> (k)) & 1u)
#ifndef MK_PROBE_MFMA
#define MK_PROBE_MFMA 0
#endif
#ifndef MK_REPEAT_MASK
#define MK_REPEAT_MASK (MK_PROBE_MODE >= 0 ? (1u << 7) : 0u)
#endif
#define NREP(k) (((MK_REPEAT_MASK >> (k)) & 1u) ? 2 : 1)
#define SEAM(k) do { if (IN(k) && (k) + 1 < hi) xcd_barrier(bar, wave0 * 64 + lane_id()); } while (0)

#define X_IN ((const float*)(*(const GAS float* const CAS*)(kargs + 0)))
#define MEM_IN ((const float*)(*(const GAS float* const CAS*)(kargs + 8)))
#define positions ((const int*)(*(const GAS int* const CAS*)(kargs + 16)))
#define hg_lb ((const float*)(*(const GAS float* const CAS*)(kargs + 24)))
#define attn_norm ((const float*)(*(const GAS float* const CAS*)(kargs + 32)))
#define w_in ((const float*)(*(const GAS float* const CAS*)(kargs + 40)))
#define hg_norm ((const float*)(*(const GAS float* const CAS*)(kargs + 48)))
#define mla_q_norm ((const float*)(*(const GAS float* const CAS*)(kargs + 56)))
#define w_q_up ((const float*)(*(const GAS float* const CAS*)(kargs + 64)))
#define mla_kv_norm ((const float*)(*(const GAS float* const CAS*)(kargs + 72)))
#define w_kv_up ((const float*)(*(const GAS float* const CAS*)(kargs + 80)))
#define mem_norm ((const float*)(*(const GAS float* const CAS*)(kargs + 88)))
#define w_mem_kv ((const float*)(*(const GAS float* const CAS*)(kargs + 96)))
#define w_branch ((const float*)(*(const GAS float* const CAS*)(kargs + 104)))
#define w_o ((const float*)(*(const GAS float* const CAS*)(kargs + 112)))
#define ffn_norm ((const float*)(*(const GAS float* const CAS*)(kargs + 120)))
#define w_dense_gu ((const float*)(*(const GAS float* const CAS*)(kargs + 128)))
#define w_dense_down ((const float*)(*(const GAS float* const CAS*)(kargs + 136)))
#define w_router ((const float*)(*(const GAS float* const CAS*)(kargs + 144)))
#define w_expert_gu ((const float*)(*(const GAS float* const CAS*)(kargs + 152)))
#define w_expert_down ((const float*)(*(const GAS float* const CAS*)(kargs + 160)))
#define final_norm ((const float*)(*(const GAS float* const CAS*)(kargs + 168)))
#define RSRC wsl
#define WIN ((bf16*)(wsl + WS_WIN))
#define WMKV ((bf16*)(wsl + WS_WMKV))
#define WQUP ((bf16*)(wsl + WS_WQUP))
#define WKVUP ((bf16*)(wsl + WS_WKVUP))
#define WBR ((bf16*)(wsl + WS_WBR))
#define WO ((bf16*)(wsl + WS_WO))
#define WGU ((bf16*)(wsl + WS_WGU))
#define WDN ((bf16*)(wsl + WS_WDN))
#define WEGU ((bf16*)(wsl + WS_WEGU))
#define WEDN ((bf16*)(wsl + WS_WEDN))
#define H ((float*)(wsl + WS_H))
#define HB ((bf16*)(wsl + WS_HB))
#define PROJ ((bf16*)(wsl + WS_PROJ))
#define ZF ((float*)(wsl + WS_ZF))
#define MEMN ((bf16*)(wsl + WS_MEMN))
#define MKV ((bf16*)(wsl + WS_MKV))
#define QMLA ((bf16*)(wsl + WS_QMLA))
#define KVB ((bf16*)(wsl + WS_KVB))
#define Y ((bf16*)(wsl + WS_Y))
#define HU ((float*)(wsl + WS_HU))
#define HDEC ((float*)(wsl + WS_HDEC))
#define MRG ((float*)(wsl + WS_MRG))
#define MRGB ((bf16*)(wsl + WS_MRGB))
#define ACT ((bf16*)(wsl + WS_ACT))
#define XS ((bf16*)(wsl + WS_XS))
#define ACTE ((bf16*)(wsl + WS_ACTE))
#define YS ((float*)(wsl + WS_YS))
#define COS ((float*)(wsl + WS_COS))
#define SIN ((float*)(wsl + WS_SIN))
#define LB ((float*)(wsl + WS_LB))
#define SSQA0 ((u64*)(wsl + WS_SSQA0))
#define TOPI ((int*)(wsl + WS_TOPI))
#define TOPW ((float*)(wsl + WS_TOPW))
#define RASS ((int*)(wsl + WS_RASS))
#define TEXP ((int*)(wsl + WS_TEXP))
#define SSQ ((u64*)(wsl + CB_SSQ))
#define BLKCNT ((int*)(wsl + CB_BLKCNT))

    if (KIND(0) && IN(0)) for (int rep = 0; rep < NREP(0); ++rep) { PHASE_IDS;
        LAS float* scr = (LAS float*)(lds + wave * 16384);
        const int gw = bx * NWAVES + wave, NGW = G * NWAVES;
#define TDESC(i) ((i) == 0 ? TDesc{w_in, WIN, attn_norm, (size_t)DM * DIN, (size_t)DINP * DM, DM, 2, DM, DIN, MK_GATE_F8 ? 6400 : DINP, MAP_WIN, 0.f} : \
                  (i) == 1 ? TDesc{w_mem_kv, WMKV, nullptr, (size_t)DM * 2048, (size_t)2048 * DM, 0, 2, DM, 2048, 2048, MAP_ID, 0.f} : \
                  (i) == 2 ? TDesc{w_q_up, WQUP, mla_q_norm, (size_t)512 * 1536, (size_t)1536 * 512, 512, 2, 512, 1536, 1536, MAP_QUP, 0.f} : \
                  (i) == 3 ? TDesc{w_kv_up, WKVUP, mla_kv_norm, (size_t)512 * 2048, (size_t)2048 * 512, 512, 2, 512, 2048, 2048, MAP_ID, 0.f} : \
                  (i) == 4 ? TDesc{w_branch, WBR, nullptr, (size_t)1024 * 2048, (size_t)2048 * 1024, 0, 6, 1024, 2048, 2048, MAP_ID, 0.f} : \
                  (i) == 5 ? TDesc{w_o, WO, nullptr, (size_t)DM * DM, (size_t)DM * DM, 0, 2, DM, DM, DM, MAP_ID, 0.f} : \
                  (i) == 6 ? TDesc{w_dense_gu, WGU, ffn_norm, 0, 0, 0, 1, DM, 2 * FF, 2 * FF, MAP_GU_D, MK_P7_F8 ? F8_WGU : 0.f} : \
                  (i) == 7 ? TDesc{w_dense_down, WDN, nullptr, 0, 0, 0, 1, FF, DM, DM, MAP_ID, MK_P8_F8 ? F8_WDN : 0.f} : \
                  (i) == 8 ? TDesc{w_expert_gu, WEGU, ffn_norm + DM, (size_t)DM * 2 * FFE, (size_t)2 * FFE * DM, 0, 8, DM, 2 * FFE, 2 * FFE, MAP_GU_E, MK_MOE_F8 ? F8_WGU : 0.f} : \
                             TDesc{w_expert_down, WEDN, nullptr, (size_t)FFE * DM, (size_t)DM * FFE, 0, 8, FFE, DM, DM, MAP_ID, MK_MOE_F8 ? F8_WDN : 0.f})
        constexpr int F8K = 64;
        constexpr int cnt[10] = {2 * (DM / 64) * ((MK_GATE_F8 ? 6400 : DINP) / 32), 2 * (DM / 64) * (2048 / 32), 2 * (512 / 64) * (1536 / 32), 2 * (512 / 64) * (2048 / 32), 6 * (1024 / 64) * (2048 / 32), 2 * (DM / 64) * (DM / 32),
                                 (DM / 64) * (2 * FF / 32), (FF / 64) * (DM / 32), 8 * (DM / F8K) * (2 * FFE / 32), 8 * (FFE / F8K) * (DM / 32)};
        int total = 0;
#pragma unroll
        for (int i = 0; i < 8; ++i) total += cnt[i];
        for (int it = gw; it < total; it += NGW) {
            int r = it;
#pragma unroll
            for (int i = 0; i < 8; ++i) { if (r >= 0 && r < cnt[i]) { const TDesc D = TDESC(i); transpose_item(D, r, scr, lane); r = -1; } else if (r >= 0) r -= cnt[i]; }
        }
        __syncthreads();
        {
            LAS float* tscr = (LAS float*)lds;
            constexpr int NT8 = 8 * (DM / TL_K) * (2 * FFE / 256), NT9 = 8 * (FFE / TL_K) * (DM / 256) + (MK_GATE_F8 ? 2 * (DM / TL_K) * (6144 / 256) : 0);
            constexpr int NT9E = 8 * (FFE / TL_K) * (DM / 256);
            const TDesc D8 = TDESC(8), D9e = TDESC(9);
            const TDesc DG = TDesc{w_in, (bf16*)(wsl + WS_WIN8), attn_norm, (size_t)DM * DIN, (size_t)6144 * DM, DM, 2, DM, DIN, 6144, MAP_GATE, F8_WIN};
            f32x4 va[TL_RW], vb[TL_RW];
            constexpr int NTT = NT8 + NT9;
#define TL_LOAD(tt, buf) do { if ((tt) < NTT) { if ((tt) < NT8) tl_load(D8, (tt), buf, wave, lane); else if ((tt) < NT8 + NT9E) tl_load(D9e, (tt) - NT8, buf, wave, lane); else tl_load(DG, (tt) - NT8 - NT9E, buf, wave, lane); } } while (0)
#define TL_STORE(tt, buf) do { if ((tt) < NTT) { if ((tt) < NT8) tl_store(D8, (tt), buf, tscr, tid, wave, lane); else if ((tt) < NT8 + NT9E) tl_store(D9e, (tt) - NT8, buf, tscr, tid, wave, lane); else tl_store(DG, (tt) - NT8 - NT9E, buf, tscr, tid, wave, lane); } } while (0)
            int t = bx;
            TL_LOAD(t, va);
            for (; t < NTT; t += 2 * G) {
                TL_LOAD(t + G, vb); TL_STORE(t, va);
                TL_LOAD(t + 2 * G, va); TL_STORE(t + G, vb);
            }
#undef TL_LOAD
#undef TL_STORE
        }
        for (int m0 = gw; m0 < NTOK; m0 += 4 * NGW) {
            f32x4 xv[4][8];
#pragma unroll
            for (int r = 0; r < 4; ++r) { const int m = m0 + r * NGW; if (m < NTOK) {
#pragma unroll
                for (int j = 0; j < 8; ++j) xv[r][j] = __builtin_nontemporal_load((const f32x4*)(X_IN + (size_t)m * DM + 4 * lane + 256 * j)); } }
#pragma unroll
            for (int r = 0; r < 4; ++r) { const int m = m0 + r * NGW; if (m < NTOK) { float sx = 0.f;
#pragma unroll
                for (int j = 0; j < 8; ++j) { const f32x4 w = xv[r][j]; sx += (w[0] * w[0] + w[1] * w[1]) + (w[2] * w[2] + w[3] * w[3]);
                    u32x2 o; o.x = cvt_pk_bf16(w[0], w[1]); o.y = cvt_pk_bf16(w[2], w[3]); *(u32x2*)(HB + (size_t)m * DM + 4 * lane + 256 * j) = o;
                    if (MK_GATE_F8) { const f32x4 z = w * F8_H; int q = 0; q = __builtin_amdgcn_cvt_pk_fp8_f32(clamp448(z[0]), clamp448(z[1]), q, false); q = __builtin_amdgcn_cvt_pk_fp8_f32(clamp448(z[2]), clamp448(z[3]), q, true); *(int*)(wsl + WS_HB8 + (size_t)m * DM + 4 * lane + 256 * j) = q; } }
                sx = wave_sum(sx, lane); if (lane == 0) SSQA0[m] = ssq_fix(sx); } }
        }
        for (int m = gw; m < NBATCH * NMEM; m += NGW) (void)row_to_bf16(MEM_IN + (size_t)m * DM, MEMN + (size_t)m * DM, mem_norm, true, lane);
        for (int i = bx * NTHR + tid; i < NTOK * 32; i += G * NTHR) { const int tok = i >> 5, j = i & 31;
            const float inv = powf(10000.0f, -((float)j / 32.0f)); const float ang = (float)positions[tok] * inv; COS[i] = cosf(ang); SIN[i] = sinf(ang); }
        for (int i = bx * NTHR + tid; i < 1024; i += G * NTHR) { const float l0 = hg_lb[i], l1 = hg_lb[1024 + i], mx = fmaxf(l0, l1), e0 = expf(l0 - mx), e1 = expf(l1 - mx);
            const float s0 = e0 / (e0 + e1), s1 = e1 / (e0 + e1); LB[i] = 0.f; LB[1024 + i] = fminf(fmaxf((s0 + s1) - s0, 0.f), 1.f); }
    }
    SEAM(0);

    for (int l = 0; l < 2; ++l) {
        const int pb = 1 + 8 * l;
#define ssq_attn ((l == 0) ? SSQA0 : SSQ + SSQ_A1 * NTOK)
#define ssq_cq (SSQ + (l == 0 ? SSQ_CQ0 : SSQ_CQ1) * NTOK)
#define ssq_ckv (SSQ + (l == 0 ? SSQ_CKV0 : SSQ_CKV1) * NTOK)
#define ssq_ffn (SSQ + (l == 0 ? SSQ_F0 : SSQ_F1) * NTOK)
#define lbv (LB + l * 1024)
        if (KIND(1) && IN(pb + 0)) for (int rep = 0; rep < NREP(1); ++rep) { PHASE_IDS;
            const bool deal = (G == 256);
            if (MK_GATE_F8) {
                SchedIn S{(unsigned)WS_HB, (unsigned)(WS_WIN + (size_t)l * DINP * DM * 2), (unsigned)WS_MEMN, (unsigned)(WS_WMKV + (size_t)l * 2048 * DM * 2), G, bx, deal ? 24 : 25, !deal};
                EpiIn E{wsl, l, rep == 0};
                pg8::gemm_run<EpiIn, SchedIn>(lds, tid, RSRC, DM, DM, DM, S, E);
                SchedPlain S8{(unsigned)WS_HB8, (unsigned)(WS_WIN8 + (size_t)l * 6144 * DM), 32, 24, G, bx, 256u * DM, 256u * DM};
                EpiGateLogit E8{wsl, l};
                pg8::gemm_run<EpiGateLogit, SchedPlain, true, true>(lds, tid, RSRC, DM / 2, DM / 2, DM / 2, S8, E8);
            } else {
                SchedIn S{(unsigned)WS_HB, (unsigned)(WS_WIN + (size_t)l * DINP * DM * 2), (unsigned)WS_MEMN, (unsigned)(WS_WMKV + (size_t)l * 2048 * DM * 2), G, bx, deal ? 48 : 49, !deal};
                EpiIn E{wsl, l, rep == 0};
                pg8::gemm_run<EpiIn, SchedIn>(lds, tid, RSRC, DM, DM, DM, S, E);
            }
        }
        SEAM(pb + 0);
        if (KIND(2) && IN(pb + 1)) for (int rep = 0; rep < NREP(2); ++rep) { PHASE_IDS;
            SchedUp S{(unsigned)WS_PROJ, (unsigned)(WS_WQUP + (size_t)l * 1536 * 512 * 2), (unsigned)(WS_WKVUP + (size_t)l * 2048 * 512 * 2), G, bx};
            EpiUp E{wsl, l};
            pg8::gemm_run<EpiUp, SchedUp>(lds, tid, RSRC, 512, DINP, 512, S, E);
            if (G == 256) {
                SchedIn2 S2{(unsigned)WS_HB, (unsigned)(WS_WIN + (size_t)l * DINP * DM * 2), (unsigned)WS_MEMN, (unsigned)(WS_WMKV + (size_t)l * 2048 * DM * 2), G, bx, MK_GATE_F8 ? 24 : 48};
                EpiIn E2{wsl, l, false};
                pg8::gemm_run<EpiIn, SchedIn2>(lds, tid, RSRC, DM, DM, DM, S2, E2);
                if (bx >= 192) hg::pass1_unit(lds, tid, bx - 192, ZF, PROJ, lbv, HU, HDEC);
                else for (int j = 0; j < 5; ++j) hg::pass1_unit(lds, tid, 64 + bx + 192 * j, ZF, PROJ, lbv, HU, HDEC);
            } else for (int u = (G - 1 - bx); u < 1024; u += G) hg::pass1_unit(lds, tid, u, ZF, PROJ, lbv, HU, HDEC);
        }
        SEAM(pb + 1);
        if (KIND(3) && IN(pb + 2)) for (int rep = 0; rep < NREP(3); ++rep) { PHASE_IDS;
            const float c_mla = 0.07216878364870322f * 1.4426950408889634f, c_mem = 0.0625f * 1.4426950408889634f;
            for (int vc = bx; vc < 256; vc += G) {
                int nm = 0, q_a = 0, q_b = 0, bh = 0;
                if (vc < 32) { nm = 1; bh = vc; q_a = 7; }
                else if (vc < 64) { nm = 1; bh = vc - 32; q_a = 6; }
                else if (vc < 96) { nm = 2; bh = vc - 64; q_a = 5; q_b = 1; }
                else if (vc < 128) { nm = 2; bh = vc - 96; q_a = 4; q_b = 2; }
                else if (vc < 160) { nm = 2; bh = vc - 128; q_a = 3; q_b = 0; }
#ifndef NO_MLA
                for (int k = 0; k < nm; ++k) { const int b = bh >> 3, h = bh & 7, qb = k ? q_b : q_a; const size_t t0 = (size_t)b * SEQ;
                    att::attn_unit<QKD, NOPE, true>(lds, tid, QMLA + (t0 + qb * 256) * 1536 + h * QKD, 1536, KVB + t0 * 2048 + h * 256, 2048, PROJ + t0 * DINP + PC_KR, DINP,
                                                    KVB + t0 * 2048 + h * 256 + 128, 2048, Y + (t0 + qb * 256) * 3072 + 1024 + h * 128, 3072, 4 * (qb + 1), qb * 256, c_mla); }
#endif
            }
            { int tid2 = tid; asm volatile("" : "+v"(tid2));
            for (int vc = bx; vc < 256; vc += G) {
                int nx = 0, x_a = 0, x_b = 0;
                if (vc >= 32 && vc < 64) { nx = 1; x_a = vc - 32; }
                else if (vc >= 128 && vc < 160) { nx = 2; x_a = 32 + 2 * (vc - 128); x_b = x_a + 1; }
                else if (vc >= 160) { const int j = vc - 160; nx = (j < 64) ? 2 : 1; x_a = 96 + j; x_b = 192 + j; }
#ifndef NO_MEM
                for (int k = 0; k < nx; ++k) { const int uu = k ? x_b : x_a, half = uu & 1, qb = (uu >> 1) & 7, bh = uu >> 4, b = bh >> 2, h = bh & 3; const size_t t0 = (size_t)b * SEQ;
                    att::attn_unit<MEMD, MEMD, false>(lds, tid2, PROJ + (t0 + qb * 256) * DINP + PC_QM + h * 256, DINP, MKV + (size_t)b * 256 * 2048 + h * 256, 2048, nullptr, 0,
                                                      MKV + (size_t)b * 256 * 2048 + 1024 + h * 256 + half * 128, 2048, Y + (t0 + qb * 256) * 3072 + 2048 + h * 256 + half * 128, 3072, 4, 0, c_mem); }
#endif
            } }
#ifndef NO_P2
            if (rep == 0) { int tid3 = tid; asm volatile("" : "+v"(tid3));
            for (int vc = bx; vc < 256; vc += G) if (vc >= 160) { for (int task = (vc - 160) * NTHR + tid3; task < 32 * 4096; task += 96 * NTHR) hg::pass2_task(task, HU, HDEC, (bf16*)(wsl + WS_HS)); } }
#endif
        }
        SEAM(pb + 2);
        if (KIND(4) && IN(pb + 3)) { PHASE_IDS; const int NU = 1024 * NREP(4);
            hg::P3In ra; int u = bx;
            hg::pass3_load(ra, tid, u & 1023, ZF, PROJ, lbv, (const bf16*)(wsl + WS_HS));
            for (; u < NU; u += G) { int tid_u = tid; asm volatile("" : "+v"(tid_u));
                hg::pass3_compute(lds, tid_u, u & 1023, ra, (u + G < NU) ? ((u + G) & 1023) : -1, ZF, PROJ, lbv, (const bf16*)(wsl + WS_HS), hg_norm + l * 128, Y); } }
        SEAM(pb + 3);
        if (KIND(5) && IN(pb + 4)) for (int rep = 0; rep < NREP(5); ++rep) { PHASE_IDS;
            SchedGate S{(unsigned)WS_Y, (unsigned)(WS_WBR + (size_t)l * 3 * 2048 * 1024 * 2), G, bx};
            EpiGate E{wsl};
            pg8::gemm_run<EpiGate, SchedGate>(lds, tid, RSRC, 1024, 3072, 1024, S, E);
        }
        SEAM(pb + 4);
        if (KIND(6) && IN(pb + 5)) { PHASE_IDS;
            SchedPlain S{(unsigned)WS_MRGB, (unsigned)(WS_WO + (size_t)l * DM * DM * 2), 32, 8, G, bx, 256u * DM * 2u, 256u * DM * 2u};
            EpiRes E{wsl, l == 0 ? SSQ_F0 : SSQ_F1, MK_P7_F8 && l == 0};
            pg8::gemm_run<EpiRes, SchedPlain>(lds, tid, RSRC, DM, DM, DM, S, E);
        }
        SEAM(pb + 5);
        if (l == 0) {
            if (KIND(7) && IN(7)) for (int rep = 0; rep < NREP(7); ++rep) { PHASE_IDS;
                if ((MK_P7_F8 || MK_P8_F8) && MK_PROBE_MODE < 0) {
                    EpiSwiglu<true, MK_P7_F8 != 0, MK_P8_F8 != 0> E8{wsl, (unsigned)WS_ACT, FF, SSQ_F0};
                    if (MK_P7_F8) { SchedPlain S8{(unsigned)WS_HB8, (unsigned)WS_WGU, 32, 44, G, bx, 256u * DM, 256u * DM};
                        pg8::gemm_run<EpiSwiglu<true, MK_P7_F8 != 0, MK_P8_F8 != 0>, SchedPlain, true, MK_P7_F8 != 0>(lds, tid, RSRC, DM / 2, DM / 2, DM / 2, S8, E8); }
                    else { SchedPlain S8{(unsigned)WS_HB, (unsigned)WS_WGU, 32, 44, G, bx, 256u * DM * 2u, 256u * DM * 2u};
                        pg8::gemm_run<EpiSwiglu<true, MK_P7_F8 != 0, MK_P8_F8 != 0>, SchedPlain, true, MK_P7_F8 != 0>(lds, tid, RSRC, DM, DM, DM, S8, E8); }
                    continue; }
                SchedPlain S{(unsigned)WS_HB, (unsigned)WS_WGU, 32, 44, G, bx, 256u * DM * 2u, 256u * DM * 2u};
                EpiSwiglu<true> E{wsl, (unsigned)WS_ACT, FF, SSQ_F0};
                if (MK_PROBE_MODE == 8 && rep == 0) { EpiSwiglu<false> EN{wsl, (unsigned)WS_ACT, FF, SSQ_F0}; pg8::gemm_run<EpiSwiglu<false>, SchedPlain, true, false, 0>(lds, tid, RSRC, 128, DM, DM, S, EN); }
                else if (MK_PROBE_MODE == 9 && rep == 0) { EpiSwiglu<true> EN{wsl, 1u, FF, SSQ_F0}; pg8::gemm_run<EpiSwiglu<true>, SchedPlain, true, false, 0>(lds, tid, RSRC, 128, DM, DM, S, EN); }
                else if (MK_PROBE_MODE == 6 && rep == 0) { EpiNull EN{wsl}; pg8::gemm_run<EpiNull, SchedPlain, true, false, 0>(lds, tid, RSRC, 128, DM, DM, S, EN); }
                else if (MK_PROBE_MODE == 7 && rep == 0) { EpiNull EN{wsl}; pg8::gemm_run<EpiNull, SchedPlain, true, false, 0>(lds, tid, RSRC, DM, DM, DM, S, EN); }
                else if (MK_PROBE_MODE == 5 && rep == 0) pg8::gemm_run<EpiSwiglu<true>, SchedPlain, true, false, 0>(lds, tid, RSRC, 128, DM, DM, S, E);
                else if (MK_PROBE_MODE > 0 && MK_PROBE_MODE < 5 && rep == 0) pg8::gemm_run<EpiSwiglu<true>, SchedPlain, true, false, MK_PROBE_MODE % 5>(lds, tid, RSRC, DM, DM, DM, S, E);
                else pg8::gemm_run<EpiSwiglu<true>, SchedPlain>(lds, tid, RSRC, DM, DM, DM, S, E);
            }
            SEAM(7);
            if (KIND(8) && IN(8)) { PHASE_IDS;
                SchedPlain S{(unsigned)WS_ACT, (unsigned)WS_WDN, 32, 8, G, bx, 256u * FF * 2u, 256u * FF * 2u};
                if (MK_P8_F8) { SchedPlain S8{(unsigned)WS_ACT, (unsigned)WS_WDN, 32, 8, G, bx, 256u * FF, 256u * FF};
                    EpiResT<true> E8{wsl, SSQ_A1, MK_GATE_F8 != 0};
                    pg8::gemm_run<EpiResT<true>, SchedPlain, true, true>(lds, tid, RSRC, FF / 2, FF / 2, FF / 2, S8, E8); }
                else {
                EpiRes E{wsl, SSQ_A1, MK_GATE_F8 != 0};
                pg8::gemm_run<EpiRes, SchedPlain>(lds, tid, RSRC, FF, FF, FF, S, E); }
#if MK_PROBE_MFMA
                { f32x4 pa[16]; bf16x8 px, py;
#pragma unroll
                  for (int j = 0; j < 8; ++j) { px[j] = (__bf16)(float)(tid + j); py[j] = (__bf16)(float)(tid - j); }
#pragma unroll
                  for (int j = 0; j < 16; ++j) pa[j] = (f32x4){0.f, 0.f, 0.f, 0.f};
                  for (int it = 0; it < 352; ++it) {
#pragma unroll
                      for (int j = 0; j < 16; ++j) pa[j] = __builtin_amdgcn_mfma_f32_16x16x32_bf16(px, py, pa[j], 0, 0, 0);
                  }
#pragma unroll
                  for (int j = 0; j < 16; ++j) asm volatile("" :: "v"(pa[j]));
                }
#endif
            }
            SEAM(8);
        }
    }
    if (KIND(15) && IN(15)) for (int rep = 0; rep < NREP(15); ++rep) { PHASE_IDS;
        LAS float* wr = (LAS float*)lds;
        LAS int* lcnt = (LAS int*)(lds + 65536);
        const u64* ssq = SSQ + SSQ_F1 * NTOK;
        for (int i = tid; i < DM * 8; i += NTHR) wr[i] = w_router[i] * ffn_norm[DM + (i >> 3)];
        for (int vc = bx; vc < 256; vc += G) {
            if (tid < 8) lcnt[tid] = 0;
            __syncthreads();
            u32x2 hrow[4][8]; float rsq[4];
#pragma unroll
            for (int q = 0; q < 4; ++q) { const int t = vc * 32 + wave * 4 + q;
#pragma unroll
                for (int j = 0; j < 8; ++j) hrow[q][j] = *(const u32x2*)(HB + (size_t)t * DM + 4 * lane + 256 * j); }
#pragma unroll
            for (int q = 0; q < 4; ++q) rsq[q] = row_rstd(ssq, vc * 32 + wave * 4 + q, 1.0f / DM);
#pragma unroll
            for (int q = 0; q < 4; ++q) {
                const int t = vc * 32 + wave * 4 + q;
                float a[8] = {0.f, 0.f, 0.f, 0.f, 0.f, 0.f, 0.f, 0.f};
#pragma unroll
                for (int j = 0; j < 8; ++j) { const int k = 4 * lane + 256 * j; const u32x2 hw = hrow[q][j]; const f32x4 hv = (f32x4){bflo(hw.x), bfhi(hw.x), bflo(hw.y), bfhi(hw.y)};
#pragma unroll
                    for (int kk = 0; kk < 4; ++kk) { const f32x4 w0 = *(const LAS f32x4*)(wr + (k + kk) * 8), w1 = *(const LAS f32x4*)(wr + (k + kk) * 8 + 4);
                        a[0] += hv[kk] * w0[0]; a[1] += hv[kk] * w0[1]; a[2] += hv[kk] * w0[2]; a[3] += hv[kk] * w0[3];
                        a[4] += hv[kk] * w1[0]; a[5] += hv[kk] * w1[1]; a[6] += hv[kk] * w1[2]; a[7] += hv[kk] * w1[3]; } }
                const float rs = rsq[q];
#pragma unroll
                for (int e = 0; e < 8; ++e) a[e] = wave_sum(a[e], lane) * rs;
                int i0 = 0; float l0 = a[0];
#pragma unroll
                for (int e = 1; e < 8; ++e) if (a[e] > l0) { l0 = a[e]; i0 = e; }
                int i1 = -1; float l1 = -3.0e38f;
#pragma unroll
                for (int e = 0; e < 8; ++e) if (e != i0 && a[e] > l1) { l1 = a[e]; i1 = e; }
                if (lane == 0) { const float ex = expf(l1 - l0), w0 = 1.0f / (1.0f + ex); TOPI[2 * t] = i0; TOPI[2 * t + 1] = i1; TOPW[2 * t] = w0; TOPW[2 * t + 1] = ex * w0;
                    __hip_atomic_fetch_add(&lcnt[i0], 1, __ATOMIC_RELAXED, __HIP_MEMORY_SCOPE_WORKGROUP); __hip_atomic_fetch_add(&lcnt[i1], 1, __ATOMIC_RELAXED, __HIP_MEMORY_SCOPE_WORKGROUP); }
            }
            __syncthreads();
            if (tid < 8) BLKCNT[vc * 8 + tid] = lcnt[tid];
            __syncthreads();
        }
    }
    SEAM(15);
    if (KIND(16) && IN(16)) for (int rep = 0; rep < NREP(16); ++rep) { PHASE_IDS;
        LAS int* bc = (LAS int*)lds;
        LAS int* pst = (LAS int*)(lds + 8192);
        LAS int* posl = (LAS int*)(lds + 8192 + 256);
        const u64* ssq = SSQ + SSQ_F1 * NTOK;
        for (int i = tid; i < 2048; i += NTHR) bc[i] = BLKCNT[i];
        __syncthreads();
        for (int vc = bx; vc < 256; vc += G) {
            {
                const int e = wave; int part = 0, mine = 0;
#pragma unroll
                for (int q = 0; q < 4; ++q) { const int i = 4 * lane + q, v = bc[i * 8 + e]; part += v; if (i < vc) mine += v; }
                float tf = wave_sum((float)part, lane), mf = wave_sum((float)mine, lane);
                if (lane == 0) { pst[8 + e] = (int)tf; pst[16 + e] = (int)mf; }
            }
            __syncthreads();
            if (tid == 0) { int s = 0; for (int e = 0; e < 8; ++e) { pst[e] = s; s += (pst[8 + e] + 255) / 256 * 256; }
                if (vc == 0) { int rt = 0; for (int e = 0; e < 8; ++e) { const int n = (pst[8 + e] + 255) / 256; for (int k = 0; k < n; ++k) TEXP[rt++] = e; } TEXP[100] = rt; } }
            __syncthreads();
            if (wave == 0) {
                const int t = vc * 32 + (lane >> 1), e = TOPI[2 * t + (lane & 1)];
                int rank = 0;
#pragma unroll
                for (int ee = 0; ee < 8; ++ee) { const unsigned long long mk = __ballot(e == ee); if (e == ee) rank = __popcll(mk & ((1ull << lane) - 1ull)); }
                const int pos = pst[e] + pst[16 + e] + rank;
                posl[lane] = pos; *(u32x2*)(RASS + 2 * pos) = (u32x2){(unsigned)(2 * t + (lane & 1)), __float_as_uint(TOPW[2 * t + (lane & 1)])}; ((int*)(wsl + WS_POS))[2 * t + (lane & 1)] = pos;
            }
            if (vc < 8 && wave == 1) { const int e = vc, s = pst[e] + pst[8 + e], en = pst[e] + (pst[8 + e] + 255) / 256 * 256; for (int p = s + lane; p < en; p += 64) *(u32x2*)(RASS + 2 * p) = (u32x2){0xffffffffu, 0u}; }
            if (vc < 8 && wave >= 2) { const int e = vc, s = pst[e] + pst[8 + e], en = pst[e] + (pst[8 + e] + 255) / 256 * 256;
                for (int p = s + (wave - 2); p < en; p += 6) for (int j = 0; j < 8; ++j) { if (MK_MOE_F8) *(int*)((unsigned char*)XS + (size_t)p * DM + 4 * lane + 256 * j) = 0; else *(u32x2*)(XS + (size_t)p * DM + 4 * lane + 256 * j) = (u32x2){0u, 0u}; } }
            __syncthreads();
            {
                u32x2 hv[4][8]; float rsv[4];
#pragma unroll
                for (int i4 = 0; i4 < 4; ++i4) { const int t = vc * 32 + wave * 4 + i4;
#pragma unroll
                    for (int j = 0; j < 8; ++j) hv[i4][j] = *(const u32x2*)(HB + (size_t)t * DM + 4 * lane + 256 * j); }
#pragma unroll
                for (int i4 = 0; i4 < 4; ++i4) rsv[i4] = row_rstd(ssq, vc * 32 + wave * 4 + i4, 1.0f / DM);
#pragma unroll
                for (int i4 = 0; i4 < 4; ++i4) { const int p0 = posl[wave * 8 + 2 * i4], p1 = posl[wave * 8 + 2 * i4 + 1]; const float rs = rsv[i4];
#pragma unroll
                    for (int j = 0; j < 8; ++j) { const u32x2 hw = hv[i4][j]; const f32x4 v = (f32x4){bflo(hw.x), bfhi(hw.x), bflo(hw.y), bfhi(hw.y)} * rs;
                        if (MK_MOE_F8) { const f32x4 w = v * F8_XS; int q = 0; q = __builtin_amdgcn_cvt_pk_fp8_f32(clamp448(w[0]), clamp448(w[1]), q, false); q = __builtin_amdgcn_cvt_pk_fp8_f32(clamp448(w[2]), clamp448(w[3]), q, true);
                            *(int*)((unsigned char*)XS + (size_t)p0 * DM + 4 * lane + 256 * j) = q; *(int*)((unsigned char*)XS + (size_t)p1 * DM + 4 * lane + 256 * j) = q; }
                        else { u32x2 o; o.x = cvt_pk_bf16(v[0], v[1]); o.y = cvt_pk_bf16(v[2], v[3]); *(u32x2*)(XS + (size_t)p0 * DM + 4 * lane + 256 * j) = o; *(u32x2*)(XS + (size_t)p1 * DM + 4 * lane + 256 * j) = o; } } }
            }
            __syncthreads();
        }
    }
    SEAM(16);
    if (KIND(17) && IN(17)) for (int rep = 0; rep < NREP(17); ++rep) { PHASE_IDS;
        const int nrt = __builtin_amdgcn_readfirstlane(__hip_atomic_load(TEXP + 100, __ATOMIC_RELAXED, __HIP_MEMORY_SCOPE_AGENT));
        if (MK_MOE_F8) {
            SchedMoe S{(unsigned)WS_XS, (unsigned)WS_WEGU, wsl, nrt, 56, G, bx, 256u * DM, 256u * DM, 2u * FFE * DM};
            EpiSwigluF8 E{wsl};
            pg8::gemm_run<EpiSwigluF8, SchedMoe, true, true>(lds, tid, RSRC, DM / 2, DM / 2, DM / 2, S, E);
        } else {
            SchedMoe S{(unsigned)WS_XS, (unsigned)WS_WEGU, wsl, nrt, 56, G, bx, 256u * DM * 2u, 256u * DM * 2u, 2u * FFE * DM * 2u};
            EpiSwiglu<false> E{wsl, (unsigned)WS_ACTE, FFE, 0};
            pg8::gemm_run<EpiSwiglu<false>, SchedMoe>(lds, tid, RSRC, DM, DM, DM, S, E);
        }
    }
    SEAM(17);
    if (KIND(18) && IN(18)) for (int rep = 0; rep < NREP(18); ++rep) { PHASE_IDS;
        const int nrt = __builtin_amdgcn_readfirstlane(__hip_atomic_load(TEXP + 100, __ATOMIC_RELAXED, __HIP_MEMORY_SCOPE_AGENT));
        if (MK_MOE_F8) {
            SchedMoe S{(unsigned)WS_ACTE, (unsigned)WS_WEDN, wsl, 64, 8, G, bx, 256u * FFE, 256u * FFE, (unsigned)DM * FFE};
            EpiMoeDown E{wsl, 1.0f / (F8_ACT * F8_WDN)};
            pg8::gemm_run<EpiMoeDown, SchedMoe, true, true>(lds, tid, RSRC, FFE / 2, FFE / 2, FFE / 2, S, E);
            SchedMoeTail ST{(unsigned)WS_ACTE, (unsigned)WS_WEDN, wsl, nrt, G, bx, 256u * FFE, 256u * FFE, (unsigned)DM * FFE, (unsigned)FFE / 4};
            const int tid_t = wave0 * 64 + lane_id();
            pg8::gemm_run<EpiMoeDown, SchedMoeTail, true, true>(lds, tid_t, RSRC, FFE / 8, FFE / 2, FFE / 2, ST, E);
        } else {
            SchedMoe S{(unsigned)WS_ACTE, (unsigned)WS_WEDN, wsl, nrt, 8, G, bx, 256u * FFE * 2u, 256u * FFE * 2u, (unsigned)DM * FFE * 2u};
            EpiMoeDown E{wsl, 1.0f};
            pg8::gemm_run<EpiMoeDown, SchedMoe>(lds, tid, RSRC, FFE, FFE, FFE, S, E);
        }
    }
    SEAM(18);
    if (IN(PH_FINAL)) { PHASE_IDS;
        const int gw = bx * NWAVES + wave, NGW = G * NWAVES;
        const bool have_moe = (MK_LAST_PHASE >= 18), have_h = (MK_LAST_PHASE >= 6); float* out_p = (float*)*(GAS float* const CAS*)(kargs + 176);
        for (int m0 = gw; m0 < NTOK; m0 += 2 * NGW) {
            int pos[2][2];
#pragma unroll
            for (int r = 0; r < 2; ++r) { const int m = m0 + r * NGW;
#pragma unroll
                for (int kk = 0; kk < 2; ++kk) pos[r][kk] = (have_moe && m < NTOK) ? __hip_atomic_load((const int*)(wsl + WS_POS) + 2 * m + kk, __ATOMIC_RELAXED, __HIP_MEMORY_SCOPE_AGENT) : 0; }
#pragma unroll
            for (int r = 0; r < 2; ++r)
#pragma unroll
                for (int kk = 0; kk < 2; ++kk) pos[r][kk] = __builtin_amdgcn_readfirstlane(pos[r][kk]);
            u32x2 hbv[2][8], yv[2][2][8];
#pragma unroll
            for (int r = 0; r < 2; ++r) { const int m = m0 + r * NGW; if (m < NTOK) {
#pragma unroll
                for (int j = 0; j < 8; ++j) { const int k = 4 * lane + 256 * j; hbv[r][j] = *(const u32x2*)(HB + (size_t)m * DM + k);
#pragma unroll
                    for (int kk = 0; kk < 2; ++kk) { const bool tl = MK_MOE_F8 && pos[r][kk] >= 64 * 256;
                        const bf16* yp = tl ? (const bf16*)(wsl + WS_YSQ) + (size_t)(pos[r][kk] - 64 * 256) * DM : (const bf16*)YS + (size_t)(2 * m + kk) * DM;
                        yv[r][kk][j] = have_moe ? *(const u32x2*)(yp + k) : (u32x2){0u, 0u}; } } } }
#pragma unroll
            for (int r = 0; r < 2; ++r) { const int m = m0 + r * NGW; if (m < NTOK) {
                f32x4 v[8]; float sx = 0.f;
#pragma unroll
                for (int j = 0; j < 8; ++j) { const int k = 4 * lane + 256 * j; const u32x2 hw = hbv[r][j];
                    v[j] = have_h ? (f32x4){bflo(hw.x), bfhi(hw.x), bflo(hw.y), bfhi(hw.y)} : *(const f32x4*)(X_IN + (size_t)m * DM + k);
#pragma unroll
                    for (int kk = 0; kk < 2; ++kk) { const u32x2 ya = yv[r][kk][j]; v[j][0] += bflo(ya.x); v[j][1] += bfhi(ya.x); v[j][2] += bflo(ya.y); v[j][3] += bfhi(ya.y);
                        if (MK_MOE_F8 && have_moe && pos[r][kk] >= 64 * 256) {
#pragma unroll
                            for (int q = 1; q < 4; ++q) { const u32x2 yb = *(const u32x2*)((const bf16*)(wsl + WS_YSQ) + ((size_t)q * 2048 + (pos[r][kk] - 64 * 256)) * DM + k);
                                v[j][0] += bflo(yb.x); v[j][1] += bfhi(yb.x); v[j][2] += bflo(yb.y); v[j][3] += bfhi(yb.y); } } }
                    sx += (v[j][0] * v[j][0] + v[j][1] * v[j][1]) + (v[j][2] * v[j][2] + v[j][3] * v[j][3]); }
                const float rs = rsqrtf(wave_sum(sx, lane) * (1.0f / DM) + EPS);
#pragma unroll
                for (int j = 0; j < 8; ++j) { const int k = 4 * lane + 256 * j; *(f32x4*)(out_p + (size_t)m * DM + k) = v[j] * rs * *(const f32x4*)(final_norm + k); }
            } }
        }
    }
#undef IN
#undef SEAM
}

extern "C" void kernel_launch(void* const* d_in, const int* in_sizes, int n_in, void* d_out, int out_size, void* d_ws, size_t ws_size, hipStream_t stream) {
    static int grid = 0;
    if (grid == 0) {
        if (n_in != 22 || out_size != NTOK * DM || ws_size < WS_END) { fprintf(stderr, "kernel_launch: unexpected shapes (n_in %d, out %d, ws %zu < %zu); nothing launched\n", n_in, out_size, ws_size, (size_t)WS_END); grid = -1; return; }
        int dev = 0, cus = 0, per_cu = 0;
        if (hipGetDevice(&dev) != hipSuccess || hipDeviceGetAttribute(&cus, hipDeviceAttributeMultiprocessorCount, dev) != hipSuccess) { grid = -1; return; }
        if (hipFuncSetAttribute((const void*)trunk_fwd, hipFuncAttributeMaxDynamicSharedMemorySize, LDS_BYTES) != hipSuccess) { fprintf(stderr, "kernel_launch: hipFuncSetAttribute failed\n"); grid = -1; return; }
        if (hipOccupancyMaxActiveBlocksPerMultiprocessor(&per_cu, (const void*)trunk_fwd, NTHR, LDS_BYTES) != hipSuccess || per_cu < 1) fprintf(stderr, "kernel_launch: occupancy query reports %d\n", per_cu);
        (void)hipGetLastError();
        grid = cus;
    }
    if (grid < 0) return;
    (void)hipMemsetAsync((char*)d_ws + WS_CTL, 0, CTL_BYTES, stream);
    Args a{};
    for (int i = 0; i < 22; ++i) a.in[i] = d_in[i];
    a.out = (float*)d_out; a.ws = (unsigned char*)d_ws;
    if (MK_N_LAUNCHES == 1) { a.ph_lo = 0; a.ph_hi = N_PHASES; hipLaunchKernelGGL(trunk_fwd, dim3(grid), dim3(NTHR), LDS_BYTES, stream, a); }
    else { for (int p = 0; p < N_PHASES; ++p) { if (p > MK_LAST_PHASE && p != PH_FINAL) continue; a.ph_lo = p; a.ph_hi = p + 1; hipLaunchKernelGGL(trunk_fwd, dim3(grid), dim3(NTHR), LDS_BYTES, stream, a); } }
    const hipError_t le = hipPeekAtLastError();
    if (le != hipSuccess) fprintf(stderr, "kernel_launch: launch failed: %s\n", hipGetErrorName(le));
}
```

```cpp
#include <hip/hip_runtime.h>
#ifndef MK_PROBE_MODE
#define MK_PROBE_MODE -1
#endif
#include <cstdio>
#include <cstdint>
#include <cstddef>

#ifndef MK_N_LAUNCHES
#define MK_N_LAUNCHES 1
#endif
#ifndef MK_MOE_F8
#define MK_MOE_F8 1
#endif
#ifndef MK_GATE_F8
#define MK_GATE_F8 1
#endif
#ifndef MK_LAST_PHASE
#define MK_LAST_PHASE 99
#endif
#ifndef MK_LAT_F8
#define MK_LAT_F8 1
#endif
#ifndef MK_P7_F8
#define MK_P7_F8 0
#endif
#ifndef MK_P8_F8
#define MK_P8_F8 1
#endif

#define GAS __attribute__((address_space(1)))
#define LAS __attribute__((address_space(3)))
#define CAS __attribute__((address_space(4)))
#ifndef HG_SIGMOID
#define HG_SIGMOID fast_sigmoid
#endif
#ifndef EPI_SIGMOID
#define EPI_SIGMOID fast_sigmoid
#endif
typedef unsigned short bf16;
typedef short bf16x8 __attribute__((ext_vector_type(8)));
typedef short s16x4 __attribute__((ext_vector_type(4)));
typedef float f32x2 __attribute__((ext_vector_type(2)));
typedef float f32x4 __attribute__((ext_vector_type(4)));
typedef float f32x16 __attribute__((ext_vector_type(16)));
typedef unsigned u32x2 __attribute__((ext_vector_type(2)));
typedef unsigned u32x4 __attribute__((ext_vector_type(4)));

constexpr int DM = 2048, NBATCH = 4, SEQ = 2048, NTOK = NBATCH * SEQ, NMEM = 256;
constexpr int HGH = 8, HGD = 128, CHUNK = 64, NCHUNK = SEQ / CHUNK;
constexpr int MLAH = 8, QRANK = 512, KVRANK = 512, NOPE = 128, ROPE = 64, QKD = NOPE + ROPE, MLAV = 128;
constexpr int MEMH = 4, MEMD = 256;
constexpr int DIN = 12352, DINP = 12544;
constexpr int FF = 5632, NEXP = 8, FFE = 7168;
constexpr float EPS = 1e-6f;
constexpr int PC_Q = 0, PC_F = 1024, PC_I = 2048, PC_G = 3072, PC_CQ = 4096, PC_CKV = 4608, PC_KR = 5120, PC_QM = 5376, PC_GATE = 6400;
constexpr int MAXRT = 72;

constexpr size_t MiB = 1u << 20;
constexpr size_t WS_CTL = 0, CTL_BYTES = 1 * MiB;
constexpr int CW_BAR = 4096;
constexpr size_t CB_SSQ = 65536;
constexpr int SSQ_F0 = 0, SSQ_A1 = 1, SSQ_F1 = 2, SSQ_CQ0 = 3, SSQ_CKV0 = 4, SSQ_CQ1 = 5, SSQ_CKV1 = 6;
constexpr size_t CB_BLKCNT = 65536 + 7 * 65536;
constexpr size_t W0 = 1 * MiB;
constexpr size_t WS_WIN = W0;
constexpr size_t WS_WMKV = WS_WIN + 2ull * DINP * 2048 * 2;
constexpr size_t WS_WQUP = WS_WMKV + 2ull * 2048 * 2048 * 2;
constexpr size_t WS_WKVUP = WS_WQUP + 2ull * 1536 * 512 * 2;
constexpr size_t WS_WBR = WS_WKVUP + 2ull * 2048 * 512 * 2;
constexpr size_t WS_WO = WS_WBR + 6ull * 2048 * 1024 * 2;
constexpr size_t WS_WGU = WS_WO + 2ull * 2048 * 2048 * 2;
constexpr size_t WS_WDN = WS_WGU + 11264ull * 2048 * 2;
constexpr size_t WS_WEGU = WS_WDN + 2048ull * 5632 * 2;
constexpr size_t WS_WEDN = WS_WEGU + 8ull * 14336 * 2048 * 2;
constexpr size_t WS_WEND = WS_WEDN + 8ull * 2048 * 7168 * 2;
constexpr size_t A0 = (WS_WEND + MiB - 1) / MiB * MiB;
constexpr size_t WS_H = A0;
constexpr size_t WS_HB = WS_H + (size_t)NTOK * DM * 4;
constexpr size_t WS_PROJ = WS_HB + (size_t)NTOK * DM * 2;
constexpr size_t WS_ZF = WS_PROJ + (size_t)NTOK * DINP * 2;
constexpr size_t WS_MEMN = WS_ZF + (size_t)NTOK * 1024 * 4;
constexpr size_t WS_MKV = WS_MEMN + 1024ull * 2048 * 2;
constexpr size_t WS_QMLA = WS_MKV + 1024ull * 2048 * 2;
constexpr size_t WS_KVB = WS_QMLA + (size_t)NTOK * 1536 * 2;
constexpr size_t WS_Y = WS_KVB + (size_t)NTOK * 2048 * 2;
constexpr size_t WS_HU = WS_Y + (size_t)NTOK * 3072 * 2;
constexpr size_t WS_HDEC = WS_HU + 1024ull * 128 * 128 * 4;
constexpr size_t WS_MRG = WS_HDEC + 1024ull * 128 * 4;
constexpr size_t WS_MRGB = WS_MRG + (size_t)NTOK * DM * 4;
constexpr size_t WS_ACT = WS_MRGB + (size_t)NTOK * DM * 2;
constexpr size_t WS_XS = WS_ACT + (size_t)NTOK * FF * 2;
constexpr size_t WS_ACTE = WS_XS + (size_t)MAXRT * 256 * DM * 2;
constexpr size_t WS_YS = WS_ACTE + (size_t)MAXRT * 256 * FFE * 2;
constexpr size_t WS_COS = WS_YS + 2ull * NTOK * DM * 4;
constexpr size_t WS_SIN = WS_COS + (size_t)NTOK * 32 * 4;
constexpr size_t WS_LB = WS_SIN + (size_t)NTOK * 32 * 4;
constexpr size_t WS_SSQA0 = WS_LB + 2 * 1024 * 4;
constexpr size_t WS_TOPI = WS_SSQA0 + (size_t)NTOK * 8;
constexpr size_t WS_TOPW = WS_TOPI + (size_t)NTOK * 8;
constexpr size_t WS_RASS = WS_TOPW + (size_t)NTOK * 8;
constexpr size_t WS_TEXP = WS_RASS + (size_t)MAXRT * 256 * 8;
constexpr size_t WS_POS = WS_TEXP + 512;
constexpr size_t WS_YSQ = WS_POS + 2ull * NTOK * 4;
constexpr size_t WS_HS = WS_YSQ + 4ull * 2048 * DM * 2;
constexpr size_t WS_HB8 = WS_HS + 1024ull * 128 * 128 * 2;
constexpr size_t WS_WIN8 = WS_HB8 + (size_t)NTOK * DM;
constexpr int WIN8_ROWS = MK_LAT_F8 ? 8192 : 6144;
constexpr size_t WS_END = WS_WIN8 + 2ull * WIN8_ROWS * DM;

constexpr int RING_BYTES = 131072;
constexpr int MISC_OFF = RING_BYTES;
constexpr int LDS_BYTES = 163840;
constexpr int NWAVES = 8, NTHR = 512;

#define RLX_AGENT __ATOMIC_RELAXED, __HIP_MEMORY_SCOPE_AGENT
#define LDS_WAIT() asm volatile("s_waitcnt lgkmcnt(0)" ::: "memory")
#define VM_WAIT() asm volatile("s_waitcnt vmcnt(0)" ::: "memory")
#define SBAR() __builtin_amdgcn_sched_barrier(0)
__device__ __forceinline__ unsigned cvt_pk_bf16(float lo, float hi) { unsigned r; asm volatile("s_nop 0\n\tv_cvt_pk_bf16_f32 %0, %1, %2" : "=v"(r) : "v"(lo), "v"(hi)); return r; }
__device__ __forceinline__ bf16 f2bf(float f) { return (bf16)(cvt_pk_bf16(f, 0.f) & 0xffffu); }
__device__ __forceinline__ float bf2f(bf16 b) { return __uint_as_float(((unsigned)b) << 16); }
__device__ __forceinline__ float bflo(unsigned w) { return __uint_as_float(w << 16); }
__device__ __forceinline__ float bfhi(unsigned w) { return __uint_as_float(w & 0xffff0000u); }
__device__ __forceinline__ f32x4 ld4h(const bf16* p) { const u32x2 w = *(const u32x2*)p; return (f32x4){bflo(w.x), bfhi(w.x), bflo(w.y), bfhi(w.y)}; }
__device__ __forceinline__ float fast_sigmoid(float x) { return __builtin_amdgcn_rcpf(1.0f + __builtin_amdgcn_exp2f(x * -1.4426950408889634f)); }
__device__ __forceinline__ float ieee_sigmoid(float x) { return 1.0f / (1.0f + __expf(-x)); }
__device__ __forceinline__ int lane_id() { int r; asm volatile("v_mbcnt_lo_u32_b32 %0, -1, 0\n\tv_mbcnt_hi_u32_b32 %0, -1, %0" : "=v"(r)); return r; }
__device__ __forceinline__ float shflx(float v, int mask, int lane) { return __int_as_float(__builtin_amdgcn_ds_bpermute((lane ^ mask) << 2, __float_as_int(v))); }
__device__ __forceinline__ float wave_sum(float v, int lane) {
#pragma unroll
    for (int o = 1; o < 64; o <<= 1) v += shflx(v, o, lane);
    return v;
}
constexpr float F8_XS = 32.0f, F8_WGU = 1024.0f, F8_ACT = 8.0f, F8_WDN = 2048.0f, F8_H = 32.0f, F8_WIN = 1024.0f;
typedef int i32x8 __attribute__((ext_vector_type(8)));
__device__ __forceinline__ float clamp448(float v) { return fminf(fmaxf(v, -448.0f), 448.0f); }
__device__ __forceinline__ u32x2 pack8_f8(const f32x4& a, const f32x4& b) {
    int w0 = 0, w1 = 0;
    w0 = __builtin_amdgcn_cvt_pk_fp8_f32(clamp448(a[0]), clamp448(a[1]), w0, false); w0 = __builtin_amdgcn_cvt_pk_fp8_f32(clamp448(a[2]), clamp448(a[3]), w0, true);
    w1 = __builtin_amdgcn_cvt_pk_fp8_f32(clamp448(b[0]), clamp448(b[1]), w1, false); w1 = __builtin_amdgcn_cvt_pk_fp8_f32(clamp448(b[2]), clamp448(b[3]), w1, true);
    u32x2 r; r.x = (unsigned)w0; r.y = (unsigned)w1; return r;
}
__device__ __forceinline__ u32x4 pack8(const f32x4& a, const f32x4& b) {
    u32x4 w; w.x = cvt_pk_bf16(a[0], a[1]); w.y = cvt_pk_bf16(a[2], a[3]); w.z = cvt_pk_bf16(b[0], b[1]); w.w = cvt_pk_bf16(b[2], b[3]); return w;
}

#define XB_TMO      128
#define XB_XCNT(j)  (256  + 64 * (j))
#define XB_XSUB(j)  (1280 + 64 * (j))
#define XB_XGEN(j)  (2304 + 64 * (j))
#define XB_TOP      3328
#define XB_TOPGEN   3392
#define XCD_BAR_WORDS 3456
#define XB_SPIN_CAP (1u << 18)
__device__ __forceinline__ unsigned xb_ld(unsigned* p)              { return __hip_atomic_load(p, __ATOMIC_RELAXED, __HIP_MEMORY_SCOPE_AGENT); }
__device__ __forceinline__ unsigned xb_add(unsigned* p, unsigned v) { return __hip_atomic_fetch_add(p, v, __ATOMIC_RELAXED, __HIP_MEMORY_SCOPE_AGENT); }
__device__ __forceinline__ unsigned xb_xcc_id() { return (unsigned)__builtin_amdgcn_s_getreg((3 << 11) | 20) & 0xFu; }
#define XB_SPIN(cond, bar) do { unsigned _sp = 0; while (cond) { __builtin_amdgcn_s_sleep(1); \
    if ((++_sp & 255u) == 0u) { if (xb_ld(&(bar)[XB_TMO])) break; if (_sp > XB_SPIN_CAP) { atomicAdd(&(bar)[XB_TMO], 1u); break; } } } } while (0)
struct XcdBarrier { unsigned* bar; unsigned x; volatile LAS unsigned* st; unsigned nloc, nx; };
__device__ __forceinline__ XcdBarrier xcd_barrier_post(unsigned* bar, volatile LAS unsigned* st, int tid) {
    XcdBarrier b; b.bar = bar; b.x = xb_xcc_id(); b.st = st; b.nloc = 0u; b.nx = 0u;
    if (tid == 0) (void)xb_add(&bar[XB_XCNT(b.x)], 1u);
    return b;
}
__device__ __forceinline__ void xcd_barrier_complete(unsigned* bar, unsigned x, unsigned& nloc, unsigned& nx) {
    const unsigned G = gridDim.x * gridDim.y * gridDim.z;
    unsigned sum, cnt, mine, sp = 0u;
    for (;;) {
        sum = 0u; cnt = 0u; mine = 0u;
#pragma unroll
        for (unsigned j = 0; j < 16; ++j) { const unsigned c = xb_ld(&bar[XB_XCNT(j)]); sum += c; cnt += (c > 0u) ? 1u : 0u; mine = (j == x) ? c : mine; }
        if (sum == G) break;
        __builtin_amdgcn_s_sleep(1);
        if ((++sp & 255u) == 0u) { if (xb_ld(&bar[XB_TMO])) break; if (sp > XB_SPIN_CAP) { atomicAdd(&bar[XB_TMO], 1u); break; } }
    }
    nloc = mine > 0u ? mine : 1u; nx = cnt > 0u ? cnt : 1u;
}
__device__ __forceinline__ void xcd_barrier(XcdBarrier& b, int tid) {
    asm volatile("s_waitcnt vmcnt(0)" ::: "memory");
    __syncthreads();
    unsigned nloc_new = b.nloc, nx_new = b.nx;
    if (tid == 0) {
        unsigned* bar = b.bar; unsigned bxx = b.x; asm volatile("" : "+s"(bar), "+s"(bxx));
        __builtin_amdgcn_s_waitcnt(0);
        unsigned nloc = b.nloc, nx = b.nx;
        if (nloc == 0u) { xcd_barrier_complete(bar, bxx, nloc, nx); nloc_new = nloc; nx_new = nx; }
        const unsigned old = xb_add(&bar[XB_XSUB(bxx)], 1u);
        const unsigned gen = old / nloc;
        if (old + 1u == (gen + 1u) * nloc) {
            __builtin_amdgcn_fence(__ATOMIC_RELEASE, "agent");
            asm volatile("s_waitcnt vmcnt(0)" ::: "memory");
            const unsigned og = xb_add(&bar[XB_TOP], 1u);
            const unsigned tg = og / nx;
            if (og + 1u != (tg + 1u) * nx) XB_SPIN(xb_ld(&bar[XB_TOP]) < (tg + 1u) * nx, bar);
            __builtin_amdgcn_fence(__ATOMIC_ACQUIRE, "agent");
            xb_add(&bar[XB_XGEN(bxx)], 1u);
            asm volatile("s_waitcnt vmcnt(0)" ::: "memory");
        } else {
            XB_SPIN(xb_ld(&bar[XB_XGEN(bxx)]) == gen, bar);
            __builtin_amdgcn_fence(__ATOMIC_ACQUIRE, "agent");
            asm volatile("s_waitcnt vmcnt(0)" ::: "memory");
        }
    }
    b.nloc = __builtin_amdgcn_readfirstlane(nloc_new); b.nx = __builtin_amdgcn_readfirstlane(nx_new);
    __syncthreads();
}

typedef unsigned long long u64;
namespace pg8 {
typedef int i32x4v __attribute__((ext_vector_type(4)));
constexpr int BM = 256, BK = 64, HALF = 128, HTB = HALF * BK * 2, STAGE_BYTES = 8 * HTB, NXCD = 8, WGM = 8;
__device__ __forceinline__ int lds_byte(int r, int c) { const int st = (r >> 4) * 2 + (c >> 5), rr = r & 15, cc = c & 31, ob = rr * 64 + cc * 2; return st * 1024 + (ob ^ (((ob >> 9) & 1) << 5)); }
__device__ __forceinline__ void stage_rc(int b, int& R, int& C) { const int st = b / 1024, sb = b % 1024, swz = sb ^ (((sb >> 9) & 1) << 5); R = (st >> 1) * 16 + swz / 64; C = (st & 1) * 32 + (swz % 64) / 2; }
__device__ __forceinline__ int perm32(int rho) { const int n = rho >> 4, i = rho & 15; return 8 * (i >> 2) + 4 * n + (i & 3); }

struct Unit { unsigned A, B; int pm, pn, kind, aux; };

__device__ __forceinline__ int xcd_remap(int L, int nwg) { const int q = nwg / NXCD, r = nwg % NXCD, xcd = L % NXCD, off = L / NXCD; return (xcd < r ? xcd * (q + 1) : r * (q + 1) + (xcd - r) * q) + off; }
__device__ __forceinline__ void tile_decode(int wgid, int nM, int nN, int& pm, int& pn) {
    const int nig = WGM * nN, gid = wgid / nig, fm = gid * WGM, gsz = (nM - fm) < WGM ? (nM - fm) : WGM;
    pm = fm + ((wgid % nig) % gsz); pn = (wgid % nig) / gsz;
}

template <class Epi, class Sched, bool ALIGN_EPI = true, bool F8 = false, int PM = 0>
__device__ __forceinline__ void gemm_run(LAS unsigned char* lds, const int tid, const unsigned char* wsbase, const int K, const int lda, const int ldb, const Sched& S, const Epi& E) {
    const int wid = __builtin_amdgcn_readfirstlane(tid >> 6), lane = tid & 63, wr = wid >> 2, wc = wid & 3, fr = lane & 15, fq = lane >> 4;
    const int nt = K / BK;
    const unsigned long long wsb = (unsigned long long)wsbase; const unsigned wlo = __builtin_amdgcn_readfirstlane((unsigned)wsb), whi = __builtin_amdgcn_readfirstlane((unsigned)(wsb >> 32));
    const __amdgpu_buffer_rsrc_t rsrc = __builtin_amdgcn_make_buffer_rsrc((void*)(((unsigned long long)whi << 32) | wlo), 0, 0xFFFFF000u, 0x00020000);
    unsigned voffA, voffB;
    { int R, C; stage_rc(tid * 16, R, C); const int Rb = (R & ~31) + perm32(R & 31); voffA = (unsigned)(R * lda + C) * 2u; voffB = (unsigned)(Rb * ldb + C) * 2u; }
    const unsigned pieceA = 64u * lda * 2u, pieceB = 64u * ldb * 2u;
    const unsigned kstep = BK * 2;
    const unsigned hstepA = (unsigned)HALF * lda * 2u, hstepB = (unsigned)HALF * ldb * 2u;
    const unsigned ldsw = (unsigned)wid * 1024u;
    const int aoff = lds_byte(wr * 64 + fr, fq * 8), boff = lds_byte(wc * 32 + fr, fq * 8);
#define PG8_SA(b, h) (((b) * 2 + (h)) * HTB)
#define PG8_SB(b, h) ((4 + (b) * 2 + (h)) * HTB)
#define PG8_STAGE(bufoff, goff, voff) do { if constexpr (PM == 2) break; \
        __builtin_amdgcn_raw_ptr_buffer_load_lds(rsrc, (LAS void*)(lds + (bufoff) + ldsw), 16, (int)(voff), (int)(goff), 0, 0); \
        __builtin_amdgcn_raw_ptr_buffer_load_lds(rsrc, (LAS void*)(lds + (bufoff) + ldsw + 8192), 16, (int)(voff), (int)((goff) + piece##voff), 0, 0); } while (0)
#define piecevoffA pieceA
#define piecevoffB pieceB
#define PG8_LDA(dst, b, h) do { if constexpr (PM == 1) break; _Pragma("unroll") for (int m = 0; m < 4; ++m) _Pragma("unroll") for (int k = 0; k < 2; ++k) dst[m][k] = *(const LAS bf16x8*)(lds + PG8_SA(b, h) + aoff + m * 2048 + k * 1024); } while (0)
#define PG8_LDB(dst, b, h) do { if constexpr (PM == 1) break; _Pragma("unroll") for (int n = 0; n < 2; ++n) _Pragma("unroll") for (int k = 0; k < 2; ++k) dst[n][k] = *(const LAS bf16x8*)(lds + PG8_SB(b, h) + boff + n * 2048 + k * 1024); } while (0)
#define PG8_CAT(lo, hi) __builtin_shufflevector(__builtin_bit_cast(i32x4v, lo), __builtin_bit_cast(i32x4v, hi), 0, 1, 2, 3, 4, 5, 6, 7)
#define PG8_MMA(ai, bj, At, Bt) do { if constexpr (PM == 3) break; __builtin_amdgcn_s_setprio(1); if constexpr (F8) { _Pragma("unroll") for (int m = 0; m < 4; ++m) _Pragma("unroll") for (int n = 0; n < 2; ++n) \
        acc[ai][bj][m][n] = __builtin_amdgcn_mfma_scale_f32_16x16x128_f8f6f4(PG8_CAT(Bt[n][0], Bt[n][1]), PG8_CAT(At[m][0], At[m][1]), acc[ai][bj][m][n], 0, 0, 0, 0x7F7F7F7F, 0, 0x7F7F7F7F); } \
      else { _Pragma("unroll") for (int m = 0; m < 4; ++m) _Pragma("unroll") for (int n = 0; n < 2; ++n) _Pragma("unroll") for (int k = 0; k < 2; ++k) \
        acc[ai][bj][m][n] = __builtin_amdgcn_mfma_f32_16x16x32_bf16(Bt[n][k], At[m][k], acc[ai][bj][m][n], 0, 0, 0); } __builtin_amdgcn_s_setprio(0); } while (0)
#define PG8_WAIT_V(n) asm volatile("s_waitcnt vmcnt(" #n ")" ::: "memory")
#define PG8_WAIT_L(n) asm volatile("s_waitcnt lgkmcnt(" #n ")" ::: "memory")
#define PG8_BAR __builtin_amdgcn_s_barrier()
#define PG8_SCHED __builtin_amdgcn_sched_barrier(0)
    Unit cur, nxt; int ui = 0;
    if (!S.next(0, cur)) return;
    LAS unsigned char* pfslot = lds + STAGE_BYTES + ldsw * 2u;
#define PG8_PF(unit) do { if constexpr (Epi::PF) { const int po = __builtin_amdgcn_readfirstlane((int)E.pf_off(unit)); \
        __builtin_amdgcn_raw_ptr_buffer_load_lds(rsrc, (LAS void*)pfslot, 16, lane * 16, po, 0, 0); \
        __builtin_amdgcn_raw_ptr_buffer_load_lds(rsrc, (LAS void*)(pfslot + 1024), 16, lane * 16, po + 1024, 0, 0); } } while (0)
    PG8_PF(cur);
    f32x4 acc[2][2][4][2];
#pragma unroll
    for (int a = 0; a < 2; ++a)
#pragma unroll
        for (int b = 0; b < 2; ++b)
#pragma unroll
            for (int m = 0; m < 4; ++m)
#pragma unroll
                for (int n = 0; n < 2; ++n) acc[a][b][m][n] = (f32x4){0.f, 0.f, 0.f, 0.f};
    bf16x8 At[4][2], B0[2][2], B1[2][2];
    if constexpr (PM == 1) {
#pragma unroll
        for (int m = 0; m < 4; ++m) { asm volatile("" : "=v"(At[m][0])); asm volatile("" : "=v"(At[m][1])); }
#pragma unroll
        for (int m = 0; m < 2; ++m) { asm volatile("" : "=v"(B0[m][0])); asm volatile("" : "=v"(B0[m][1])); asm volatile("" : "=v"(B1[m][0])); asm volatile("" : "=v"(B1[m][1])); }
    }
    unsigned cA = cur.A, cB = cur.B;
    PG8_STAGE(PG8_SB(0, 0), cB, voffB); PG8_STAGE(PG8_SB(0, 1), cB + hstepB, voffB); PG8_STAGE(PG8_SA(0, 0), cA, voffA); PG8_STAGE(PG8_SA(0, 1), cA + hstepA, voffA);
    if (wr == 1) PG8_BAR;
    PG8_WAIT_V(2); PG8_BAR;
    PG8_STAGE(PG8_SB(1, 0), cB + kstep, voffB); PG8_STAGE(PG8_SA(1, 0), cA + kstep, voffA); PG8_STAGE(PG8_SB(1, 1), cB + hstepB + kstep, voffB);
    PG8_WAIT_V(6); PG8_BAR;
    for (;;) {
        const bool has_next = S.next(ui + 1, nxt);
        const unsigned nA = has_next ? nxt.A : cA, nB = has_next ? nxt.B : cB;
        for (int t = 0; t < nt; t += 2) {
            const bool last = (t == nt - 2);
            const unsigned a1 = cA + (unsigned)(t + 1) * kstep;
            const unsigned a2 = last ? nA : cA + (unsigned)(t + 2) * kstep, b2 = last ? nB : cB + (unsigned)(t + 2) * kstep;
            const unsigned a3 = a2 + kstep, b3 = b2 + kstep;
            PG8_LDB(B0, 0, 0); PG8_LDB(B1, 0, 1); PG8_SCHED; PG8_LDA(At, 0, 0); PG8_STAGE(PG8_SA(1, 1), a1 + hstepA, voffA);
            PG8_WAIT_V(8); PG8_WAIT_L(0); PG8_BAR; PG8_MMA(0, 0, At, B0); PG8_MMA(0, 1, At, B1); PG8_BAR; PG8_SCHED;
            PG8_LDA(At, 0, 1); PG8_STAGE(PG8_SB(0, 0), b2, voffB); PG8_STAGE(PG8_SB(0, 1), b2 + hstepB, voffB); PG8_STAGE(PG8_SA(0, 0), a2, voffA);
            PG8_WAIT_V(8); PG8_WAIT_L(0); PG8_BAR; PG8_MMA(1, 0, At, B0); PG8_MMA(1, 1, At, B1); PG8_BAR; PG8_SCHED;
            PG8_LDB(B0, 1, 0); PG8_LDB(B1, 1, 1); PG8_SCHED; PG8_LDA(At, 1, 0); PG8_STAGE(PG8_SA(0, 1), a2 + hstepA, voffA);
            PG8_WAIT_V(8); PG8_WAIT_L(0); PG8_BAR; PG8_MMA(0, 0, At, B0); PG8_MMA(0, 1, At, B1); PG8_BAR; PG8_SCHED;
            PG8_LDA(At, 1, 1); PG8_STAGE(PG8_SB(1, 0), b3, voffB); PG8_STAGE(PG8_SB(1, 1), b3 + hstepB, voffB); PG8_STAGE(PG8_SA(1, 0), a3, voffA);
            PG8_WAIT_V(8); PG8_WAIT_L(0); PG8_BAR; PG8_MMA(1, 0, At, B0); PG8_MMA(1, 1, At, B1); PG8_BAR; PG8_SCHED;
        }
        if constexpr (ALIGN_EPI) { if (wr == 0) PG8_BAR; }
        bool zero_acc = true;
        { Unit eu = cur; asm volatile("" : "+s"(eu.pm), "+s"(eu.pn));
          const int lane_o = lane_id(); if constexpr (Epi::INPLACE) zero_acc = E(acc, eu, wr, wc, lane_o & 15, lane_o >> 4, (const LAS u64*)pfslot); else E(acc, eu, wr, wc, lane_o & 15, lane_o >> 4, (const LAS u64*)pfslot); }
        if (!has_next) break;
        PG8_SCHED; PG8_PF(nxt); PG8_SCHED;
        if (zero_acc) {
#pragma unroll
        for (int a = 0; a < 2; ++a)
#pragma unroll
            for (int b = 0; b < 2; ++b)
#pragma unroll
                for (int m = 0; m < 4; ++m)
#pragma unroll
                    for (int n = 0; n < 2; ++n) acc[a][b][m][n] = (f32x4){0.f, 0.f, 0.f, 0.f};
        }
        cur = nxt; cA = nA; cB = nB; ++ui;
        if constexpr (ALIGN_EPI) { if (wr == 1) PG8_BAR; }
    }
    PG8_WAIT_V(0);
    if constexpr (!ALIGN_EPI) { if (wr == 0) PG8_BAR; }
    PG8_BAR;
#undef PG8_PF
#undef PG8_SA
#undef PG8_SB
#undef PG8_STAGE
#undef piecevoffA
#undef piecevoffB
#undef PG8_LDA
#undef PG8_LDB
#undef PG8_MMA
#undef PG8_CAT
#undef PG8_WAIT_V
#undef PG8_WAIT_L
#undef PG8_BAR
#undef PG8_SCHED
}
}
using pg8::Unit;

typedef f32x4 Acc[2][2][4][2];
#define EPI_ROWS(u, wr, fr) const int row0 = (u).pm * 256 + (wr) * 64 + (fr)

__device__ __forceinline__ float ssq_val(const u64* ssq, int row) { return (float)ssq[row] * 2.3283064365386963e-10f; }
__device__ __forceinline__ u64 ssq_fix(float s) { return (u64)(s * 4294967296.0f); }
__device__ __forceinline__ float row_rstd_lds(const LAS u64* pf, int lrow, float invn) { return rsqrtf((float)pf[lrow] * 2.3283064365386963e-10f * invn + EPS); }
__device__ __forceinline__ float row_rstd(const u64* ssq, int row, float invn) { return rsqrtf(ssq_val(ssq, row) * invn + EPS); }
__device__ __forceinline__ void ssq_atomic(u64* ssq, int row, float s, int fr, int fq) {
    const int lane = fr + 16 * fq; s += shflx(s, 16, lane); s += shflx(s, 32, lane);
    if (fq == 0) atomicAdd(ssq + row, ssq_fix(s));
}

struct EpiIn {
    static constexpr bool INPLACE = false, PF = true;
    unsigned char* ws; int l; bool do_ssq; float scale;
    __device__ __forceinline__ unsigned pf_off(const Unit& u) const { return (unsigned)(l == 0 ? WS_SSQA0 : CB_SSQ + (size_t)SSQ_A1 * NTOK * 8) + (u.kind == 1 ? 0u : (unsigned)u.pm * 2048u); }
    __device__ __forceinline__ void operator()(const Acc& acc, const Unit& u, int wr, int wc, int fr, int fq, const LAS u64* pf) const {
        EPI_ROWS(u, wr, fr);
        bf16* proj = (bf16*)(ws + WS_PROJ); float* zf = (float*)(ws + WS_ZF); bf16* mkv = (bf16*)(ws + WS_MKV);
        const u64* ssq_h = l == 0 ? (const u64*)(ws + WS_SSQA0) : (const u64*)(ws + CB_SSQ) + SSQ_A1 * NTOK;
        u64* ssq_cq = (u64*)(ws + CB_SSQ) + (l == 0 ? SSQ_CQ0 : SSQ_CQ1) * NTOK; u64* ssq_ckv = (u64*)(ws + CB_SSQ) + (l == 0 ? SSQ_CKV0 : SSQ_CKV1) * NTOK;
        const float* cosT = (const float*)(ws + WS_COS); const float* sinT = (const float*)(ws + WS_SIN);
        if (u.kind == 1) {
#pragma unroll
            for (int ai = 0; ai < 2; ++ai)
#pragma unroll
                for (int m = 0; m < 4; ++m) { const int row = row0 + ai * 128 + m * 16;
#pragma unroll
                    for (int bj = 0; bj < 2; ++bj) { const int col = u.pn * 256 + bj * 128 + wc * 32 + 8 * fq;
                        *(u32x4*)(mkv + (size_t)row * 2048 + col) = pack8(acc[ai][bj][m][0], acc[ai][bj][m][1]); } }
            return;
        }
        const int pn = u.pn;
        float rsv[2][4];
#pragma unroll
        for (int ai = 0; ai < 2; ++ai)
#pragma unroll
            for (int m = 0; m < 4; ++m) rsv[ai][m] = row_rstd_lds(pf, ai * 128 + wr * 64 + m * 16 + fr, 1.0f / DM) * scale;
#pragma unroll
        for (int ai = 0; ai < 2; ++ai)
#pragma unroll
            for (int m = 0; m < 4; ++m) {
                const int row = row0 + ai * 128 + m * 16;
                const float rs = rsv[ai][m];
                float sq = 0.f;
#pragma unroll
                for (int bj = 0; bj < 2; ++bj) {
                    const int col = pn * 256 + bj * 128 + wc * 32 + 8 * fq;
                    f32x4 v0 = acc[ai][bj][m][0] * rs, v1 = acc[ai][bj][m][1] * rs;
                    if (pn >= 4 && pn < 8) {
                        float* zp = zf + (size_t)row * 1024 + (col - PC_F);
                        *(f32x4*)zp = v0; *(f32x4*)(zp + 4) = v1;
                    } else {
                        if (pn >= 16 && pn < 20) sq += (v0[0] * v0[0] + v0[1] * v0[1]) + (v0[2] * v0[2] + v0[3] * v0[3]) + (v1[0] * v1[0] + v1[1] * v1[1]) + (v1[2] * v1[2] + v1[3] * v1[3]);
                        if (pn == 20 && bj == 0 && wc < 2) {
                            const int j0 = (wc * 32 + 8 * fq) >> 1;
                            const f32x4 cs = *(const f32x4*)(cosT + (size_t)row * 32 + j0), sn = *(const f32x4*)(sinT + (size_t)row * 32 + j0);
                            f32x4 r0, r1;
                            r0[0] = v0[0] * cs[0] - v0[1] * sn[0]; r0[1] = v0[1] * cs[0] + v0[0] * sn[0];
                            r0[2] = v0[2] * cs[1] - v0[3] * sn[1]; r0[3] = v0[3] * cs[1] + v0[2] * sn[1];
                            r1[0] = v1[0] * cs[2] - v1[1] * sn[2]; r1[1] = v1[1] * cs[2] + v1[0] * sn[2];
                            r1[2] = v1[2] * cs[3] - v1[3] * sn[3]; r1[3] = v1[3] * cs[3] + v1[2] * sn[3];
                            v0 = r0; v1 = r1;
                        }
                        if (pn >= 25) {
#pragma unroll
                            for (int j = 0; j < 4; ++j) { v0[j] = EPI_SIGMOID(v0[j]); v1[j] = EPI_SIGMOID(v1[j]); }
                        }
                        *(u32x4*)(proj + (size_t)row * DINP + col) = pack8(v0, v1);
                    }
                }
                if (do_ssq && pn >= 16 && pn < 18) ssq_atomic(ssq_cq, row, sq, fr, fq);
                if (do_ssq && pn >= 18 && pn < 20) ssq_atomic(ssq_ckv, row, sq, fr, fq);
            }
    }
};

struct EpiGateLogit {
    static constexpr bool INPLACE = false, PF = true;
    unsigned char* ws; int l;
    __device__ __forceinline__ unsigned pf_off(const Unit& u) const { return (unsigned)(l == 0 ? WS_SSQA0 : CB_SSQ + (size_t)SSQ_A1 * NTOK * 8) + (unsigned)u.pm * 2048u; }
    __device__ __forceinline__ void operator()(const Acc& acc, const Unit& u, int wr, int wc, int fr, int fq, const LAS u64* pf) const {
        if (MK_LAT_F8 && u.pn >= 24) {
            Unit v = u; v.pn = u.pn - 8; v.kind = 0; const EpiIn e{ws, l, true, 1.0f / (F8_H * F8_WIN)}; e(acc, v, wr, wc, fr, fq, pf); return; }
        EPI_ROWS(u, wr, fr);
        bf16* proj = (bf16*)(ws + WS_PROJ);
        const u64* ssq_h = l == 0 ? (const u64*)(ws + WS_SSQA0) : (const u64*)(ws + CB_SSQ) + SSQ_A1 * NTOK;
        float rsv[2][4];
#pragma unroll
        for (int ai = 0; ai < 2; ++ai)
#pragma unroll
            for (int m = 0; m < 4; ++m) rsv[ai][m] = row_rstd_lds(pf, ai * 128 + wr * 64 + m * 16 + fr, 1.0f / DM) * (1.0f / (F8_H * F8_WIN));
#pragma unroll
        for (int ai = 0; ai < 2; ++ai)
#pragma unroll
            for (int m = 0; m < 4; ++m) {
                const int row = row0 + ai * 128 + m * 16;
                const float rsl = rsv[ai][m] * -1.4426950408889634f;
#pragma unroll
                for (int bj = 0; bj < 2; ++bj) {
                    const int col = u.pn * 256 + bj * 128 + wc * 32 + 8 * fq;
                    f32x4 v0, v1;
#pragma unroll
                    for (int j = 0; j < 4; ++j) { v0[j] = __builtin_amdgcn_rcpf(1.0f + __builtin_amdgcn_exp2f(acc[ai][bj][m][0][j] * rsl)); v1[j] = __builtin_amdgcn_rcpf(1.0f + __builtin_amdgcn_exp2f(acc[ai][bj][m][1][j] * rsl)); }
                    *(u32x4*)(proj + (size_t)row * DINP + PC_GATE + col) = pack8(v0, v1);
                }
            }
    }
};

struct EpiUp {
    static constexpr bool INPLACE = false, PF = true;
    unsigned char* ws; int l;
    __device__ __forceinline__ unsigned pf_off(const Unit& u) const { return (unsigned)(CB_SSQ + (size_t)(u.kind == 0 ? (l == 0 ? SSQ_CQ0 : SSQ_CQ1) : (l == 0 ? SSQ_CKV0 : SSQ_CKV1)) * NTOK * 8) + (unsigned)u.pm * 2048u; }
    __device__ __forceinline__ void operator()(const Acc& acc, const Unit& u, int wr, int wc, int fr, int fq, const LAS u64* pf) const {
        EPI_ROWS(u, wr, fr);
        bf16* qmla = (bf16*)(ws + WS_QMLA); bf16* kvb = (bf16*)(ws + WS_KVB);
        const u64* ssq_cq = (const u64*)(ws + CB_SSQ) + (l == 0 ? SSQ_CQ0 : SSQ_CQ1) * NTOK; const u64* ssq_ckv = (const u64*)(ws + CB_SSQ) + (l == 0 ? SSQ_CKV0 : SSQ_CKV1) * NTOK;
        const float* cosT = (const float*)(ws + WS_COS); const float* sinT = (const float*)(ws + WS_SIN);
        const bool isq = (u.kind == 0);
        float rsv[2][4];
#pragma unroll
        for (int ai = 0; ai < 2; ++ai)
#pragma unroll
            for (int m = 0; m < 4; ++m) rsv[ai][m] = row_rstd_lds(pf, ai * 128 + wr * 64 + m * 16 + fr, 1.0f / 512.0f);
#pragma unroll
        for (int ai = 0; ai < 2; ++ai)
#pragma unroll
            for (int m = 0; m < 4; ++m) {
                const int row = row0 + ai * 128 + m * 16;
                const float rs = rsv[ai][m];
#pragma unroll
                for (int bj = 0; bj < 2; ++bj) {
                    const int col = u.pn * 256 + bj * 128 + wc * 32 + 8 * fq;
                    f32x4 v0 = acc[ai][bj][m][0] * rs, v1 = acc[ai][bj][m][1] * rs;
                    if (isq) {
                        const int c192 = col % QKD;
                        if (c192 >= NOPE) {
                            const int j0 = (c192 - NOPE) >> 1;
                            const f32x4 cs = *(const f32x4*)(cosT + (size_t)row * 32 + j0), sn = *(const f32x4*)(sinT + (size_t)row * 32 + j0);
                            f32x4 r0, r1;
                            r0[0] = v0[0] * cs[0] - v0[1] * sn[0]; r0[1] = v0[1] * cs[0] + v0[0] * sn[0];
                            r0[2] = v0[2] * cs[1] - v0[3] * sn[1]; r0[3] = v0[3] * cs[1] + v0[2] * sn[1];
                            r1[0] = v1[0] * cs[2] - v1[1] * sn[2]; r1[1] = v1[1] * cs[2] + v1[0] * sn[2];
                            r1[2] = v1[2] * cs[3] - v1[3] * sn[3]; r1[3] = v1[3] * cs[3] + v1[2] * sn[3];
                            v0 = r0; v1 = r1;
                        }
                        *(u32x4*)(qmla + (size_t)row * 1536 + col) = pack8(v0, v1);
                    } else {
                        *(u32x4*)(kvb + (size_t)row * 2048 + col) = pack8(v0, v1);
                    }
                }
            }
    }
};

struct EpiGate {
    static constexpr bool INPLACE = true, PF = false;
    unsigned char* ws;
    __device__ __forceinline__ bool operator()(Acc& acc, const Unit& u, int wr, int wc, int fr, int fq, const LAS u64* pf) const {
        EPI_ROWS(u, wr, fr);
        const bf16* proj = (const bf16*)(ws + WS_PROJ); bf16* mrgb = (bf16*)(ws + WS_MRGB);
        const int n = u.kind;
#pragma unroll
        for (int ai = 0; ai < 2; ++ai) {
            u32x4 ga[4][2], gb[4][2];
#pragma unroll
            for (int m = 0; m < 4; ++m)
#pragma unroll
                for (int bj = 0; bj < 2; ++bj) { const int row = row0 + ai * 128 + m * 16, col = u.pn * 256 + bj * 128 + wc * 32 + 8 * fq;
                    const bf16* gp = proj + (size_t)row * DINP + PC_GATE + col;
                    ga[m][bj] = *(const u32x4*)(gp + n * DM);
                    if (n < 2) gb[m][bj] = *(const u32x4*)(gp + (n + 1) * DM); }
#pragma unroll
            for (int m = 0; m < 4; ++m)
#pragma unroll
                for (int bj = 0; bj < 2; ++bj) { const int row = row0 + ai * 128 + m * 16, col = u.pn * 256 + bj * 128 + wc * 32 + 8 * fq;
                    const unsigned aw[4] = {ga[m][bj].x, ga[m][bj].y, ga[m][bj].z, ga[m][bj].w}, bw[4] = {gb[m][bj].x, gb[m][bj].y, gb[m][bj].z, gb[m][bj].w};
                    float f[8];
#pragma unroll
                    for (int j = 0; j < 4; ++j) { float n0 = bflo(aw[j]), n1 = bfhi(aw[j]);
                        if (n > 0) { n0 = fmaxf(n0, 1e-6f); n1 = fmaxf(n1, 1e-6f); }
                        if (n < 2) { n0 *= __builtin_amdgcn_rcpf(fmaxf(bflo(bw[j]), 1e-6f)); n1 *= __builtin_amdgcn_rcpf(fmaxf(bfhi(bw[j]), 1e-6f)); }
                        f[2 * j] = n0; f[2 * j + 1] = n1; }
                    f32x4& v0 = acc[ai][bj][m][0]; f32x4& v1 = acc[ai][bj][m][1];
                    v0[0] *= f[0]; v0[1] *= f[1]; v0[2] *= f[2]; v0[3] *= f[3]; v1[0] *= f[4]; v1[1] *= f[5]; v1[2] *= f[6]; v1[3] *= f[7];
                    if (n == 2) *(u32x4*)(mrgb + (size_t)row * DM + col) = pack8(v0, v1); }
        }
        return n == 2;
    }
};

template <bool SCALED> struct EpiResT {
    static constexpr bool INPLACE = false, PF = false;
    unsigned char* ws; int ssq_idx; bool f8copy;
    __device__ __forceinline__ void operator()(const Acc& acc, const Unit& u, int wr, int wc, int fr, int fq, const LAS u64* pf) const {
        EPI_ROWS(u, wr, fr);
        bf16* hb = (bf16*)(ws + WS_HB); u64* ssq = (u64*)(ws + CB_SSQ) + ssq_idx * NTOK;
        u32x4 bv[2][4][2];
#pragma unroll
        for (int ai = 0; ai < 2; ++ai)
#pragma unroll
            for (int m = 0; m < 4; ++m)
#pragma unroll
                for (int bj = 0; bj < 2; ++bj) bv[ai][m][bj] = *(const u32x4*)(hb + (size_t)(row0 + ai * 128 + m * 16) * DM + u.pn * 256 + bj * 128 + wc * 32 + 8 * fq);
#pragma unroll
        for (int ai = 0; ai < 2; ++ai)
#pragma unroll
            for (int m = 0; m < 4; ++m) {
                const int row = row0 + ai * 128 + m * 16;
                float sq = 0.f;
#pragma unroll
                for (int bj = 0; bj < 2; ++bj) {
                    const int col = u.pn * 256 + bj * 128 + wc * 32 + 8 * fq;
                    const u32x4 b = bv[ai][m][bj];
                    f32x4 v0 = acc[ai][bj][m][0], v1 = acc[ai][bj][m][1];
                    if (SCALED) {
#pragma unroll
                        for (int j = 0; j < 4; ++j) { v0[j] = __builtin_ldexpf(v0[j], -14); v1[j] = __builtin_ldexpf(v1[j], -14); } }
                    v0 = v0 + (f32x4){bflo(b.x), bfhi(b.x), bflo(b.y), bfhi(b.y)}; v1 = v1 + (f32x4){bflo(b.z), bfhi(b.z), bflo(b.w), bfhi(b.w)};
                    *(u32x4*)(hb + (size_t)row * DM + col) = pack8(v0, v1);
                    if (f8copy) *(u32x2*)(ws + WS_HB8 + (size_t)row * DM + col) = pack8_f8(v0 * F8_H, v1 * F8_H);
                    sq += (v0[0] * v0[0] + v0[1] * v0[1]) + (v0[2] * v0[2] + v0[3] * v0[3]) + (v1[0] * v1[0] + v1[1] * v1[1]) + (v1[2] * v1[2] + v1[3] * v1[3]);
                }
                ssq_atomic(ssq, row, sq, fr, fq);
            }
    }
};

typedef EpiResT<false> EpiRes;
static_assert(F8_ACT * F8_WDN == 16384.0f && F8_H * F8_WGU == 32768.0f, "power-of-two fp8 scales");
template <bool RSTD, bool IN8 = false, bool OUT8 = false> struct EpiSwiglu {
    static constexpr bool INPLACE = false, PF = RSTD;
    unsigned char* ws; unsigned act_off; int ldc; int ssq_idx;
    __device__ __forceinline__ unsigned pf_off(const Unit& u) const { return (unsigned)(CB_SSQ + (size_t)ssq_idx * NTOK * 8) + (unsigned)u.pm * 2048u; }
    __device__ __forceinline__ void operator()(const Acc& acc, const Unit& u, int wr, int wc, int fr, int fq, const LAS u64* pf) const {
        EPI_ROWS(u, wr, fr);
        bf16* act = (bf16*)(ws + act_off); const u64* ssq = (const u64*)(ws + CB_SSQ) + ssq_idx * NTOK;
        float rsv[2][4];
#pragma unroll
        for (int ai = 0; ai < 2; ++ai)
#pragma unroll
            for (int m = 0; m < 4; ++m) { rsv[ai][m] = RSTD ? row_rstd_lds(pf, ai * 128 + wr * 64 + m * 16 + fr, 1.0f / DM) : 1.0f; if (IN8) rsv[ai][m] = __builtin_ldexpf(rsv[ai][m], -15); }
#pragma unroll
        for (int ai = 0; ai < 2; ++ai)
#pragma unroll
            for (int m = 0; m < 4; ++m) {
                const int row = row0 + ai * 128 + m * 16;
                const float rs = rsv[ai][m], rsl = rs * -1.4426950408889634f, rs2 = OUT8 ? __builtin_ldexpf(rs * rs, 3) : rs * rs;
                f32x4 o[2];
#pragma unroll
                for (int n = 0; n < 2; ++n)
#pragma unroll
                    for (int j = 0; j < 4; ++j) { const float ag = acc[ai][0][m][n][j];
                        o[n][j] = ag * __builtin_amdgcn_rcpf(1.0f + __builtin_amdgcn_exp2f(ag * rsl)) * acc[ai][1][m][n][j] * rs2; }
                if (MK_PROBE_MODE == 9 && act_off == 1u) { const u32x4 pk = pack8(o[0], o[1]); asm volatile("" :: "v"(pk)); } else
                if (OUT8) *(u32x2*)((unsigned char*)act + (size_t)row * ldc + u.pn * 128 + wc * 32 + 8 * fq) = pack8_f8(o[0], o[1]); else
                *(u32x4*)(act + (size_t)row * ldc + u.pn * 128 + wc * 32 + 8 * fq) = pack8(o[0], o[1]);
            }
    }
};

struct EpiNull {
    static constexpr bool INPLACE = false, PF = false;
    unsigned char* ws;
    __device__ __forceinline__ void operator()(const Acc& acc, const Unit& u, int wr, int wc, int fr, int fq, const LAS u64* pf) const {
#pragma unroll
        for (int ai = 0; ai < 2; ++ai)
#pragma unroll
            for (int bj = 0; bj < 2; ++bj)
#pragma unroll
                for (int m = 0; m < 4; ++m) { asm volatile("" :: "v"(acc[ai][bj][m][0])); asm volatile("" :: "v"(acc[ai][bj][m][1])); }
    }
};

struct EpiSwigluF8 {
    static constexpr bool INPLACE = false, PF = false;
    unsigned char* ws;
    __device__ __forceinline__ void operator()(const Acc& acc, const Unit& u, int wr, int wc, int fr, int fq, const LAS u64* pf) const {
        EPI_ROWS(u, wr, fr);
        unsigned char* act = ws + WS_ACTE; constexpr int ldc = FFE;
        const float inv = 1.0f / (F8_XS * F8_WGU);
#pragma unroll
        for (int ai = 0; ai < 2; ++ai)
#pragma unroll
            for (int m = 0; m < 4; ++m) {
                const int row = row0 + ai * 128 + m * 16;
                f32x4 o[2];
#pragma unroll
                for (int n = 0; n < 2; ++n)
#pragma unroll
                    for (int j = 0; j < 4; ++j) { const float ag = acc[ai][0][m][n][j];
                        o[n][j] = ag * __builtin_amdgcn_rcpf(1.0f + __builtin_amdgcn_exp2f(ag * (inv * -1.4426950408889634f))) * acc[ai][1][m][n][j] * (inv * inv * F8_ACT); }
                *(u32x2*)(act + (size_t)row * ldc + u.pn * 128 + wc * 32 + 8 * fq) = pack8_f8(o[0], o[1]);
            }
    }
};
struct EpiMoeDown {
    static constexpr bool INPLACE = false, PF = true;
    unsigned char* ws; float oscale;
    __device__ __forceinline__ unsigned pf_off(const Unit& u) const { return (unsigned)WS_RASS + (unsigned)u.pm * 2048u; }
    __device__ __forceinline__ void operator()(const Acc& acc, const Unit& u, int wr, int wc, int fr, int fq, const LAS u64* pf) const {
        EPI_ROWS(u, wr, fr);
        bf16* ys = (bf16*)(ws + WS_YS); const int* rass = (const int*)(ws + WS_RASS); const float* topw = (const float*)(ws + WS_TOPW);
        int rav[2][4]; float wv[2][4];
#pragma unroll
        for (int ai = 0; ai < 2; ++ai)
#pragma unroll
            for (int m = 0; m < 4; ++m) { const u64 v = pf[ai * 128 + wr * 64 + m * 16 + fr]; rav[ai][m] = (int)(unsigned)v; wv[ai][m] = __uint_as_float((unsigned)(v >> 32)) * oscale; }
#pragma unroll
        for (int ai = 0; ai < 2; ++ai)
#pragma unroll
            for (int m = 0; m < 4; ++m) {
                const int ra = rav[ai][m];
                if (ra >= 0) {
                    const float w = wv[ai][m];
#pragma unroll
                    for (int bj = 0; bj < 2; ++bj) {
                        const int col = u.pn * 256 + bj * 128 + wc * 32 + 8 * fq;
                        bf16* dst = u.aux ? (bf16*)(ws + WS_YSQ) + ((size_t)(u.aux - 1) * 2048 + (size_t)(row0 + ai * 128 + m * 16 - 64 * 256)) * DM + col : ys + (size_t)ra * DM + col;
                        *(u32x4*)dst = pack8(acc[ai][bj][m][0] * w, acc[ai][bj][m][1] * w);
                    }
                }
            }
    }
};

struct SchedPlain {
    unsigned A, B; int nM, nN, G, c; unsigned a_tile, b_tile;
    __device__ __forceinline__ bool next(int i, Unit& u) const {
        const int total = nM * nN; const int L = i * G + c; if (L >= total) return false;
        int pm, pn; pg8::tile_decode(pg8::xcd_remap(L, total), nM, nN, pm, pn);
        u.pm = pm; u.pn = pn; u.kind = 0; u.aux = 0; u.A = A + (unsigned)pm * a_tile; u.B = B + (unsigned)pn * b_tile; return true;
    }
};
struct SchedIn {
    unsigned hb, win, memn, wmkv; int G, c, nN1; bool memkv;
    __device__ __forceinline__ bool next(int i, Unit& u) const {
        const int T0 = 32 * nN1, TOT = memkv ? T0 + 32 : T0; const int L = i * G + c; if (L >= TOT) return false;
        const int w = pg8::xcd_remap(L, TOT); int pm, pn;
        if (w < T0) { pg8::tile_decode(w, 32, nN1, pm, pn); u.kind = 0; u.A = hb + (unsigned)pm * 256u * DM * 2u; u.B = win + (unsigned)pn * 256u * DM * 2u; }
        else { pg8::tile_decode(w - T0, 4, 8, pm, pn); u.kind = 1; u.A = memn + (unsigned)pm * 256u * DM * 2u; u.B = wmkv + (unsigned)pn * 256u * DM * 2u; }
        u.pm = pm; u.pn = pn; u.aux = 0; return true;
    }
};
struct SchedIn2 {
    unsigned hb, win, memn, wmkv; int G, c, pnx;
    __device__ __forceinline__ bool next(int i, Unit& u) const {
        const int L = c - (G - 64); if (i != 0 || L < 0) return false;
        if (L < 32) { u.kind = 0; u.pm = L; u.pn = pnx; u.A = hb + (unsigned)L * 256u * DM * 2u; u.B = win + (unsigned)pnx * 256u * DM * 2u; }
        else { const int t = L - 32; u.kind = 1; u.pm = t & 3; u.pn = t >> 2; u.A = memn + (unsigned)(t & 3) * 256u * DM * 2u; u.B = wmkv + (unsigned)(t >> 2) * 256u * DM * 2u; }
        u.aux = 0; return true;
    }
};
struct SchedUp {
    unsigned proj, wq, wkv; int G, c;
    __device__ __forceinline__ bool next(int i, Unit& u) const {
        constexpr int T0 = 32 * 6, TOT = T0 + 32 * 8; const int L = i * G + c; if (L >= TOT) return false;
        const int w = pg8::xcd_remap(L, TOT); int pm, pn;
        if (w < T0) { pg8::tile_decode(w, 32, 6, pm, pn); u.kind = 0; u.A = proj + ((unsigned)pm * 256u * DINP + PC_CQ) * 2u; u.B = wq + (unsigned)pn * 256u * 512u * 2u; }
        else { pg8::tile_decode(w - T0, 32, 8, pm, pn); u.kind = 1; u.A = proj + ((unsigned)pm * 256u * DINP + PC_CKV) * 2u; u.B = wkv + (unsigned)pn * 256u * 512u * 2u; }
        u.pm = pm; u.pn = pn; u.aux = 0; return true;
    }
};
struct SchedGate {
    unsigned y, wbr; int G, c;
    __device__ __forceinline__ bool next(int i, Unit& u) const {
        const int ti = i / 3, n = i - 3 * ti; const int L = ti * G + c; if (L >= 256) return false;
        int pm, pn; pg8::tile_decode(pg8::xcd_remap(L, 256), 32, 8, pm, pn);
        u.pm = pm; u.pn = pn; u.kind = n; u.aux = 0;
        u.A = y + ((unsigned)pm * 256u * 3072u + n * 1024u) * 2u; u.B = wbr + ((unsigned)n * 2048u + pn * 256u) * 1024u * 2u; return true;
    }
};
struct SchedMoe {
    unsigned A, B; const unsigned char* ws; int nrt, nN, G, c; unsigned a_tile, b_tile, b_exp;
    __device__ __forceinline__ bool next(int i, Unit& u) const {
        const int total = nrt * nN; const int L = i * G + c; if (L >= total) return false;
        int pm, pn; pg8::tile_decode(pg8::xcd_remap(L, total), nrt, nN, pm, pn);
        const int e = __builtin_amdgcn_readfirstlane(__hip_atomic_load((const int*)(ws + WS_TEXP) + pm, __ATOMIC_RELAXED, __HIP_MEMORY_SCOPE_AGENT));
        u.pm = pm; u.pn = pn; u.kind = e; u.aux = 0; u.A = A + (unsigned)pm * a_tile; u.B = B + (unsigned)e * b_exp + (unsigned)pn * b_tile; return true;
    }
};

struct SchedMoeTail {
    unsigned A, B; const unsigned char* ws; int nrt, G, c; unsigned a_tile, b_tile, b_exp, kq_bytes;
    __device__ __forceinline__ bool next(int i, Unit& u) const {
        const int total = (nrt - 64) * 8 * 4; const int L = i * G + c; if (L >= total) return false;
        const int kq = L & 3, tile = L >> 2, pm = 64 + (tile >> 3), pn = tile & 7;
        const int e = __builtin_amdgcn_readfirstlane(__hip_atomic_load((const int*)(ws + WS_TEXP) + pm, __ATOMIC_RELAXED, __HIP_MEMORY_SCOPE_AGENT));
        u.pm = pm; u.pn = pn; u.kind = e; u.aux = kq + 1; u.A = A + (unsigned)pm * a_tile + (unsigned)kq * kq_bytes; u.B = B + (unsigned)e * b_exp + (unsigned)pn * b_tile + (unsigned)kq * kq_bytes; return true;
    }
};

namespace att {
__device__ __forceinline__ int crow(int r, int hi) { return (r & 3) + 8 * (r >> 2) + 4 * hi; }
__device__ __forceinline__ int v_st(int k, int c) { const int kk = (k & ~0xC) | ((k & 4) << 1) | ((k & 8) >> 1); return ((kk >> 3) * 4 + (c >> 5)) * 512 + ((kk & 7) * 32 + (c & 31)) * 2; }
__device__ __forceinline__ int v_rd_base(int lane) { return ((lane & 3) << 3) | (((lane >> 2) & 3) << 6) | (((lane >> 4) & 1) << 5) | (((lane >> 5) & 1) << 8); }
constexpr int v_rd_off(int d0, int ks, int half) { return d0 * 512 + ks * 4096 + half * 2048; }
template <int OFF> __device__ __forceinline__ s16x4 tr_read(unsigned vb) {
    s16x4 r; asm volatile("ds_read_b64_tr_b16 %0, %1 offset:%2" : "=&v"(r) : "v"(vb), "i"(OFF) : "memory"); return r;
}
template <int D0> __device__ __forceinline__ void pv_one(f32x16& od, unsigned vb, bf16x8 pa0, bf16x8 pa1, bf16x8 pa2, bf16x8 pa3) {
    const s16x4 l0 = tr_read<v_rd_off(D0, 0, 0)>(vb), h0 = tr_read<v_rd_off(D0, 0, 1)>(vb), l1 = tr_read<v_rd_off(D0, 1, 0)>(vb), h1 = tr_read<v_rd_off(D0, 1, 1)>(vb);
    const s16x4 l2 = tr_read<v_rd_off(D0, 2, 0)>(vb), h2 = tr_read<v_rd_off(D0, 2, 1)>(vb), l3 = tr_read<v_rd_off(D0, 3, 0)>(vb), h3 = tr_read<v_rd_off(D0, 3, 1)>(vb);
    asm volatile("s_waitcnt lgkmcnt(0)" ::: "memory"); SBAR();
#define ATT_PK(L, H) (bf16x8){L[0], L[1], L[2], L[3], H[0], H[1], H[2], H[3]}
    od = __builtin_amdgcn_mfma_f32_32x32x16_bf16(pa0, ATT_PK(l0, h0), od, 0, 0, 0);
    od = __builtin_amdgcn_mfma_f32_32x32x16_bf16(pa1, ATT_PK(l1, h1), od, 0, 0, 0);
    od = __builtin_amdgcn_mfma_f32_32x32x16_bf16(pa2, ATT_PK(l2, h2), od, 0, 0, 0);
    od = __builtin_amdgcn_mfma_f32_32x32x16_bf16(pa3, ATT_PK(l3, h3), od, 0, 0, 0);
#undef ATT_PK
}

template <int DK, int K1DIM, bool CAUSAL>
__device__ __forceinline__ void attn_unit(LAS unsigned char* lds, const int tid, const bf16* __restrict__ Qb, int ldq, const bf16* __restrict__ K1, int ldk1, const bf16* __restrict__ K2, int ldk2,
                                          const bf16* __restrict__ Vp, int ldv, bf16* __restrict__ Ob, int ldo, int NT, int q0, float C) {
    constexpr int NKS = DK / 16, KROWB = DK * 2 + 16  , SHM_K = 64 * KROWB, SHM_V = 64 * 128 * 2;
    constexpr int NC1 = K1DIM / 8, NC2 = (DK - K1DIM) / 8, KC1 = NC1 / 8, KC2 = NC2 / 8;
    static_assert(NC2 == 0 || NC2 == 8, "K2 part is 0 or 64 wide");
    const int wid = tid >> 6, lane = tid & 63, r32 = lane & 31, hi = lane >> 5;
    LAS unsigned char* V_lds = lds; LAS unsigned char* K_lds = lds + 3 * SHM_V;
    LAS float* wsp = (LAS float*)(lds + 3 * SHM_V + 2 * SHM_K) + wid * 64;
    static_assert(3 * SHM_V + 2 * SHM_K + 8 * 64 * 4 <= RING_BYTES, "attention LDS");
    const bool grpB = wid >= 4; LAS float* li_l = wsp; LAS float* al_l = wsp + 32;
    float m_reg = -1e30f, l_reg = 0.f; f32x16 o[4] = {}; bf16x8 qr[NKS];
    { const bf16* Qw = Qb + (unsigned)((wid * 32 + r32) * ldq + hi * 8);
#pragma unroll
      for (int d0 = 0; d0 < NKS; ++d0) qr[d0] = *(const bf16x8*)(Qw + d0 * 16); }
    const int sr = tid >> 4, sc = (tid & 15) * 8, vst0 = v_st(sr, sc), vst1 = v_st(32 + sr, sc);
    const unsigned vb0 = (unsigned)(uintptr_t)V_lds + v_rd_base(lane);
    const unsigned voffv = (unsigned)(sr * ldv + sc);
    unsigned koff1[KC1], kw1[KC1];
#pragma unroll
    for (int i = 0; i < KC1; ++i) { const int c = tid + 512 * i, row = c / NC1, cc = (c % NC1) * 8; koff1[i] = (unsigned)(row * ldk1 + cc); kw1[i] = (unsigned)(row * KROWB + cc * 2); }
    const unsigned koff2 = (unsigned)((tid >> 3) * ldk2 + (tid & 7) * 8), kw2 = (unsigned)((tid >> 3) * KROWB + (K1DIM + (tid & 7) * 8) * 2);
    const unsigned kr0 = (unsigned)(r32 * KROWB + hi * 16);
    bf16x8 ks1[KC1], ks2, vs0, vs1;
#define ATT_SLOAD(k0) do { const bf16* kb_ = K1 + (size_t)(k0) * ldk1; _Pragma("unroll") for (int i_ = 0; i_ < KC1; ++i_) ks1[i_] = *(const bf16x8*)(kb_ + koff1[i_]); \
        if (KC2) { const bf16* k2_ = K2 + (size_t)(k0) * ldk2; ks2 = *(const bf16x8*)(k2_ + koff2); } \
        const bf16* vb_ = Vp + (size_t)(k0) * ldv; vs0 = *(const bf16x8*)(vb_ + voffv); vs1 = *(const bf16x8*)(vb_ + (size_t)32 * ldv + voffv); } while (0)
#define ATT_SWRITE(b, vbuf) do { _Pragma("unroll") for (int i_ = 0; i_ < KC1; ++i_) *(LAS bf16x8*)(K_lds + (b) * SHM_K + kw1[i_]) = ks1[i_]; \
        if (KC2) *(LAS bf16x8*)(K_lds + (b) * SHM_K + kw2) = ks2; \
        *(LAS bf16x8*)(V_lds + (vbuf) * SHM_V + vst0) = vs0; *(LAS bf16x8*)(V_lds + (vbuf) * SHM_V + vst1) = vs1; } while (0)
#define ATT_PV(vbuf) do { const unsigned vb = vb0 + (vbuf) * SHM_V; \
          pv_one<0>(o[0], vb, pa0, pa1, pa2, pa3); pv_one<1>(o[1], vb, pa0, pa1, pa2, pa3); pv_one<2>(o[2], vb, pa0, pa1, pa2, pa3); pv_one<3>(o[3], vb, pa0, pa1, pa2, pa3); } while (0)
    __syncthreads();
    ATT_SLOAD(0); ATT_SWRITE(0, 0); __syncthreads();
    bf16x8 pa0 = {}, pa1 = {}, pa2 = {}, pa3 = {};
    int vcur = 0, vprev = 0;
#pragma unroll 1
    for (int j = 0; j < NT; ++j) {
        const int bsel = j & 1;
        if (grpB && j > 0) ATT_PV(vprev);
        if (j + 1 < NT) ATT_SLOAD((j + 1) * 64);
        f32x16 p0 = {}, p1 = {};
        { const LAS unsigned char* Kb = K_lds + bsel * SHM_K + kr0;
#pragma unroll
          for (int d0 = 0; d0 < NKS; ++d0) {
            const bf16x8 b0 = *(const LAS bf16x8*)(Kb + d0 * 32);
            const bf16x8 b1 = *(const LAS bf16x8*)(Kb + 32 * KROWB + d0 * 32);
            p0 = __builtin_amdgcn_mfma_f32_32x32x16_bf16(b0, qr[d0], p0, 0, 0, 0);
            p1 = __builtin_amdgcn_mfma_f32_32x32x16_bf16(b1, qr[d0], p1, 0, 0, 0); } }
        if (CAUSAL && j >= NT - 4) {
            const int qpos = q0 + wid * 32 + r32, kb = j * 64;
#pragma unroll
            for (int r = 0; r < 16; ++r) { const int kp = kb + crow(r, hi); p0[r] = (kp <= qpos) ? p0[r] : -1e30f; p1[r] = (kp + 32 <= qpos) ? p1[r] : -1e30f; }
        }
        float pmax = p0[0];
#pragma unroll
        for (int r = 1; r < 16; ++r) pmax = fmaxf(pmax, p0[r]);
#pragma unroll
        for (int r = 0; r < 16; ++r) pmax = fmaxf(pmax, p1[r]);
        { auto rr = __builtin_amdgcn_permlane32_swap(__float_as_uint(pmax), __float_as_uint(pmax), false, false); pmax = fmaxf(__uint_as_float(rr[0]), __uint_as_float(rr[1])); }
        if (!__all(pmax <= m_reg)) {
            const float mn = fmaxf(m_reg, pmax), alpha = __builtin_amdgcn_exp2f((m_reg - mn) * C); m_reg = mn; l_reg *= alpha;
            if (hi == 0) al_l[r32] = alpha;
            asm volatile("s_waitcnt lgkmcnt(0)" ::: "memory");
#pragma unroll
            for (int r = 0; r < 16; ++r) { const float a = al_l[crow(r, hi)];
#pragma unroll
                for (int d = 0; d < 4; ++d) o[d][r] *= a; }
        }
        const float mnC = -m_reg * C; float ps = 0.f;
#pragma unroll
        for (int r = 0; r < 16; ++r) { p0[r] = __builtin_amdgcn_exp2f(fmaf(p0[r], C, mnC)); p1[r] = __builtin_amdgcn_exp2f(fmaf(p1[r], C, mnC)); ps += p0[r] + p1[r]; }
        { auto rr = __builtin_amdgcn_permlane32_swap(__float_as_uint(ps), __float_as_uint(ps), false, false); ps = __uint_as_float(rr[0]) + __uint_as_float(rr[1]); }
        l_reg += ps;
#define ATT_PK4(P, BASE, OUT) do { unsigned a0 = cvt_pk_bf16(P[BASE + 0], P[BASE + 1]), a1 = cvt_pk_bf16(P[BASE + 2], P[BASE + 3]); \
        unsigned b0_ = cvt_pk_bf16(P[BASE + 4], P[BASE + 5]), b1_ = cvt_pk_bf16(P[BASE + 6], P[BASE + 7]); \
        auto r0_ = __builtin_amdgcn_permlane32_swap(a0, b0_, false, false); auto r1_ = __builtin_amdgcn_permlane32_swap(a1, b1_, false, false); \
        u32x4 w_ = {r0_[0], r1_[0], r0_[1], r1_[1]}; OUT = *reinterpret_cast<bf16x8*>(&w_); } while (0)
        ATT_PK4(p0, 0, pa0); ATT_PK4(p0, 8, pa1); ATT_PK4(p1, 0, pa2); ATT_PK4(p1, 8, pa3);
#undef ATT_PK4
        if (!grpB) ATT_PV(vcur);
        const int vnext = vcur == 2 ? 0 : vcur + 1;
        if (j + 1 < NT) ATT_SWRITE(bsel ^ 1, vnext);
        vprev = vcur; vcur = vnext;
        __syncthreads();
    }
    if (grpB) ATT_PV(vprev);
    if (hi == 0) li_l[r32] = l_reg;
    asm volatile("s_waitcnt lgkmcnt(0)" ::: "memory");
    int ldo_o = ldo, hi_o = hi; asm volatile("" : "+v"(hi_o), "+s"(ldo_o));
    bf16* Ow = Ob + (unsigned)((wid * 32) * ldo_o + r32);
#pragma unroll
    for (int r = 0; r < 16; ++r) { const int orow = crow(r, hi_o); const float rl = __builtin_amdgcn_rcpf(li_l[orow]);
        bf16* op = Ow + (unsigned)(orow * ldo_o);
#pragma unroll
        for (int d0 = 0; d0 < 4; ++d0) op[d0 * 32] = f2bf(o[d0][r] * rl); }
#undef ATT_SLOAD
#undef ATT_SWRITE
#undef ATT_PV
}
}

namespace hg {
__device__ __forceinline__ int crow(int r, int hi) { return (r & 3) + 8 * (r >> 2) + 4 * hi; }
__device__ __forceinline__ void mma32(f32x16& acc, const LAS bf16* A, int lda, const LAS bf16* Bt, int ldb, int K, int r32, int hi) {
    for (int k0 = 0; k0 < K; k0 += 16) {
        const bf16x8 a = *(const LAS bf16x8*)(A + r32 * lda + k0 + hi * 8);
        const bf16x8 b = *(const LAS bf16x8*)(Bt + r32 * ldb + k0 + hi * 8);
        acc = __builtin_amdgcn_mfma_f32_32x32x16_bf16(a, b, acc, 0, 0, 0);
    }
}
constexpr int LD_D = 136, LD_S = 72, LD_O = 132;
constexpr int L_TOT = 0;
constexpr int L_VT = 2048;
constexpr int L_KT = L_VT + 128 * LD_S * 2;
constexpr int L_QT = L_KT + 128 * LD_S * 2;
constexpr int L_QH = L_QT + 64 * LD_D * 2;
constexpr int L_P = L_QH + 64 * LD_D * 2;
constexpr int L_O = L_P + 64 * LD_S * 2;
constexpr int L_END = L_O + 64 * LD_O * 4;
static_assert(L_END <= RING_BYTES, "hgrn LDS");

__device__ __forceinline__ void gate_scan(LAS unsigned char* lds, const float (&z)[16], float lb, int d, int jq, float (&kk)[16], float (&bl)[16], float& bref, float& b63) {
    LAS float* tot = (LAS float*)(lds + L_TOT);
    float run = 0.f;
#pragma unroll
    for (int i = 0; i < 16; ++i) {
        const float f = lb + (1.0f - lb) * HG_SIGMOID(z[i]);
        run += __logf(fmaxf(f, 1e-20f)); bl[i] = run; kk[i] = 1.0f - f;
    }
    tot[jq * 128 + d] = run;
    __syncthreads();
    const float t0 = tot[d], t1 = tot[128 + d], t2 = tot[256 + d], t3 = tot[384 + d];
    const float off = (jq > 0 ? t0 : 0.f) + (jq > 1 ? t1 : 0.f) + (jq > 2 ? t2 : 0.f);
#pragma unroll
    for (int i = 0; i < 16; ++i) bl[i] += off;
    bref = t0 + t1; b63 = (t0 + t1) + (t2 + t3);
}
__device__ __forceinline__ void stage_vt(LAS unsigned char* lds, const bf16x8 (&vch)[2], int tid) {
    LAS bf16* VT = (LAS bf16*)(lds + L_VT);
#pragma unroll
    for (int i = 0; i < 2; ++i) { const int id = tid + 512 * i, s = id >> 4, e8 = (id & 15) * 8;
#pragma unroll
        for (int q = 0; q < 8; ++q) VT[(e8 + q) * LD_S + s] = (bf16)vch[i][q]; }
}
__device__ __forceinline__ void pass1_unit(LAS unsigned char* lds, const int tid, int unit, const float* zf, const bf16* proj, const float* lbv, float* hu, float* hdec) {
    const int wid = tid >> 6, lane = tid & 63, r32 = lane & 31, hi = lane >> 5;
    const int bh = unit >> 5, c = unit & 31, b = bh >> 3, hh = bh & 7, tok0 = b * SEQ + c * CHUNK;
    const int d = tid & 127, jq = tid >> 7;
    float z[16], kk[16], bl[16], bref, b63; bf16x8 vch[2];
    const float lb = lbv[hh * 128 + d];
#pragma unroll
    for (int i = 0; i < 16; ++i) z[i] = zf[(size_t)(tok0 + jq * 16 + i) * 1024 + hh * 128 + d];
#pragma unroll
    for (int i = 0; i < 2; ++i) { const int id = tid + 512 * i, s = id >> 4, e8 = (id & 15) * 8; vch[i] = *(const bf16x8*)(proj + (size_t)(tok0 + s) * DINP + PC_I + hh * 128 + e8); }
    __syncthreads();
    gate_scan(lds, z, lb, d, jq, kk, bl, bref, b63);
    LAS bf16* KT = (LAS bf16*)(lds + L_KT);
#pragma unroll
    for (int i = 0; i < 16; ++i) KT[d * LD_S + jq * 16 + i] = f2bf(kk[i] * __expf(b63 - bl[i]));
    stage_vt(lds, vch, tid);
    if (jq == 0) hdec[(size_t)unit * 128 + d] = __expf(b63);
    __syncthreads();
    const LAS bf16* VT = (const LAS bf16*)(lds + L_VT);
    const int eb = wid >> 1;
#pragma unroll
    for (int q = 0; q < 2; ++q) { const int db = (wid & 1) * 2 + q; f32x16 acc = {};
        mma32(acc, VT + eb * 32 * LD_S, LD_S, KT + db * 32 * LD_S, LD_S, 64, r32, hi);
#pragma unroll
        for (int r = 0; r < 16; ++r) hu[(size_t)unit * 16384 + (size_t)(eb * 32 + crow(r, hi)) * 128 + db * 32 + r32] = acc[r]; }
}
__device__ __forceinline__ void pass2_task(int task, const float* hu, const float* hdec, bf16* hs) {
    const int bh = task >> 12, g = task & 4095, d4 = (g & 31) * 4;
    f32x4 st = {0.f, 0.f, 0.f, 0.f};
    const float* p = hu + (size_t)bh * 32 * 16384 + (size_t)g * 4;
    bf16* q = hs + (size_t)bh * 32 * 16384 + (size_t)g * 4;
    const float* dp = hdec + (size_t)bh * 32 * 128 + d4;
#pragma unroll 8
    for (int c = 0; c < 32; ++c) { const f32x4 u = *(const f32x4*)(p + (size_t)c * 16384); const f32x4 dv = *(const f32x4*)(dp + c * 128);
        u32x2 o; o.x = cvt_pk_bf16(st[0], st[1]); o.y = cvt_pk_bf16(st[2], st[3]); *(u32x2*)(q + (size_t)c * 16384) = o; st = dv * st + u; }
}
struct P3In { float z[16]; bf16 qraw[16]; bf16x8 vch[2]; float lb; };
__device__ __forceinline__ void pass3_load(P3In& R, const int tid, int unit, const float* zf, const bf16* proj, const float* lbv, const bf16* hs) {
    const int bh = unit >> 5, c = unit & 31, b = bh >> 3, hh = bh & 7, tok0 = b * SEQ + c * CHUNK;
    const unsigned d = tid & 127, jq = tid >> 7;
    const float* zb = zf + (size_t)tok0 * 1024 + hh * 128; const unsigned zo = jq * 16u * 1024u + d;
    const bf16* qb = proj + (size_t)tok0 * DINP + PC_Q + hh * 128; const unsigned qo = jq * 16u * (unsigned)DINP + d;
    const bf16* vb = proj + (size_t)tok0 * DINP + PC_I + hh * 128; const unsigned vo = ((unsigned)tid >> 4) * (unsigned)DINP + ((unsigned)tid & 15u) * 8u;
    R.lb = (lbv + hh * 128)[d];
#pragma unroll
    for (int i = 0; i < 16; ++i) R.z[i] = (zb + i * 1024)[zo];
#pragma unroll
    for (int i = 0; i < 16; ++i) R.qraw[i] = (qb + i * DINP)[qo];
#pragma unroll
    for (int i = 0; i < 2; ++i) R.vch[i] = *(const bf16x8*)((vb + 32 * i * DINP) + vo);
}
__device__ __forceinline__ void pass3_compute(LAS unsigned char* lds, const int tid, int unit, P3In& R, int next_unit, const float* zf, const bf16* proj, const float* lbv, const bf16* hs, const float* hgn, bf16* y) {
    const int wid = tid >> 6, lane = tid & 63, r32 = lane & 31, hi = lane >> 5;
    const int bh = unit >> 5, c = unit & 31, b = bh >> 3, hh = bh & 7, tok0 = b * SEQ + c * CHUNK;
    const int d = tid & 127, jq = tid >> 7;
    const int tb = wid >> 2, eb = wid & 3;
    const int tn = tid >> 3, part = tid & 7;
    float kk[16], bl[16], bref, b63;
    const float (&z)[16] = R.z; const bf16 (&qraw)[16] = R.qraw; const bf16x8 (&vch)[2] = R.vch; const float lb = R.lb;
    bf16x8 st[8]; u32x4 g0, g1;
    { const bf16* sp = hs + (size_t)unit * 16384 + (size_t)(eb * 32 + r32) * 128 + hi * 8;
#pragma unroll
      for (int k = 0; k < 8; ++k) st[k] = *(const bf16x8*)(sp + 16 * k); }
    { const bf16* gp = proj + (size_t)(tok0 + tn) * DINP + PC_G + hh * 128 + part * 16; g0 = *(const u32x4*)gp; g1 = *(const u32x4*)(gp + 8); }
    __syncthreads();
    gate_scan(lds, z, lb, d, jq, kk, bl, bref, b63);
    LAS bf16* KT = (LAS bf16*)(lds + L_KT); LAS bf16* QT = (LAS bf16*)(lds + L_QT); LAS bf16* QH = (LAS bf16*)(lds + L_QH);
    const float eref = __expf(bref);
#pragma unroll
    for (int i = 0; i < 16; ++i) { const int t = jq * 16 + i;
        const float qv = bf2f(qraw[i]), er = __expf(bl[i] - bref);
        QT[t * LD_D + d] = f2bf(qv * er);
        QH[t * LD_D + d] = f2bf(qv * (er * eref));
        KT[t * LD_D + d] = f2bf(kk[i] * __builtin_amdgcn_rcpf(er)); }
    stage_vt(lds, vch, tid);
    if (next_unit >= 0) pass3_load(R, tid, next_unit, zf, proj, lbv, hs);
    __syncthreads();
    LAS bf16* PL = (LAS bf16*)(lds + L_P);
    if (wid < 4) {
        const int tb2 = wid >> 1, sb = wid & 1; f32x16 acc = {};
        if (!(tb2 == 0 && sb == 1)) mma32(acc, QT + tb2 * 32 * LD_D, LD_D, KT + sb * 32 * LD_D, LD_D, 128, r32, hi);
#pragma unroll
        for (int r = 0; r < 16; ++r) { const int t = tb2 * 32 + crow(r, hi), s2 = sb * 32 + r32; PL[t * LD_S + s2] = f2bf(s2 <= t ? acc[r] : 0.f); }
    }
    __syncthreads();
    {
        f32x16 acc = {};
        mma32(acc, PL + tb * 32 * LD_S, LD_S, (const LAS bf16*)(lds + L_VT) + eb * 32 * LD_S, LD_S, 64, r32, hi);
#pragma unroll
        for (int k = 0; k < 8; ++k) {
            const bf16x8 a = *(const LAS bf16x8*)(QH + (tb * 32 + r32) * LD_D + 16 * k + hi * 8);
            acc = __builtin_amdgcn_mfma_f32_32x32x16_bf16(a, st[k], acc, 0, 0, 0);
        }
        LAS float* OL = (LAS float*)(lds + L_O);
#pragma unroll
        for (int r = 0; r < 16; ++r) OL[(tb * 32 + crow(r, hi)) * LD_O + eb * 32 + r32] = acc[r];
    }
    __syncthreads();
    {
        const LAS float* orow = (const LAS float*)(lds + L_O) + tn * LD_O + part * 16;
        float v[16]; float ss = 0.f;
#pragma unroll
        for (int i = 0; i < 16; ++i) { v[i] = orow[i]; ss += v[i] * v[i]; }
        ss += shflx(ss, 1, lane); ss += shflx(ss, 2, lane); ss += shflx(ss, 4, lane);
        const float rs = rsqrtf(ss * (1.0f / 128.0f) + EPS);
        const unsigned gw[8] = {g0.x, g0.y, g0.z, g0.w, g1.x, g1.y, g1.z, g1.w};
        float ov[16];
#pragma unroll
        for (int i = 0; i < 8; ++i) { const float ga = bflo(gw[i]), gb = bfhi(gw[i]);
            ov[2 * i] = v[2 * i] * rs * hgn[part * 16 + 2 * i] * (ga * HG_SIGMOID(ga));
            ov[2 * i + 1] = v[2 * i + 1] * rs * hgn[part * 16 + 2 * i + 1] * (gb * HG_SIGMOID(gb)); }
        bf16* yp = y + (size_t)(tok0 + tn) * 3072 + hh * 128 + part * 16;
        u32x4 w0, w1;
        w0.x = cvt_pk_bf16(ov[0], ov[1]); w0.y = cvt_pk_bf16(ov[2], ov[3]); w0.z = cvt_pk_bf16(ov[4], ov[5]); w0.w = cvt_pk_bf16(ov[6], ov[7]);
        w1.x = cvt_pk_bf16(ov[8], ov[9]); w1.y = cvt_pk_bf16(ov[10], ov[11]); w1.z = cvt_pk_bf16(ov[12], ov[13]); w1.w = cvt_pk_bf16(ov[14], ov[15]);
        *(u32x4*)yp = w0; *(u32x4*)(yp + 8) = w1;
    }
}
__device__ __forceinline__ void pass3_unit(LAS unsigned char* lds, const int tid, int unit, const float* zf, const bf16* proj, const float* lbv, const bf16* hs, const float* hgn, bf16* y) {
    P3In R; pass3_load(R, tid, unit, zf, proj, lbv, hs); pass3_compute(lds, tid, unit, R, -1, zf, proj, lbv, hs, hgn, y);
}
}

struct TDesc { const float* src; bf16* dst; const float* gain; size_t sstride, dstride; int gstride, nbatch, K, ld, Ndst, map; float f8scale; };
enum { MAP_ID = 0, MAP_WIN = 1, MAP_QUP = 2, MAP_GU_D = 3, MAP_GU_E = 4, MAP_GATE = 5, MAP_WIN4K = 6 };
__device__ __forceinline__ int src_col(int map, int n) {
    switch (map) {
    case MAP_WIN4K: n += 4096; [[fallthrough]];
    case MAP_WIN:
        if (n < PC_KR) return n;
        if (n < PC_KR + 64) { const int p = n - PC_KR; return 5120 + (p & 1) * 32 + (p >> 1); }
        if (n < PC_QM) return -1;
        return n - 192;
    case MAP_QUP: { const int hd = n / QKD, c = n % QKD; if (c < NOPE) return n; const int p = c - NOPE; return hd * QKD + NOPE + (p & 1) * 32 + (p >> 1); }
    case MAP_GU_D: { const int t = n >> 8, r = n & 255; return r < 128 ? 128 * t + r : FF + 128 * t + (r - 128); }
    case MAP_GATE: return n + 6208;
    case MAP_GU_E: { const int t = n >> 8, r = n & 255; return r < 128 ? 128 * t + r : FFE + 128 * t + (r - 128); }
    default: return n;
    }
}
__device__ __forceinline__ void transpose_item(const TDesc& D, int item, LAS float* scr, int lane) {
    const int nblk = D.Ndst / 32, per = (D.K / 64) * nblk, bt = item / per, r = item % per, kb = r / nblk, nb = r % nblk, k0 = 64 * kb, n0 = 32 * nb;
    const float* W = D.src + (size_t)bt * D.sstride; bf16* WT = D.dst + (size_t)bt * D.dstride; const float* gn = D.gain ? D.gain + (size_t)bt * D.gstride : nullptr;
    const int sc = src_col(D.map, n0 + (lane & 31));
    const float msk = sc < 0 ? 0.f : 1.f;
    const float* wp = W + (size_t)(k0 + (lane >> 5)) * D.ld + (sc < 0 ? 0 : sc);
    float v[32];
#pragma unroll
    for (int i = 0; i < 32; ++i) v[i] = __builtin_nontemporal_load(wp + (size_t)(2 * i) * D.ld);
#pragma unroll
    for (int i = 0; i < 32; ++i) scr[(2 * i + (lane >> 5)) * 33 + (lane & 31)] = v[i] * msk;
    LDS_WAIT(); asm volatile("" ::: "memory");
    const int c = lane & 7;
    f32x4 g0 = {1.f, 1.f, 1.f, 1.f}, g1 = g0;
    if (gn) { g0 = *(const f32x4*)(gn + k0 + 8 * c); g1 = *(const f32x4*)(gn + k0 + 8 * c + 4); }
    if (D.f8scale != 0.f) {
        g0 = g0 * D.f8scale; g1 = g1 * D.f8scale; unsigned char* W8 = (unsigned char*)D.dst + (size_t)bt * D.dstride;
#pragma unroll
        for (int j = 0; j < 4; ++j) { const int n = (lane >> 3) + 8 * j; const LAS float* s = scr + (8 * c) * 33 + n;
            const f32x4 a = {s[0 * 33] * g0[0], s[1 * 33] * g0[1], s[2 * 33] * g0[2], s[3 * 33] * g0[3]}, b = {s[4 * 33] * g1[0], s[5 * 33] * g1[1], s[6 * 33] * g1[2], s[7 * 33] * g1[3]};
            *(u32x2*)(W8 + (size_t)(n0 + n) * D.K + k0 + 8 * c) = pack8_f8(a, b); }
    } else {
#pragma unroll
    for (int j = 0; j < 4; ++j) { const int n = (lane >> 3) + 8 * j; const LAS float* s = scr + (8 * c) * 33 + n;
        u32x4 o; o.x = cvt_pk_bf16(s[0 * 33] * g0[0], s[1 * 33] * g0[1]); o.y = cvt_pk_bf16(s[2 * 33] * g0[2], s[3 * 33] * g0[3]);
        o.z = cvt_pk_bf16(s[4 * 33] * g1[0], s[5 * 33] * g1[1]); o.w = cvt_pk_bf16(s[6 * 33] * g1[2], s[7 * 33] * g1[3]);
        *(u32x4*)(WT + (size_t)(n0 + n) * D.K + k0 + 8 * c) = o; }
    }
    LDS_WAIT(); asm volatile("" ::: "memory");
}
constexpr int TL_LD = 260, TL_K = 128, TL_RW = TL_K / 8;
__device__ __forceinline__ void tl_decode(const TDesc& D, int tile, int& bt, int& k0, int& n0) {
    const int nblk = D.Ndst / 256, per = (D.K / TL_K) * nblk; bt = tile / per; const int r = tile % per; k0 = TL_K * (r / nblk); n0 = 256 * (r % nblk);
}
__device__ __forceinline__ void tl_load(const TDesc& D, int tile, f32x4 (&v)[TL_RW], int wave, int lane) {
    int bt, k0, n0; tl_decode(D, tile, bt, k0, n0);
    const int sc = src_col(D.map, n0 + 4 * lane);
    const float* wp = D.src + (size_t)bt * D.sstride + (size_t)(k0 + wave * TL_RW) * D.ld + sc;
#pragma unroll
    for (int i = 0; i < TL_RW; ++i) v[i] = __builtin_nontemporal_load((const f32x4*)(wp + (size_t)i * D.ld));
}
__device__ __forceinline__ void tl_store(const TDesc& D, int tile, const f32x4 (&v)[TL_RW], LAS float* scr, int tid, int wave, int lane) {
    int bt, k0, n0; tl_decode(D, tile, bt, k0, n0);
#pragma unroll
    for (int i = 0; i < TL_RW; ++i) *(LAS f32x4*)(scr + (wave * TL_RW + i) * TL_LD + 4 * lane) = v[i];
    __syncthreads();
    constexpr int HK = TL_K / 2;
    const int n = tid >> 1, h = tid & 1; const LAS float* s = scr + (HK * h) * TL_LD + n;
    const float* gn = D.gain ? D.gain + (size_t)bt * D.gstride + k0 + HK * h : nullptr;
    const float sc = D.f8scale != 0.f ? D.f8scale : 1.0f;
#pragma unroll
    for (int p = 0; p < HK / 16; ++p) {
        f32x4 x[4];
#pragma unroll
        for (int q = 0; q < 4; ++q) { f32x4 g = {sc, sc, sc, sc}; if (gn) g = g * *(const f32x4*)(gn + 16 * p + 4 * q);
            const LAS float* sq = s + (16 * p + 4 * q) * TL_LD;
            x[q] = (f32x4){sq[0] * g[0], sq[TL_LD] * g[1], sq[2 * TL_LD] * g[2], sq[3 * TL_LD] * g[3]}; }
        if (D.f8scale != 0.f) {
            unsigned char* W8 = (unsigned char*)D.dst + (size_t)bt * D.dstride + (size_t)(n0 + n) * D.K + k0 + HK * h + 16 * p;
            const u32x2 a = pack8_f8(x[0], x[1]), b = pack8_f8(x[2], x[3]);
            *(u32x4*)W8 = (u32x4){a.x, a.y, b.x, b.y};
        } else {
            bf16* WT = D.dst + (size_t)bt * D.dstride + (size_t)(n0 + n) * D.K + k0 + HK * h + 16 * p;
            *(u32x4*)WT = pack8(x[0], x[1]); *(u32x4*)(WT + 8) = pack8(x[2], x[3]);
        }
    }
    __syncthreads();
}
__device__ __forceinline__ float row_to_bf16(const float* xrow, bf16* orow, const float* gain, bool normalize, int lane, unsigned char* o8 = nullptr) {
    f32x4 v[8]; float s = 0.f;
#pragma unroll
    for (int j = 0; j < 8; ++j) { v[j] = *(const f32x4*)(xrow + 4 * lane + 256 * j); s += (v[j][0] * v[j][0] + v[j][1] * v[j][1]) + (v[j][2] * v[j][2] + v[j][3] * v[j][3]); }
    s = wave_sum(s, lane);
    const float rs = normalize ? rsqrtf(s * (1.0f / DM) + EPS) : 1.0f;
#pragma unroll
    for (int j = 0; j < 8; ++j) { f32x4 w = v[j] * rs; if (gain) w = w * *(const f32x4*)(gain + 4 * lane + 256 * j);
        u32x2 o; o.x = cvt_pk_bf16(w[0], w[1]); o.y = cvt_pk_bf16(w[2], w[3]); *(u32x2*)(orow + 4 * lane + 256 * j) = o;
        if (o8) { const f32x4 z = w * F8_H; int q = 0; q = __builtin_amdgcn_cvt_pk_fp8_f32(clamp448(z[0]), clamp448(z[1]), q, false); q = __builtin_amdgcn_cvt_pk_fp8_f32(clamp448(z[2]), clamp448(z[3]), q, true); *(int*)(o8 + 4 * lane + 256 * j) = q; } }
    return s;
}

struct Args { const void* in[22]; float* out; unsigned char* ws; int ph_lo, ph_hi; };
static_assert(sizeof(Args) == 200 && offsetof(Args, out) == 176 && offsetof(Args, ws) == 184, "Args layout");
constexpr int PH_FINAL = 19, N_PHASES = 20;

__global__ void __launch_bounds__(NTHR, 2) trunk_fwd(Args args) {
    extern __shared__ __attribute__((aligned(16))) unsigned char lds_raw[];
    LAS unsigned char* lds = (LAS unsigned char*)lds_raw;
    const int wave0 = __builtin_amdgcn_readfirstlane((int)threadIdx.x >> 6);
#define PHASE_IDS int tid = wave0 * 64 + lane_id(); const CAS char* kargs = (const CAS char*)__builtin_amdgcn_kernarg_segment_ptr(); asm volatile("" : "+s"(kargs)); \
    GAS unsigned char* wsg = *(GAS unsigned char* const CAS*)(kargs + 184); int G = gridDim.x, bx = blockIdx.x; asm volatile("" : "+v"(tid), "+s"(wsg), "+s"(G), "+s"(bx)); unsigned char* wsl = (unsigned char*)wsg; const int lane = tid & 63, wave = __builtin_amdgcn_readfirstlane(tid >> 6); (void)lane; (void)wave
    unsigned* ctl = (unsigned*)(args.ws + WS_CTL);
    XcdBarrier bar; bar.bar = ctl + CW_BAR; bar.x = 0; bar.st = nullptr; bar.nloc = 0u; bar.nx = 0u;
    const int lo = args.ph_lo, hi = args.ph_hi;
    const bool multi = (hi - lo) > 1;
    if (multi) bar = xcd_barrier_post(ctl + CW_BAR, nullptr, wave0 * 64 + lane_id());
#define IN(k) (lo <= (k) && (k) < hi && ((k) <= MK_LAST_PHASE || (k) == PH_FINAL))
#ifndef MK_KIND_MASK
#define MK_KIND_MASK 0xFFFFFFFFu
#endif
#define KIND(k) ((MK_KIND_MASK >> (k)) & 1u)
#ifndef MK_PROBE_MFMA
#define MK_PROBE_MFMA 0
#endif
#ifndef MK_REPEAT_MASK
#define MK_REPEAT_MASK (MK_PROBE_MODE >= 0 ? (1u << 7) : 0u)
#endif
#define NREP(k) (((MK_REPEAT_MASK >> (k)) & 1u) ? 2 : 1)
#define SEAM(k) do { if (IN(k) && (k) + 1 < hi) xcd_barrier(bar, wave0 * 64 + lane_id()); } while (0)

#define X_IN ((const float*)(*(const GAS float* const CAS*)(kargs + 0)))
#define MEM_IN ((const float*)(*(const GAS float* const CAS*)(kargs + 8)))
#define positions ((const int*)(*(const GAS int* const CAS*)(kargs + 16)))
#define hg_lb ((const float*)(*(const GAS float* const CAS*)(kargs + 24)))
#define attn_norm ((const float*)(*(const GAS float* const CAS*)(kargs + 32)))
#define w_in ((const float*)(*(const GAS float* const CAS*)(kargs + 40)))
#define hg_norm ((const float*)(*(const GAS float* const CAS*)(kargs + 48)))
#define mla_q_norm ((const float*)(*(const GAS float* const CAS*)(kargs + 56)))
#define w_q_up ((const float*)(*(const GAS float* const CAS*)(kargs + 64)))
#define mla_kv_norm ((const float*)(*(const GAS float* const CAS*)(kargs + 72)))
#define w_kv_up ((const float*)(*(const GAS float* const CAS*)(kargs + 80)))
#define mem_norm ((const float*)(*(const GAS float* const CAS*)(kargs + 88)))
#define w_mem_kv ((const float*)(*(const GAS float* const CAS*)(kargs + 96)))
#define w_branch ((const float*)(*(const GAS float* const CAS*)(kargs + 104)))
#define w_o ((const float*)(*(const GAS float* const CAS*)(kargs + 112)))
#define ffn_norm ((const float*)(*(const GAS float* const CAS*)(kargs + 120)))
#define w_dense_gu ((const float*)(*(const GAS float* const CAS*)(kargs + 128)))
#define w_dense_down ((const float*)(*(const GAS float* const CAS*)(kargs + 136)))
#define w_router ((const float*)(*(const GAS float* const CAS*)(kargs + 144)))
#define w_expert_gu ((const float*)(*(const GAS float* const CAS*)(kargs + 152)))
#define w_expert_down ((const float*)(*(const GAS float* const CAS*)(kargs + 160)))
#define final_norm ((const float*)(*(const GAS float* const CAS*)(kargs + 168)))
#define RSRC wsl
#define WIN ((bf16*)(wsl + WS_WIN))
#define WMKV ((bf16*)(wsl + WS_WMKV))
#define WQUP ((bf16*)(wsl + WS_WQUP))
#define WKVUP ((bf16*)(wsl + WS_WKVUP))
#define WBR ((bf16*)(wsl + WS_WBR))
#define WO ((bf16*)(wsl + WS_WO))
#define WGU ((bf16*)(wsl + WS_WGU))
#define WDN ((bf16*)(wsl + WS_WDN))
#define WEGU ((bf16*)(wsl + WS_WEGU))
#define WEDN ((bf16*)(wsl + WS_WEDN))
#define H ((float*)(wsl + WS_H))
#define HB ((bf16*)(wsl + WS_HB))
#define PROJ ((bf16*)(wsl + WS_PROJ))
#define ZF ((float*)(wsl + WS_ZF))
#define MEMN ((bf16*)(wsl + WS_MEMN))
#define MKV ((bf16*)(wsl + WS_MKV))
#define QMLA ((bf16*)(wsl + WS_QMLA))
#define KVB ((bf16*)(wsl + WS_KVB))
#define Y ((bf16*)(wsl + WS_Y))
#define HU ((float*)(wsl + WS_HU))
#define HDEC ((float*)(wsl + WS_HDEC))
#define MRG ((float*)(wsl + WS_MRG))
#define MRGB ((bf16*)(wsl + WS_MRGB))
#define ACT ((bf16*)(wsl + WS_ACT))
#define XS ((bf16*)(wsl + WS_XS))
#define ACTE ((bf16*)(wsl + WS_ACTE))
#define YS ((float*)(wsl + WS_YS))
#define COS ((float*)(wsl + WS_COS))
#define SIN ((float*)(wsl + WS_SIN))
#define LB ((float*)(wsl + WS_LB))
#define SSQA0 ((u64*)(wsl + WS_SSQA0))
#define TOPI ((int*)(wsl + WS_TOPI))
#define TOPW ((float*)(wsl + WS_TOPW))
#define RASS ((int*)(wsl + WS_RASS))
#define TEXP ((int*)(wsl + WS_TEXP))
#define SSQ ((u64*)(wsl + CB_SSQ))
#define BLKCNT ((int*)(wsl + CB_BLKCNT))

    if (KIND(0) && IN(0)) for (int rep = 0; rep < NREP(0); ++rep) { PHASE_IDS;
        LAS float* scr = (LAS float*)(lds + wave * 16384);
        const int gw = bx * NWAVES + wave, NGW = G * NWAVES;
#define TDESC(i) ((i) == 0 ? TDesc{w_in, WIN, attn_norm, (size_t)DM * DIN, (size_t)DINP * DM, DM, 2, DM, DIN, MK_GATE_F8 ? 6400 : DINP, MAP_WIN, 0.f} : \
                  (i) == 1 ? TDesc{w_mem_kv, WMKV, nullptr, (size_t)DM * 2048, (size_t)2048 * DM, 0, 2, DM, 2048, 2048, MAP_ID, 0.f} : \
                  (i) == 2 ? TDesc{w_q_up, WQUP, mla_q_norm, (size_t)512 * 1536, (size_t)1536 * 512, 512, 2, 512, 1536, 1536, MAP_QUP, 0.f} : \
                  (i) == 3 ? TDesc{w_kv_up, WKVUP, mla_kv_norm, (size_t)512 * 2048, (size_t)2048 * 512, 512, 2, 512, 2048, 2048, MAP_ID, 0.f} : \
                  (i) == 4 ? TDesc{w_branch, WBR, nullptr, (size_t)1024 * 2048, (size_t)2048 * 1024, 0, 6, 1024, 2048, 2048, MAP_ID, 0.f} : \
                  (i) == 5 ? TDesc{w_o, WO, nullptr, (size_t)DM * DM, (size_t)DM * DM, 0, 2, DM, DM, DM, MAP_ID, 0.f} : \
                  (i) == 6 ? TDesc{w_dense_gu, WGU, ffn_norm, 0, 0, 0, 1, DM, 2 * FF, 2 * FF, MAP_GU_D, MK_P7_F8 ? F8_WGU : 0.f} : \
                  (i) == 7 ? TDesc{w_dense_down, WDN, nullptr, 0, 0, 0, 1, FF, DM, DM, MAP_ID, MK_P8_F8 ? F8_WDN : 0.f} : \
                  (i) == 8 ? TDesc{w_expert_gu, WEGU, ffn_norm + DM, (size_t)DM * 2 * FFE, (size_t)2 * FFE * DM, 0, 8, DM, 2 * FFE, 2 * FFE, MAP_GU_E, MK_MOE_F8 ? F8_WGU : 0.f} : \
                             TDesc{w_expert_down, WEDN, nullptr, (size_t)FFE * DM, (size_t)DM * FFE, 0, 8, FFE, DM, DM, MAP_ID, MK_MOE_F8 ? F8_WDN : 0.f})
        constexpr int F8K = 64;
        constexpr int cnt[10] = {2 * (DM / 64) * ((MK_GATE_F8 ? 6400 : DINP) / 32), 2 * (DM / 64) * (2048 / 32), 2 * (512 / 64) * (1536 / 32), 2 * (512 / 64) * (2048 / 32), 6 * (1024 / 64) * (2048 / 32), 2 * (DM / 64) * (DM / 32),
                                 (DM / 64) * (2 * FF / 32), (FF / 64) * (DM / 32), 8 * (DM / F8K) * (2 * FFE / 32), 8 * (FFE / F8K) * (DM / 32)};
        int total = 0;
#pragma unroll
        for (int i = 0; i < 8; ++i) total += cnt[i];
        for (int it = gw; it < total; it += NGW) {
            int r = it;
#pragma unroll
            for (int i = 0; i < 8; ++i) { if (r >= 0 && r < cnt[i]) { const TDesc D = TDESC(i); transpose_item(D, r, scr, lane); r = -1; } else if (r >= 0) r -= cnt[i]; }
        }
        if (MK_LAT_F8) { const TDesc DL = TDesc{w_in, (bf16*)(wsl + WS_WIN8 + (size_t)6144 * DM), attn_norm, (size_t)DM * DIN, (size_t)WIN8_ROWS * DM, DM, 2, DM, DIN, 2048, MAP_WIN4K, F8_WIN};
            for (int it = gw; it < 2 * (DM / 64) * (2048 / 32); it += NGW) transpose_item(DL, it, scr, lane); }
        __syncthreads();
        {
            LAS float* tscr = (LAS float*)lds;
            constexpr int NT8 = 8 * (DM / TL_K) * (2 * FFE / 256), NT9 = 8 * (FFE / TL_K) * (DM / 256) + (MK_GATE_F8 ? 2 * (DM / TL_K) * (6144 / 256) : 0);
            constexpr int NT9E = 8 * (FFE / TL_K) * (DM / 256);
            const TDesc D8 = TDESC(8), D9e = TDESC(9);
            const TDesc DG = TDesc{w_in, (bf16*)(wsl + WS_WIN8), attn_norm, (size_t)DM * DIN, (size_t)WIN8_ROWS * DM, DM, 2, DM, DIN, 6144, MAP_GATE, F8_WIN};
            f32x4 va[TL_RW], vb[TL_RW];
            constexpr int NTT = NT8 + NT9;
#define TL_LOAD(tt, buf) do { if ((tt) < NTT) { if ((tt) < NT8) tl_load(D8, (tt), buf, wave, lane); else if ((tt) < NT8 + NT9E) tl_load(D9e, (tt) - NT8, buf, wave, lane); else tl_load(DG, (tt) - NT8 - NT9E, buf, wave, lane); } } while (0)
#define TL_STORE(tt, buf) do { if ((tt) < NTT) { if ((tt) < NT8) tl_store(D8, (tt), buf, tscr, tid, wave, lane); else if ((tt) < NT8 + NT9E) tl_store(D9e, (tt) - NT8, buf, tscr, tid, wave, lane); else tl_store(DG, (tt) - NT8 - NT9E, buf, tscr, tid, wave, lane); } } while (0)
            int t = bx;
            TL_LOAD(t, va);
            for (; t < NTT; t += 2 * G) {
                TL_LOAD(t + G, vb); TL_STORE(t, va);
                TL_LOAD(t + 2 * G, va); TL_STORE(t + G, vb);
            }
#undef TL_LOAD
#undef TL_STORE
        }
        for (int m0 = gw; m0 < NTOK; m0 += 4 * NGW) {
            f32x4 xv[4][8];
#pragma unroll
            for (int r = 0; r < 4; ++r) { const int m = m0 + r * NGW; if (m < NTOK) {
#pragma unroll
                for (int j = 0; j < 8; ++j) xv[r][j] = __builtin_nontemporal_load((const f32x4*)(X_IN + (size_t)m * DM + 4 * lane + 256 * j)); } }
#pragma unroll
            for (int r = 0; r < 4; ++r) { const int m = m0 + r * NGW; if (m < NTOK) { float sx = 0.f;
#pragma unroll
                for (int j = 0; j < 8; ++j) { const f32x4 w = xv[r][j]; sx += (w[0] * w[0] + w[1] * w[1]) + (w[2] * w[2] + w[3] * w[3]);
                    u32x2 o; o.x = cvt_pk_bf16(w[0], w[1]); o.y = cvt_pk_bf16(w[2], w[3]); *(u32x2*)(HB + (size_t)m * DM + 4 * lane + 256 * j) = o;
                    if (MK_GATE_F8) { const f32x4 z = w * F8_H; int q = 0; q = __builtin_amdgcn_cvt_pk_fp8_f32(clamp448(z[0]), clamp448(z[1]), q, false); q = __builtin_amdgcn_cvt_pk_fp8_f32(clamp448(z[2]), clamp448(z[3]), q, true); *(int*)(wsl + WS_HB8 + (size_t)m * DM + 4 * lane + 256 * j) = q; } }
                sx = wave_sum(sx, lane); if (lane == 0) SSQA0[m] = ssq_fix(sx); } }
        }
        for (int m = gw; m < NBATCH * NMEM; m += NGW) (void)row_to_bf16(MEM_IN + (size_t)m * DM, MEMN + (size_t)m * DM, mem_norm, true, lane);
        for (int i = bx * NTHR + tid; i < NTOK * 32; i += G * NTHR) { const int tok = i >> 5, j = i & 31;
            const float inv = powf(10000.0f, -((float)j / 32.0f)); const float ang = (float)positions[tok] * inv; COS[i] = cosf(ang); SIN[i] = sinf(ang); }
        for (int i = bx * NTHR + tid; i < 1024; i += G * NTHR) { const float l0 = hg_lb[i], l1 = hg_lb[1024 + i], mx = fmaxf(l0, l1), e0 = expf(l0 - mx), e1 = expf(l1 - mx);
            const float s0 = e0 / (e0 + e1), s1 = e1 / (e0 + e1); LB[i] = 0.f; LB[1024 + i] = fminf(fmaxf((s0 + s1) - s0, 0.f), 1.f); }
    }
    SEAM(0);

    for (int l = 0; l < 2; ++l) {
        const int pb = 1 + 8 * l;
#define ssq_attn ((l == 0) ? SSQA0 : SSQ + SSQ_A1 * NTOK)
#define ssq_cq (SSQ + (l == 0 ? SSQ_CQ0 : SSQ_CQ1) * NTOK)
#define ssq_ckv (SSQ + (l == 0 ? SSQ_CKV0 : SSQ_CKV1) * NTOK)
#define ssq_ffn (SSQ + (l == 0 ? SSQ_F0 : SSQ_F1) * NTOK)
#define lbv (LB + l * 1024)
        if (KIND(1) && IN(pb + 0)) for (int rep = 0; rep < NREP(1); ++rep) { PHASE_IDS;
            const bool deal = (G == 256);
            if (MK_GATE_F8) {
                SchedIn S{(unsigned)WS_HB, (unsigned)(WS_WIN + (size_t)l * DINP * DM * 2), (unsigned)WS_MEMN, (unsigned)(WS_WMKV + (size_t)l * 2048 * DM * 2), G, bx, deal ? (MK_LAT_F8 ? 16 : 24) : 25, !deal};
                EpiIn E{wsl, l, rep == 0, 1.0f};
                pg8::gemm_run<EpiIn, SchedIn>(lds, tid, RSRC, DM, DM, DM, S, E);
                SchedPlain S8{(unsigned)WS_HB8, (unsigned)(WS_WIN8 + (size_t)l * WIN8_ROWS * DM), 32, MK_LAT_F8 ? 32 : 24, G, bx, 256u * DM, 256u * DM};
                EpiGateLogit E8{wsl, l};
                pg8::gemm_run<EpiGateLogit, SchedPlain, true, true>(lds, tid, RSRC, DM / 2, DM / 2, DM / 2, S8, E8);
            } else {
                SchedIn S{(unsigned)WS_HB, (unsigned)(WS_WIN + (size_t)l * DINP * DM * 2), (unsigned)WS_MEMN, (unsigned)(WS_WMKV + (size_t)l * 2048 * DM * 2), G, bx, deal ? 48 : 49, !deal};
                EpiIn E{wsl, l, rep == 0, 1.0f};
                pg8::gemm_run<EpiIn, SchedIn>(lds, tid, RSRC, DM, DM, DM, S, E);
            }
        }
        SEAM(pb + 0);
        if (KIND(2) && IN(pb + 1)) for (int rep = 0; rep < NREP(2); ++rep) { PHASE_IDS;
            SchedUp S{(unsigned)WS_PROJ, (unsigned)(WS_WQUP + (size_t)l * 1536 * 512 * 2), (unsigned)(WS_WKVUP + (size_t)l * 2048 * 512 * 2), G, bx};
            EpiUp E{wsl, l};
            pg8::gemm_run<EpiUp, SchedUp>(lds, tid, RSRC, 512, DINP, 512, S, E);
            if (G == 256) {
                SchedIn2 S2{(unsigned)WS_HB, (unsigned)(WS_WIN + (size_t)l * DINP * DM * 2), (unsigned)WS_MEMN, (unsigned)(WS_WMKV + (size_t)l * 2048 * DM * 2), G, bx, MK_GATE_F8 ? 24 : 48};
                EpiIn E2{wsl, l, false, 1.0f};
                pg8::gemm_run<EpiIn, SchedIn2>(lds, tid, RSRC, DM, DM, DM, S2, E2);
                if (bx >= 192) hg::pass1_unit(lds, tid, bx - 192, ZF, PROJ, lbv, HU, HDEC);
                else for (int j = 0; j < 5; ++j) hg::pass1_unit(lds, tid, 64 + bx + 192 * j, ZF, PROJ, lbv, HU, HDEC);
            } else for (int u = (G - 1 - bx); u < 1024; u += G) hg::pass1_unit(lds, tid, u, ZF, PROJ, lbv, HU, HDEC);
        }
        SEAM(pb + 1);
        if (KIND(3) && IN(pb + 2)) for (int rep = 0; rep < NREP(3); ++rep) { PHASE_IDS;
            const float c_mla = 0.07216878364870322f * 1.4426950408889634f, c_mem = 0.0625f * 1.4426950408889634f;
            for (int vc = bx; vc < 256; vc += G) {
                int nm = 0, q_a = 0, q_b = 0, bh = 0;
                if (vc < 32) { nm = 1; bh = vc; q_a = 7; }
                else if (vc < 64) { nm = 1; bh = vc - 32; q_a = 6; }
                else if (vc < 96) { nm = 2; bh = vc - 64; q_a = 5; q_b = 1; }
                else if (vc < 128) { nm = 2; bh = vc - 96; q_a = 4; q_b = 2; }
                else if (vc < 160) { nm = 2; bh = vc - 128; q_a = 3; q_b = 0; }
#ifndef NO_MLA
                for (int k = 0; k < nm; ++k) { const int b = bh >> 3, h = bh & 7, qb = k ? q_b : q_a; const size_t t0 = (size_t)b * SEQ;
                    att::attn_unit<QKD, NOPE, true>(lds, tid, QMLA + (t0 + qb * 256) * 1536 + h * QKD, 1536, KVB + t0 * 2048 + h * 256, 2048, PROJ + t0 * DINP + PC_KR, DINP,
                                                    KVB + t0 * 2048 + h * 256 + 128, 2048, Y + (t0 + qb * 256) * 3072 + 1024 + h * 128, 3072, 4 * (qb + 1), qb * 256, c_mla); }
#endif
            }
            { int tid2 = tid; asm volatile("" : "+v"(tid2));
            for (int vc = bx; vc < 256; vc += G) {
                int nx = 0, x_a = 0, x_b = 0;
                if (vc >= 32 && vc < 64) { nx = 1; x_a = vc - 32; }
                else if (vc >= 128 && vc < 160) { nx = 2; x_a = 32 + 2 * (vc - 128); x_b = x_a + 1; }
                else if (vc >= 160) { const int j = vc - 160; nx = (j < 64) ? 2 : 1; x_a = 96 + j; x_b = 192 + j; }
#ifndef NO_MEM
                for (int k = 0; k < nx; ++k) { const int uu = k ? x_b : x_a, half = uu & 1, qb = (uu >> 1) & 7, bh = uu >> 4, b = bh >> 2, h = bh & 3; const size_t t0 = (size_t)b * SEQ;
                    att::attn_unit<MEMD, MEMD, false>(lds, tid2, PROJ + (t0 + qb * 256) * DINP + PC_QM + h * 256, DINP, MKV + (size_t)b * 256 * 2048 + h * 256, 2048, nullptr, 0,
                                                      MKV + (size_t)b * 256 * 2048 + 1024 + h * 256 + half * 128, 2048, Y + (t0 + qb * 256) * 3072 + 2048 + h * 256 + half * 128, 3072, 4, 0, c_mem); }
#endif
            } }
#ifndef NO_P2
            if (rep == 0) { int tid3 = tid; asm volatile("" : "+v"(tid3));
            for (int vc = bx; vc < 256; vc += G) if (vc >= 160) { for (int task = (vc - 160) * NTHR + tid3; task < 32 * 4096; task += 96 * NTHR) hg::pass2_task(task, HU, HDEC, (bf16*)(wsl + WS_HS)); } }
#endif
        }
        SEAM(pb + 2);
        if (KIND(4) && IN(pb + 3)) { PHASE_IDS; const int NU = 1024 * NREP(4);
            hg::P3In ra; int u = bx;
            hg::pass3_load(ra, tid, u & 1023, ZF, PROJ, lbv, (const bf16*)(wsl + WS_HS));
            for (; u < NU; u += G) { int tid_u = tid; asm volatile("" : "+v"(tid_u));
                hg::pass3_compute(lds, tid_u, u & 1023, ra, (u + G < NU) ? ((u + G) & 1023) : -1, ZF, PROJ, lbv, (const bf16*)(wsl + WS_HS), hg_norm + l * 128, Y); } }
        SEAM(pb + 3);
        if (KIND(5) && IN(pb + 4)) for (int rep = 0; rep < NREP(5); ++rep) { PHASE_IDS;
            SchedGate S{(unsigned)WS_Y, (unsigned)(WS_WBR + (size_t)l * 3 * 2048 * 1024 * 2), G, bx};
            EpiGate E{wsl};
            pg8::gemm_run<EpiGate, SchedGate>(lds, tid, RSRC, 1024, 3072, 1024, S, E);
        }
        SEAM(pb + 4);
        if (KIND(6) && IN(pb + 5)) { PHASE_IDS;
            SchedPlain S{(unsigned)WS_MRGB, (unsigned)(WS_WO + (size_t)l * DM * DM * 2), 32, 8, G, bx, 256u * DM * 2u, 256u * DM * 2u};
            EpiRes E{wsl, l == 0 ? SSQ_F0 : SSQ_F1, MK_P7_F8 && l == 0};
            pg8::gemm_run<EpiRes, SchedPlain>(lds, tid, RSRC, DM, DM, DM, S, E);
        }
        SEAM(pb + 5);
        if (l == 0) {
            if (KIND(7) && IN(7)) for (int rep = 0; rep < NREP(7); ++rep) { PHASE_IDS;
                if ((MK_P7_F8 || MK_P8_F8) && MK_PROBE_MODE < 0) {
                    EpiSwiglu<true, MK_P7_F8 != 0, MK_P8_F8 != 0> E8{wsl, (unsigned)WS_ACT, FF, SSQ_F0};
                    if (MK_P7_F8) { SchedPlain S8{(unsigned)WS_HB8, (unsigned)WS_WGU, 32, 44, G, bx, 256u * DM, 256u * DM};
                        pg8::gemm_run<EpiSwiglu<true, MK_P7_F8 != 0, MK_P8_F8 != 0>, SchedPlain, true, MK_P7_F8 != 0>(lds, tid, RSRC, DM / 2, DM / 2, DM / 2, S8, E8); }
                    else { SchedPlain S8{(unsigned)WS_HB, (unsigned)WS_WGU, 32, 44, G, bx, 256u * DM * 2u, 256u * DM * 2u};
                        pg8::gemm_run<EpiSwiglu<true, MK_P7_F8 != 0, MK_P8_F8 != 0>, SchedPlain, true, MK_P7_F8 != 0>(lds, tid, RSRC, DM, DM, DM, S8, E8); }
                    continue; }
                SchedPlain S{(unsigned)WS_HB, (unsigned)WS_WGU, 32, 44, G, bx, 256u * DM * 2u, 256u * DM * 2u};
                EpiSwiglu<true> E{wsl, (unsigned)WS_ACT, FF, SSQ_F0};
                if (MK_PROBE_MODE == 8 && rep == 0) { EpiSwiglu<false> EN{wsl, (unsigned)WS_ACT, FF, SSQ_F0}; pg8::gemm_run<EpiSwiglu<false>, SchedPlain, true, false, 0>(lds, tid, RSRC, 128, DM, DM, S, EN); }
                else if (MK_PROBE_MODE == 9 && rep == 0) { EpiSwiglu<true> EN{wsl, 1u, FF, SSQ_F0}; pg8::gemm_run<EpiSwiglu<true>, SchedPlain, true, false, 0>(lds, tid, RSRC, 128, DM, DM, S, EN); }
                else if (MK_PROBE_MODE == 6 && rep == 0) { EpiNull EN{wsl}; pg8::gemm_run<EpiNull, SchedPlain, true, false, 0>(lds, tid, RSRC, 128, DM, DM, S, EN); }
                else if (MK_PROBE_MODE == 7 && rep == 0) { EpiNull EN{wsl}; pg8::gemm_run<EpiNull, SchedPlain, true, false, 0>(lds, tid, RSRC, DM, DM, DM, S, EN); }
                else if (MK_PROBE_MODE == 5 && rep == 0) pg8::gemm_run<EpiSwiglu<true>, SchedPlain, true, false, 0>(lds, tid, RSRC, 128, DM, DM, S, E);
                else if (MK_PROBE_MODE > 0 && MK_PROBE_MODE < 5 && rep == 0) pg8::gemm_run<EpiSwiglu<true>, SchedPlain, true, false, MK_PROBE_MODE % 5>(lds, tid, RSRC, DM, DM, DM, S, E);
                else pg8::gemm_run<EpiSwiglu<true>, SchedPlain>(lds, tid, RSRC, DM, DM, DM, S, E);
            }
            SEAM(7);
            if (KIND(8) && IN(8)) { PHASE_IDS;
                SchedPlain S{(unsigned)WS_ACT, (unsigned)WS_WDN, 32, 8, G, bx, 256u * FF * 2u, 256u * FF * 2u};
                if (MK_P8_F8) { SchedPlain S8{(unsigned)WS_ACT, (unsigned)WS_WDN, 32, 8, G, bx, 256u * FF, 256u * FF};
                    EpiResT<true> E8{wsl, SSQ_A1, MK_GATE_F8 != 0};
                    pg8::gemm_run<EpiResT<true>, SchedPlain, true, true>(lds, tid, RSRC, FF / 2, FF / 2, FF / 2, S8, E8); }
                else {
                EpiRes E{wsl, SSQ_A1, MK_GATE_F8 != 0};
                pg8::gemm_run<EpiRes, SchedPlain>(lds, tid, RSRC, FF, FF, FF, S, E); }
#if MK_PROBE_MFMA
                { f32x4 pa[16]; bf16x8 px, py;
#pragma unroll
                  for (int j = 0; j < 8; ++j) { px[j] = (__bf16)(float)(tid + j); py[j] = (__bf16)(float)(tid - j); }
#pragma unroll
                  for (int j = 0; j < 16; ++j) pa[j] = (f32x4){0.f, 0.f, 0.f, 0.f};
                  for (int it = 0; it < 352; ++it) {
#pragma unroll
                      for (int j = 0; j < 16; ++j) pa[j] = __builtin_amdgcn_mfma_f32_16x16x32_bf16(px, py, pa[j], 0, 0, 0);
                  }
#pragma unroll
                  for (int j = 0; j < 16; ++j) asm volatile("" :: "v"(pa[j]));
                }
#endif
            }
            SEAM(8);
        }
    }
    if (KIND(15) && IN(15)) for (int rep = 0; rep < NREP(15); ++rep) { PHASE_IDS;
        LAS float* wr = (LAS float*)lds;
        LAS int* lcnt = (LAS int*)(lds + 65536);
        const u64* ssq = SSQ + SSQ_F1 * NTOK;
        for (int i = tid; i < DM * 8; i += NTHR) wr[i] = w_router[i] * ffn_norm[DM + (i >> 3)];
        for (int vc = bx; vc < 256; vc += G) {
            if (tid < 8) lcnt[tid] = 0;
            __syncthreads();
            u32x2 hrow[4][8]; float rsq[4];
#pragma unroll
            for (int q = 0; q < 4; ++q) { const int t = vc * 32 + wave * 4 + q;
#pragma unroll
                for (int j = 0; j < 8; ++j) hrow[q][j] = *(const u32x2*)(HB + (size_t)t * DM + 4 * lane + 256 * j); }
#pragma unroll
            for (int q = 0; q < 4; ++q) rsq[q] = row_rstd(ssq, vc * 32 + wave * 4 + q, 1.0f / DM);
#pragma unroll
            for (int q = 0; q < 4; ++q) {
                const int t = vc * 32 + wave * 4 + q;
                float a[8] = {0.f, 0.f, 0.f, 0.f, 0.f, 0.f, 0.f, 0.f};
#pragma unroll
                for (int j = 0; j < 8; ++j) { const int k = 4 * lane + 256 * j; const u32x2 hw = hrow[q][j]; const f32x4 hv = (f32x4){bflo(hw.x), bfhi(hw.x), bflo(hw.y), bfhi(hw.y)};
#pragma unroll
                    for (int kk = 0; kk < 4; ++kk) { const f32x4 w0 = *(const LAS f32x4*)(wr + (k + kk) * 8), w1 = *(const LAS f32x4*)(wr + (k + kk) * 8 + 4);
                        a[0] += hv[kk] * w0[0]; a[1] += hv[kk] * w0[1]; a[2] += hv[kk] * w0[2]; a[3] += hv[kk] * w0[3];
                        a[4] += hv[kk] * w1[0]; a[5] += hv[kk] * w1[1]; a[6] += hv[kk] * w1[2]; a[7] += hv[kk] * w1[3]; } }
                const float rs = rsq[q];
#pragma unroll
                for (int e = 0; e < 8; ++e) a[e] = wave_sum(a[e], lane) * rs;
                int i0 = 0; float l0 = a[0];
#pragma unroll
                for (int e = 1; e < 8; ++e) if (a[e] > l0) { l0 = a[e]; i0 = e; }
                int i1 = -1; float l1 = -3.0e38f;
#pragma unroll
                for (int e = 0; e < 8; ++e) if (e != i0 && a[e] > l1) { l1 = a[e]; i1 = e; }
                if (lane == 0) { const float ex = expf(l1 - l0), w0 = 1.0f / (1.0f + ex); TOPI[2 * t] = i0; TOPI[2 * t + 1] = i1; TOPW[2 * t] = w0; TOPW[2 * t + 1] = ex * w0;
                    __hip_atomic_fetch_add(&lcnt[i0], 1, __ATOMIC_RELAXED, __HIP_MEMORY_SCOPE_WORKGROUP); __hip_atomic_fetch_add(&lcnt[i1], 1, __ATOMIC_RELAXED, __HIP_MEMORY_SCOPE_WORKGROUP); }
            }
            __syncthreads();
            if (tid < 8) BLKCNT[vc * 8 + tid] = lcnt[tid];
            __syncthreads();
        }
    }
    SEAM(15);
    if (KIND(16) && IN(16)) for (int rep = 0; rep < NREP(16); ++rep) { PHASE_IDS;
        LAS int* bc = (LAS int*)lds;
        LAS int* pst = (LAS int*)(lds + 8192);
        LAS int* posl = (LAS int*)(lds + 8192 + 256);
        const u64* ssq = SSQ + SSQ_F1 * NTOK;
        for (int i = tid; i < 2048; i += NTHR) bc[i] = BLKCNT[i];
        __syncthreads();
        for (int vc = bx; vc < 256; vc += G) {
            {
                const int e = wave; int part = 0, mine = 0;
#pragma unroll
                for (int q = 0; q < 4; ++q) { const int i = 4 * lane + q, v = bc[i * 8 + e]; part += v; if (i < vc) mine += v; }
                float tf = wave_sum((float)part, lane), mf = wave_sum((float)mine, lane);
                if (lane == 0) { pst[8 + e] = (int)tf; pst[16 + e] = (int)mf; }
            }
            __syncthreads();
            if (tid == 0) { int s = 0; for (int e = 0; e < 8; ++e) { pst[e] = s; s += (pst[8 + e] + 255) / 256 * 256; }
                if (vc == 0) { int rt = 0; for (int e = 0; e < 8; ++e) { const int n = (pst[8 + e] + 255) / 256; for (int k = 0; k < n; ++k) TEXP[rt++] = e; } TEXP[100] = rt; } }
            __syncthreads();
            if (wave == 0) {
                const int t = vc * 32 + (lane >> 1), e = TOPI[2 * t + (lane & 1)];
                int rank = 0;
#pragma unroll
                for (int ee = 0; ee < 8; ++ee) { const unsigned long long mk = __ballot(e == ee); if (e == ee) rank = __popcll(mk & ((1ull << lane) - 1ull)); }
                const int pos = pst[e] + pst[16 + e] + rank;
                posl[lane] = pos; *(u32x2*)(RASS + 2 * pos) = (u32x2){(unsigned)(2 * t + (lane & 1)), __float_as_uint(TOPW[2 * t + (lane & 1)])}; ((int*)(wsl + WS_POS))[2 * t + (lane & 1)] = pos;
            }
            if (vc < 8 && wave == 1) { const int e = vc, s = pst[e] + pst[8 + e], en = pst[e] + (pst[8 + e] + 255) / 256 * 256; for (int p = s + lane; p < en; p += 64) *(u32x2*)(RASS + 2 * p) = (u32x2){0xffffffffu, 0u}; }
            if (vc < 8 && wave >= 2) { const int e = vc, s = pst[e] + pst[8 + e], en = pst[e] + (pst[8 + e] + 255) / 256 * 256;
                for (int p = s + (wave - 2); p < en; p += 6) for (int j = 0; j < 8; ++j) { if (MK_MOE_F8) *(int*)((unsigned char*)XS + (size_t)p * DM + 4 * lane + 256 * j) = 0; else *(u32x2*)(XS + (size_t)p * DM + 4 * lane + 256 * j) = (u32x2){0u, 0u}; } }
            __syncthreads();
            {
                u32x2 hv[4][8]; float rsv[4];
#pragma unroll
                for (int i4 = 0; i4 < 4; ++i4) { const int t = vc * 32 + wave * 4 + i4;
#pragma unroll
                    for (int j = 0; j < 8; ++j) hv[i4][j] = *(const u32x2*)(HB + (size_t)t * DM + 4 * lane + 256 * j); }
#pragma unroll
                for (int i4 = 0; i4 < 4; ++i4) rsv[i4] = row_rstd(ssq, vc * 32 + wave * 4 + i4, 1.0f / DM);
#pragma unroll
                for (int i4 = 0; i4 < 4; ++i4) { const int p0 = posl[wave * 8 + 2 * i4], p1 = posl[wave * 8 + 2 * i4 + 1]; const float rs = rsv[i4];
#pragma unroll
                    for (int j = 0; j < 8; ++j) { const u32x2 hw = hv[i4][j]; const f32x4 v = (f32x4){bflo(hw.x), bfhi(hw.x), bflo(hw.y), bfhi(hw.y)} * rs;
                        if (MK_MOE_F8) { const f32x4 w = v * F8_XS; int q = 0; q = __builtin_amdgcn_cvt_pk_fp8_f32(clamp448(w[0]), clamp448(w[1]), q, false); q = __builtin_amdgcn_cvt_pk_fp8_f32(clamp448(w[2]), clamp448(w[3]), q, true);
                            *(int*)((unsigned char*)XS + (size_t)p0 * DM + 4 * lane + 256 * j) = q; *(int*)((unsigned char*)XS + (size_t)p1 * DM + 4 * lane + 256 * j) = q; }
                        else { u32x2 o; o.x = cvt_pk_bf16(v[0], v[1]); o.y = cvt_pk_bf16(v[2], v[3]); *(u32x2*)(XS + (size_t)p0 * DM + 4 * lane + 256 * j) = o; *(u32x2*)(XS + (size_t)p1 * DM + 4 * lane + 256 * j) = o; } } }
            }
            __syncthreads();
        }
    }
    SEAM(16);
    if (KIND(17) && IN(17)) for (int rep = 0; rep < NREP(17); ++rep) { PHASE_IDS;
        const int nrt = __builtin_amdgcn_readfirstlane(__hip_atomic_load(TEXP + 100, __ATOMIC_RELAXED, __HIP_MEMORY_SCOPE_AGENT));
        if (MK_MOE_F8) {
            SchedMoe S{(unsigned)WS_XS, (unsigned)WS_WEGU, wsl, nrt, 56, G, bx, 256u * DM, 256u * DM, 2u * FFE * DM};
            EpiSwigluF8 E{wsl};
            pg8::gemm_run<EpiSwigluF8, SchedMoe, true, true>(lds, tid, RSRC, DM / 2, DM / 2, DM / 2, S, E);
        } else {
            SchedMoe S{(unsigned)WS_XS, (unsigned)WS_WEGU, wsl, nrt, 56, G, bx, 256u * DM * 2u, 256u * DM * 2u, 2u * FFE * DM * 2u};
            EpiSwiglu<false> E{wsl, (unsigned)WS_ACTE, FFE, 0};
            pg8::gemm_run<EpiSwiglu<false>, SchedMoe>(lds, tid, RSRC, DM, DM, DM, S, E);
        }
    }
    SEAM(17);
    if (KIND(18) && IN(18)) for (int rep = 0; rep < NREP(18); ++rep) { PHASE_IDS;
        const int nrt = __builtin_amdgcn_readfirstlane(__hip_atomic_load(TEXP + 100, __ATOMIC_RELAXED, __HIP_MEMORY_SCOPE_AGENT));
        if (MK_MOE_F8) {
            SchedMoe S{(unsigned)WS_ACTE, (unsigned)WS_WEDN, wsl, 64, 8, G, bx, 256u * FFE, 256u * FFE, (unsigned)DM * FFE};
            EpiMoeDown E{wsl, 1.0f / (F8_ACT * F8_WDN)};
            pg8::gemm_run<EpiMoeDown, SchedMoe, true, true>(lds, tid, RSRC, FFE / 2, FFE / 2, FFE / 2, S, E);
            SchedMoeTail ST{(unsigned)WS_ACTE, (unsigned)WS_WEDN, wsl, nrt, G, bx, 256u * FFE, 256u * FFE, (unsigned)DM * FFE, (unsigned)FFE / 4};
            const int tid_t = wave0 * 64 + lane_id();
            pg8::gemm_run<EpiMoeDown, SchedMoeTail, true, true>(lds, tid_t, RSRC, FFE / 8, FFE / 2, FFE / 2, ST, E);
        } else {
            SchedMoe S{(unsigned)WS_ACTE, (unsigned)WS_WEDN, wsl, nrt, 8, G, bx, 256u * FFE * 2u, 256u * FFE * 2u, (unsigned)DM * FFE * 2u};
            EpiMoeDown E{wsl, 1.0f};
            pg8::gemm_run<EpiMoeDown, SchedMoe>(lds, tid, RSRC, FFE, FFE, FFE, S, E);
        }
    }
    SEAM(18);
    if (IN(PH_FINAL)) { PHASE_IDS;
        const int gw = bx * NWAVES + wave, NGW = G * NWAVES;
        const bool have_moe = (MK_LAST_PHASE >= 18), have_h = (MK_LAST_PHASE >= 6); float* out_p = (float*)*(GAS float* const CAS*)(kargs + 176);
        for (int m0 = gw; m0 < NTOK; m0 += 2 * NGW) {
            int pos[2][2];
#pragma unroll
            for (int r = 0; r < 2; ++r) { const int m = m0 + r * NGW;
#pragma unroll
                for (int kk = 0; kk < 2; ++kk) pos[r][kk] = (have_moe && m < NTOK) ? __hip_atomic_load((const int*)(wsl + WS_POS) + 2 * m + kk, __ATOMIC_RELAXED, __HIP_MEMORY_SCOPE_AGENT) : 0; }
#pragma unroll
            for (int r = 0; r < 2; ++r)
#pragma unroll
                for (int kk = 0; kk < 2; ++kk) pos[r][kk] = __builtin_amdgcn_readfirstlane(pos[r][kk]);
            u32x2 hbv[2][8], yv[2][2][8];
#pragma unroll
            for (int r = 0; r < 2; ++r) { const int m = m0 + r * NGW; if (m < NTOK) {
#pragma unroll
                for (int j = 0; j < 8; ++j) { const int k = 4 * lane + 256 * j; hbv[r][j] = *(const u32x2*)(HB + (size_t)m * DM + k);
#pragma unroll
                    for (int kk = 0; kk < 2; ++kk) { const bool tl = MK_MOE_F8 && pos[r][kk] >= 64 * 256;
                        const bf16* yp = tl ? (const bf16*)(wsl + WS_YSQ) + (size_t)(pos[r][kk] - 64 * 256) * DM : (const bf16*)YS + (size_t)(2 * m + kk) * DM;
                        yv[r][kk][j] = have_moe ? *(const u32x2*)(yp + k) : (u32x2){0u, 0u}; } } } }
#pragma unroll
            for (int r = 0; r < 2; ++r) { const int m = m0 + r * NGW; if (m < NTOK) {
                f32x4 v[8]; float sx = 0.f;
#pragma unroll
                for (int j = 0; j < 8; ++j) { const int k = 4 * lane + 256 * j; const u32x2 hw = hbv[r][j];
                    v[j] = have_h ? (f32x4){bflo(hw.x), bfhi(hw.x), bflo(hw.y), bfhi(hw.y)} : *(const f32x4*)(X_IN + (size_t)m * DM + k);
#pragma unroll
                    for (int kk = 0; kk < 2; ++kk) { const u32x2 ya = yv[r][kk][j]; v[j][0] += bflo(ya.x); v[j][1] += bfhi(ya.x); v[j][2] += bflo(ya.y); v[j][3] += bfhi(ya.y);
                        if (MK_MOE_F8 && have_moe && pos[r][kk] >= 64 * 256) {
#pragma unroll
                            for (int q = 1; q < 4; ++q) { const u32x2 yb = *(const u32x2*)((const bf16*)(wsl + WS_YSQ) + ((size_t)q * 2048 + (pos[r][kk] - 64 * 256)) * DM + k);
                                v[j][0] += bflo(yb.x); v[j][1] += bfhi(yb.x); v[j][2] += bflo(yb.y); v[j][3] += bfhi(yb.y); } } }
                    sx += (v[j][0] * v[j][0] + v[j][1] * v[j][1]) + (v[j][2] * v[j][2] + v[j][3] * v[j][3]); }
                const float rs = rsqrtf(wave_sum(sx, lane) * (1.0f / DM) + EPS);
#pragma unroll
                for (int j = 0; j < 8; ++j) { const int k = 4 * lane + 256 * j; *(f32x4*)(out_p + (size_t)m * DM + k) = v[j] * rs * *(const f32x4*)(final_norm + k); }
            } }
        }
    }
#undef IN
#undef SEAM
}

extern "C" void kernel_launch(void* const* d_in, const int* in_sizes, int n_in, void* d_out, int out_size, void* d_ws, size_t ws_size, hipStream_t stream) {
    static int grid = 0;
    if (grid == 0) {
        if (n_in != 22 || out_size != NTOK * DM || ws_size < WS_END) { fprintf(stderr, "kernel_launch: unexpected shapes (n_in %d, out %d, ws %zu < %zu); nothing launched\n", n_in, out_size, ws_size, (size_t)WS_END); grid = -1; return; }
        int dev = 0, cus = 0, per_cu = 0;
        if (hipGetDevice(&dev) != hipSuccess || hipDeviceGetAttribute(&cus, hipDeviceAttributeMultiprocessorCount, dev) != hipSuccess) { grid = -1; return; }
        if (hipFuncSetAttribute((const void*)trunk_fwd, hipFuncAttributeMaxDynamicSharedMemorySize, LDS_BYTES) != hipSuccess) { fprintf(stderr, "kernel_launch: hipFuncSetAttribute failed\n"); grid = -1; return; }
        if (hipOccupancyMaxActiveBlocksPerMultiprocessor(&per_cu, (const void*)trunk_fwd, NTHR, LDS_BYTES) != hipSuccess || per_cu < 1) fprintf(stderr, "kernel_launch: occupancy query reports %d\n", per_cu);
        (void)hipGetLastError();
        grid = cus;
    }
    if (grid < 0) return;
    (void)hipMemsetAsync((char*)d_ws + WS_CTL, 0, CTL_BYTES, stream);
    Args a{};
    for (int i = 0; i < 22; ++i) a.in[i] = d_in[i];
    a.out = (float*)d_out; a.ws = (unsigned char*)d_ws;
    if (MK_N_LAUNCHES == 1) { a.ph_lo = 0; a.ph_hi = N_PHASES; hipLaunchKernelGGL(trunk_fwd, dim3(grid), dim3(NTHR), LDS_BYTES, stream, a); }
    else { for (int p = 0; p < N_PHASES; ++p) { if (p > MK_LAST_PHASE && p != PH_FINAL) continue; a.ph_lo = p; a.ph_hi = p + 1; hipLaunchKernelGGL(trunk_fwd, dim3(grid), dim3(NTHR), LDS_BYTES, stream, a); } }
    const hipError_t le = hipPeekAtLastError();
    if (le != hipSuccess) fprintf(stderr, "kernel_launch: launch failed: %s\n", hipGetErrorName(le));
}
```

```cpp
#include <hip/hip_runtime.h>
#ifndef MK_PROBE_MODE
#define MK_PROBE_MODE -1
#endif
#include <cstdio>
#include <cstdint>
#include <cstddef>

#ifndef MK_N_LAUNCHES
#define MK_N_LAUNCHES 1
#endif
#ifndef MK_MOE_F8
#define MK_MOE_F8 1
#endif
#ifndef MK_GATE_F8
#define MK_GATE_F8 1
#endif
#ifndef MK_LAST_PHASE
#define MK_LAST_PHASE 99
#endif
#ifndef MK_LAT_F8
#define MK_LAT_F8 1
#endif
#ifndef MK_P7_F8
#define MK_P7_F8 0
#endif
#ifndef MK_P8_F8
#define MK_P8_F8 1
#endif

#define GAS __attribute__((address_space(1)))
#define LAS __attribute__((address_space(3)))
#define CAS __attribute__((address_space(4)))
#ifndef HG_SIGMOID
#define HG_SIGMOID fast_sigmoid
#endif
#ifndef EPI_SIGMOID
#define EPI_SIGMOID fast_sigmoid
#endif
typedef unsigned short bf16;
typedef short bf16x8 __attribute__((ext_vector_type(8)));
typedef short s16x4 __attribute__((ext_vector_type(4)));
typedef float f32x2 __attribute__((ext_vector_type(2)));
typedef float f32x4 __attribute__((ext_vector_type(4)));
typedef float f32x16 __attribute__((ext_vector_type(16)));
typedef unsigned u32x2 __attribute__((ext_vector_type(2)));
typedef unsigned u32x4 __attribute__((ext_vector_type(4)));

constexpr int DM = 2048, NBATCH = 4, SEQ = 2048, NTOK = NBATCH * SEQ, NMEM = 256;
constexpr int HGH = 8, HGD = 128, CHUNK = 64, NCHUNK = SEQ / CHUNK;
constexpr int MLAH = 8, QRANK = 512, KVRANK = 512, NOPE = 128, ROPE = 64, QKD = NOPE + ROPE, MLAV = 128;
constexpr int MEMH = 4, MEMD = 256;
constexpr int DIN = 12352, DINP = 12544;
constexpr int FF = 5632, NEXP = 8, FFE = 7168;
constexpr float EPS = 1e-6f;
constexpr int PC_Q = 0, PC_F = 1024, PC_I = 2048, PC_G = 3072, PC_CQ = 4096, PC_CKV = 4608, PC_KR = 5120, PC_QM = 5376, PC_GATE = 6400;
constexpr int MAXRT = 72;

constexpr size_t MiB = 1u << 20;
constexpr size_t WS_CTL = 0, CTL_BYTES = 1 * MiB;
constexpr int CW_BAR = 4096;
constexpr size_t CB_SSQ = 65536;
constexpr int SSQ_F0 = 0, SSQ_A1 = 1, SSQ_F1 = 2, SSQ_CQ0 = 3, SSQ_CKV0 = 4, SSQ_CQ1 = 5, SSQ_CKV1 = 6;
constexpr size_t CB_BLKCNT = 65536 + 7 * 65536;
constexpr size_t W0 = 1 * MiB;
constexpr size_t WS_WIN = W0;
constexpr size_t WS_WMKV = WS_WIN + 2ull * DINP * 2048 * 2;
constexpr size_t WS_WQUP = WS_WMKV + 2ull * 2048 * 2048 * 2;
constexpr size_t WS_WKVUP = WS_WQUP + 2ull * 1536 * 512 * 2;
constexpr size_t WS_WBR = WS_WKVUP + 2ull * 2048 * 512 * 2;
constexpr size_t WS_WO = WS_WBR + 6ull * 2048 * 1024 * 2;
constexpr size_t WS_WGU = WS_WO + 2ull * 2048 * 2048 * 2;
constexpr size_t WS_WDN = WS_WGU + 11264ull * 2048 * 2;
constexpr size_t WS_WEGU = WS_WDN + 2048ull * 5632 * 2;
constexpr size_t WS_WEDN = WS_WEGU + 8ull * 14336 * 2048 * 2;
constexpr size_t WS_WEND = WS_WEDN + 8ull * 2048 * 7168 * 2;
constexpr size_t A0 = (WS_WEND + MiB - 1) / MiB * MiB;
constexpr size_t WS_H = A0;
constexpr size_t WS_HB = WS_H + (size_t)NTOK * DM * 4;
constexpr size_t WS_PROJ = WS_HB + (size_t)NTOK * DM * 2;
constexpr size_t WS_ZF = WS_PROJ + (size_t)NTOK * DINP * 2;
constexpr size_t WS_MEMN = WS_ZF + (size_t)NTOK * 1024 * 4;
constexpr size_t WS_MKV = WS_MEMN + 1024ull * 2048 * 2;
constexpr size_t WS_QMLA = WS_MKV + 1024ull * 2048 * 2;
constexpr size_t WS_KVB = WS_QMLA + (size_t)NTOK * 1536 * 2;
constexpr size_t WS_Y = WS_KVB + (size_t)NTOK * 2048 * 2;
constexpr size_t WS_HU = WS_Y + (size_t)NTOK * 3072 * 2;
constexpr size_t WS_HDEC = WS_HU + 1024ull * 128 * 128 * 4;
constexpr size_t WS_MRG = WS_HDEC + 1024ull * 128 * 4;
constexpr size_t WS_MRGB = WS_MRG + (size_t)NTOK * DM * 4;
constexpr size_t WS_ACT = WS_MRGB + (size_t)NTOK * DM * 2;
constexpr size_t WS_XS = WS_ACT + (size_t)NTOK * FF * 2;
constexpr size_t WS_ACTE = WS_XS + (size_t)MAXRT * 256 * DM * 2;
constexpr size_t WS_YS = WS_ACTE + (size_t)MAXRT * 256 * FFE * 2;
constexpr size_t WS_COS = WS_YS + 2ull * NTOK * DM * 4;
constexpr size_t WS_SIN = WS_COS + (size_t)NTOK * 32 * 4;
constexpr size_t WS_LB = WS_SIN + (size_t)NTOK * 32 * 4;
constexpr size_t WS_SSQA0 = WS_LB + 2 * 1024 * 4;
constexpr size_t WS_TOPI = WS_SSQA0 + (size_t)NTOK * 8;
constexpr size_t WS_TOPW = WS_TOPI + (size_t)NTOK * 8;
constexpr size_t WS_RASS = WS_TOPW + (size_t)NTOK * 8;
constexpr size_t WS_TEXP = WS_RASS + (size_t)MAXRT * 256 * 8;
constexpr size_t WS_POS = WS_TEXP + 512;
constexpr size_t WS_YSQ = WS_POS + 2ull * NTOK * 4;
constexpr size_t WS_HS = WS_YSQ + 4ull * 2048 * DM * 2;
constexpr size_t WS_HB8 = WS_HS + 1024ull * 128 * 128 * 2;
constexpr size_t WS_WIN8 = WS_HB8 + (size_t)NTOK * DM;
constexpr int WIN8_ROWS = MK_LAT_F8 ? 8192 : 6144;
constexpr size_t WS_END = WS_WIN8 + 2ull * WIN8_ROWS * DM;

constexpr int RING_BYTES = 131072;
constexpr int MISC_OFF = RING_BYTES;
constexpr int LDS_BYTES = 163840;
constexpr int NWAVES = 8, NTHR = 512;

#define RLX_AGENT __ATOMIC_RELAXED, __HIP_MEMORY_SCOPE_AGENT
#define LDS_WAIT() asm volatile("s_waitcnt lgkmcnt(0)" ::: "memory")
#define VM_WAIT() asm volatile("s_waitcnt vmcnt(0)" ::: "memory")
#define SBAR() __builtin_amdgcn_sched_barrier(0)
__device__ __forceinline__ unsigned cvt_pk_bf16(float lo, float hi) { unsigned r; asm volatile("s_nop 0\n\tv_cvt_pk_bf16_f32 %0, %1, %2" : "=v"(r) : "v"(lo), "v"(hi)); return r; }
__device__ __forceinline__ bf16 f2bf(float f) { return (bf16)(cvt_pk_bf16(f, 0.f) & 0xffffu); }
__device__ __forceinline__ float bf2f(bf16 b) { return __uint_as_float(((unsigned)b) << 16); }
__device__ __forceinline__ float bflo(unsigned w) { return __uint_as_float(w << 16); }
__device__ __forceinline__ float bfhi(unsigned w) { return __uint_as_float(w & 0xffff0000u); }
__device__ __forceinline__ f32x4 ld4h(const bf16* p) { const u32x2 w = *(const u32x2*)p; return (f32x4){bflo(w.x), bfhi(w.x), bflo(w.y), bfhi(w.y)}; }
__device__ __forceinline__ float fast_sigmoid(float x) { return __builtin_amdgcn_rcpf(1.0f + __builtin_amdgcn_exp2f(x * -1.4426950408889634f)); }
__device__ __forceinline__ float ieee_sigmoid(float x) { return 1.0f / (1.0f + __expf(-x)); }
__device__ __forceinline__ int lane_id() { int r; asm volatile("v_mbcnt_lo_u32_b32 %0, -1, 0\n\tv_mbcnt_hi_u32_b32 %0, -1, %0" : "=v"(r)); return r; }
__device__ __forceinline__ float shflx(float v, int mask, int lane) { return __int_as_float(__builtin_amdgcn_ds_bpermute((lane ^ mask) << 2, __float_as_int(v))); }
__device__ __forceinline__ float wave_sum(float v, int lane) {
#pragma unroll
    for (int o = 1; o < 64; o <<= 1) v += shflx(v, o, lane);
    return v;
}
constexpr float F8_XS = 32.0f, F8_WGU = 1024.0f, F8_ACT = 8.0f, F8_WDN = 2048.0f, F8_H = 32.0f, F8_WIN = 1024.0f;
typedef int i32x8 __attribute__((ext_vector_type(8)));
__device__ __forceinline__ float clamp448(float v) { return fminf(fmaxf(v, -448.0f), 448.0f); }
__device__ __forceinline__ u32x2 pack8_f8(const f32x4& a, const f32x4& b) {
    int w0 = 0, w1 = 0;
    w0 = __builtin_amdgcn_cvt_pk_fp8_f32(clamp448(a[0]), clamp448(a[1]), w0, false); w0 = __builtin_amdgcn_cvt_pk_fp8_f32(clamp448(a[2]), clamp448(a[3]), w0, true);
    w1 = __builtin_amdgcn_cvt_pk_fp8_f32(clamp448(b[0]), clamp448(b[1]), w1, false); w1 = __builtin_amdgcn_cvt_pk_fp8_f32(clamp448(b[2]), clamp448(b[3]), w1, true);
    u32x2 r; r.x = (unsigned)w0; r.y = (unsigned)w1; return r;
}
__device__ __forceinline__ u32x4 pack8(const f32x4& a, const f32x4& b) {
    u32x4 w; w.x = cvt_pk_bf16(a[0], a[1]); w.y = cvt_pk_bf16(a[2], a[3]); w.z = cvt_pk_bf16(b[0], b[1]); w.w = cvt_pk_bf16(b[2], b[3]); return w;
}

#define XB_TMO      128
#define XB_XCNT(j)  (256  + 64 * (j))
#define XB_XSUB(j)  (1280 + 64 * (j))
#define XB_XGEN(j)  (2304 + 64 * (j))
#define XB_TOP      3328
#define XB_TOPGEN   3392
#define XCD_BAR_WORDS 3456
#define XB_SPIN_CAP (1u << 18)
__device__ __forceinline__ unsigned xb_ld(unsigned* p)              { return __hip_atomic_load(p, __ATOMIC_RELAXED, __HIP_MEMORY_SCOPE_AGENT); }
__device__ __forceinline__ unsigned xb_add(unsigned* p, unsigned v) { return __hip_atomic_fetch_add(p, v, __ATOMIC_RELAXED, __HIP_MEMORY_SCOPE_AGENT); }
__device__ __forceinline__ unsigned xb_xcc_id() { return (unsigned)__builtin_amdgcn_s_getreg((3 << 11) | 20) & 0xFu; }
#define XB_SPIN(cond, bar) do { unsigned _sp = 0; while (cond) { __builtin_amdgcn_s_sleep(1); \
    if ((++_sp & 255u) == 0u) { if (xb_ld(&(bar)[XB_TMO])) break; if (_sp > XB_SPIN_CAP) { atomicAdd(&(bar)[XB_TMO], 1u); break; } } } } while (0)
struct XcdBarrier { unsigned* bar; unsigned x; volatile LAS unsigned* st; unsigned nloc, nx; };
__device__ __forceinline__ XcdBarrier xcd_barrier_post(unsigned* bar, volatile LAS unsigned* st, int tid) {
    XcdBarrier b; b.bar = bar; b.x = xb_xcc_id(); b.st = st; b.nloc = 0u; b.nx = 0u;
    if (tid == 0) (void)xb_add(&bar[XB_XCNT(b.x)], 1u);
    return b;
}
__device__ __forceinline__ void xcd_barrier_complete(unsigned* bar, unsigned x, unsigned& nloc, unsigned& nx) {
    const unsigned G = gridDim.x * gridDim.y * gridDim.z;
    unsigned sum, cnt, mine, sp = 0u;
    for (;;) {
        sum = 0u; cnt = 0u; mine = 0u;
#pragma unroll
        for (unsigned j = 0; j < 16; ++j) { const unsigned c = xb_ld(&bar[XB_XCNT(j)]); sum += c; cnt += (c > 0u) ? 1u : 0u; mine = (j == x) ? c : mine; }
        if (sum == G) break;
        __builtin_amdgcn_s_sleep(1);
        if ((++sp & 255u) == 0u) { if (xb_ld(&bar[XB_TMO])) break; if (sp > XB_SPIN_CAP) { atomicAdd(&bar[XB_TMO], 1u); break; } }
    }
    nloc = mine > 0u ? mine : 1u; nx = cnt > 0u ? cnt : 1u;
}
__device__ __forceinline__ void xcd_barrier(XcdBarrier& b, int tid) {
    asm volatile("s_waitcnt vmcnt(0)" ::: "memory");
    __syncthreads();
    unsigned nloc_new = b.nloc, nx_new = b.nx;
    if (tid == 0) {
        unsigned* bar = b.bar; unsigned bxx = b.x; asm volatile("" : "+s"(bar), "+s"(bxx));
        __builtin_amdgcn_s_waitcnt(0);
        unsigned nloc = b.nloc, nx = b.nx;
        if (nloc == 0u) { xcd_barrier_complete(bar, bxx, nloc, nx); nloc_new = nloc; nx_new = nx; }
        const unsigned old = xb_add(&bar[XB_XSUB(bxx)], 1u);
        const unsigned gen = old / nloc;
        if (old + 1u == (gen + 1u) * nloc) {
            __builtin_amdgcn_fence(__ATOMIC_RELEASE, "agent");
            asm volatile("s_waitcnt vmcnt(0)" ::: "memory");
            const unsigned og = xb_add(&bar[XB_TOP], 1u);
            const unsigned tg = og / nx;
            if (og + 1u != (tg + 1u) * nx) XB_SPIN(xb_ld(&bar[XB_TOP]) < (tg + 1u) * nx, bar);
            __builtin_amdgcn_fence(__ATOMIC_ACQUIRE, "agent");
            xb_add(&bar[XB_XGEN(bxx)], 1u);
            asm volatile("s_waitcnt vmcnt(0)" ::: "memory");
        } else {
            XB_SPIN(xb_ld(&bar[XB_XGEN(bxx)]) == gen, bar);
            __builtin_amdgcn_fence(__ATOMIC_ACQUIRE, "agent");
            asm volatile("s_waitcnt vmcnt(0)" ::: "memory");
        }
    }
    b.nloc = __builtin_amdgcn_readfirstlane(nloc_new); b.nx = __builtin_amdgcn_readfirstlane(nx_new);
    __syncthreads();
}

typedef unsigned long long u64;
namespace pg8 {
typedef int i32x4v __attribute__((ext_vector_type(4)));
constexpr int BM = 256, BK = 64, HALF = 128, HTB = HALF * BK * 2, STAGE_BYTES = 8 * HTB, NXCD = 8, WGM = 8;
__device__ __forceinline__ int lds_byte(int r, int c) { const int st = (r >> 4) * 2 + (c >> 5), rr = r & 15, cc = c & 31, ob = rr * 64 + cc * 2; return st * 1024 + (ob ^ (((ob >> 9) & 1) << 5)); }
__device__ __forceinline__ void stage_rc(int b, int& R, int& C) { const int st = b / 1024, sb = b % 1024, swz = sb ^ (((sb >> 9) & 1) << 5); R = (st >> 1) * 16 + swz / 64; C = (st & 1) * 32 + (swz % 64) / 2; }
__device__ __forceinline__ int perm32(int rho) { const int n = rho >> 4, i = rho & 15; return 8 * (i >> 2) + 4 * n + (i & 3); }

struct Unit { unsigned A, B; int pm, pn, kind, aux; };

__device__ __forceinline__ int xcd_remap(int L, int nwg) { const int q = nwg / NXCD, r = nwg % NXCD, xcd = L % NXCD, off = L / NXCD; return (xcd < r ? xcd * (q + 1) : r * (q + 1) + (xcd - r) * q) + off; }
__device__ __forceinline__ void tile_decode(int wgid, int nM, int nN, int& pm, int& pn) {
    const int nig = WGM * nN, gid = wgid / nig, fm = gid * WGM, gsz = (nM - fm) < WGM ? (nM - fm) : WGM;
    pm = fm + ((wgid % nig) % gsz); pn = (wgid % nig) / gsz;
}

template <class Epi, class Sched, bool ALIGN_EPI = true, bool F8 = false, int PM = 0>
__device__ __forceinline__ void gemm_run(LAS unsigned char* lds, const int tid, const unsigned char* wsbase, const int K, const int lda, const int ldb, const Sched& S, const Epi& E) {
    const int wid = __builtin_amdgcn_readfirstlane(tid >> 6), lane = tid & 63, wr = wid >> 2, wc = wid & 3, fr = lane & 15, fq = lane >> 4;
    const int nt = K / BK;
    const unsigned long long wsb = (unsigned long long)wsbase; const unsigned wlo = __builtin_amdgcn_readfirstlane((unsigned)wsb), whi = __builtin_amdgcn_readfirstlane((unsigned)(wsb >> 32));
    const __amdgpu_buffer_rsrc_t rsrc = __builtin_amdgcn_make_buffer_rsrc((void*)(((unsigned long long)whi << 32) | wlo), 0, 0xFFFFF000u, 0x00020000);
    unsigned voffA, voffB;
    { int R, C; stage_rc(tid * 16, R, C); const int Rb = (R & ~31) + perm32(R & 31); voffA = (unsigned)(R * lda + C) * 2u; voffB = (unsigned)(Rb * ldb + C) * 2u; }
    const unsigned pieceA = 64u * lda * 2u, pieceB = 64u * ldb * 2u;
    const unsigned kstep = BK * 2;
    const unsigned hstepA = (unsigned)HALF * lda * 2u, hstepB = (unsigned)HALF * ldb * 2u;
    const unsigned ldsw = (unsigned)wid * 1024u;
    const int aoff = lds_byte(wr * 64 + fr, fq * 8), boff = lds_byte(wc * 32 + fr, fq * 8);
#define PG8_SA(b, h) (((b) * 2 + (h)) * HTB)
#define PG8_SB(b, h) ((4 + (b) * 2 + (h)) * HTB)
#define PG8_STAGE(bufoff, goff, voff) do { if constexpr (PM == 2) break; \
        __builtin_amdgcn_raw_ptr_buffer_load_lds(rsrc, (LAS void*)(lds + (bufoff) + ldsw), 16, (int)(voff), (int)(goff), 0, 0); \
        __builtin_amdgcn_raw_ptr_buffer_load_lds(rsrc, (LAS void*)(lds + (bufoff) + ldsw + 8192), 16, (int)(voff), (int)((goff) + piece##voff), 0, 0); } while (0)
#define piecevoffA pieceA
#define piecevoffB pieceB
#define PG8_LDA(dst, b, h) do { if constexpr (PM == 1) break; _Pragma("unroll") for (int m = 0; m < 4; ++m) _Pragma("unroll") for (int k = 0; k < 2; ++k) dst[m][k] = *(const LAS bf16x8*)(lds + PG8_SA(b, h) + aoff + m * 2048 + k * 1024); } while (0)
#define PG8_LDB(dst, b, h) do { if constexpr (PM == 1) break; _Pragma("unroll") for (int n = 0; n < 2; ++n) _Pragma("unroll") for (int k = 0; k < 2; ++k) dst[n][k] = *(const LAS bf16x8*)(lds + PG8_SB(b, h) + boff + n * 2048 + k * 1024); } while (0)
#define PG8_CAT(lo, hi) __builtin_shufflevector(__builtin_bit_cast(i32x4v, lo), __builtin_bit_cast(i32x4v, hi), 0, 1, 2, 3, 4, 5, 6, 7)
#define PG8_MMA(ai, bj, At, Bt) do { if constexpr (PM == 3) break; __builtin_amdgcn_s_setprio(1); if constexpr (F8) { _Pragma("unroll") for (int m = 0; m < 4; ++m) _Pragma("unroll") for (int n = 0; n < 2; ++n) \
        acc[ai][bj][m][n] = __builtin_amdgcn_mfma_scale_f32_16x16x128_f8f6f4(PG8_CAT(Bt[n][0], Bt[n][1]), PG8_CAT(At[m][0], At[m][1]), acc[ai][bj][m][n], 0, 0, 0, 0x7F7F7F7F, 0, 0x7F7F7F7F); } \
      else { _Pragma("unroll") for (int m = 0; m < 4; ++m) _Pragma("unroll") for (int n = 0; n < 2; ++n) _Pragma("unroll") for (int k = 0; k < 2; ++k) \
        acc[ai][bj][m][n] = __builtin_amdgcn_mfma_f32_16x16x32_bf16(Bt[n][k], At[m][k], acc[ai][bj][m][n], 0, 0, 0); } __builtin_amdgcn_s_setprio(0); } while (0)
#define PG8_WAIT_V(n) asm volatile("s_waitcnt vmcnt(" #n ")" ::: "memory")
#define PG8_WAIT_L(n) asm volatile("s_waitcnt lgkmcnt(" #n ")" ::: "memory")
#define PG8_BAR __builtin_amdgcn_s_barrier()
#define PG8_SCHED __builtin_amdgcn_sched_barrier(0)
    Unit cur, nxt; int ui = 0;
    if (!S.next(0, cur)) return;
    LAS unsigned char* pfslot = lds + STAGE_BYTES + ldsw * 2u;
#define PG8_PF(unit) do { if constexpr (Epi::PF) { const int po = __builtin_amdgcn_readfirstlane((int)E.pf_off(unit)); \
        __builtin_amdgcn_raw_ptr_buffer_load_lds(rsrc, (LAS void*)pfslot, 16, lane * 16, po, 0, 0); \
        __builtin_amdgcn_raw_ptr_buffer_load_lds(rsrc, (LAS void*)(pfslot + 1024), 16, lane * 16, po + 1024, 0, 0); } } while (0)
    PG8_PF(cur);
    f32x4 acc[2][2][4][2];
#pragma unroll
    for (int a = 0; a < 2; ++a)
#pragma unroll
        for (int b = 0; b < 2; ++b)
#pragma unroll
            for (int m = 0; m < 4; ++m)
#pragma unroll
                for (int n = 0; n < 2; ++n) acc[a][b][m][n] = (f32x4){0.f, 0.f, 0.f, 0.f};
    bf16x8 At[4][2], B0[2][2], B1[2][2];
    if constexpr (PM == 1) {
#pragma unroll
        for (int m = 0; m < 4; ++m) { asm volatile("" : "=v"(At[m][0])); asm volatile("" : "=v"(At[m][1])); }
#pragma unroll
        for (int m = 0; m < 2; ++m) { asm volatile("" : "=v"(B0[m][0])); asm volatile("" : "=v"(B0[m][1])); asm volatile("" : "=v"(B1[m][0])); asm volatile("" : "=v"(B1[m][1])); }
    }
    unsigned cA = cur.A, cB = cur.B;
    PG8_STAGE(PG8_SB(0, 0), cB, voffB); PG8_STAGE(PG8_SB(0, 1), cB + hstepB, voffB); PG8_STAGE(PG8_SA(0, 0), cA, voffA); PG8_STAGE(PG8_SA(0, 1), cA + hstepA, voffA);
    if (wr == 1) PG8_BAR;
    PG8_WAIT_V(2); PG8_BAR;
    PG8_STAGE(PG8_SB(1, 0), cB + kstep, voffB); PG8_STAGE(PG8_SA(1, 0), cA + kstep, voffA); PG8_STAGE(PG8_SB(1, 1), cB + hstepB + kstep, voffB);
    PG8_WAIT_V(6); PG8_BAR;
    for (;;) {
        const bool has_next = S.next(ui + 1, nxt);
        const unsigned nA = has_next ? nxt.A : cA, nB = has_next ? nxt.B : cB;
        for (int t = 0; t < nt; t += 2) {
            const bool last = (t == nt - 2);
            const unsigned a1 = cA + (unsigned)(t + 1) * kstep;
            const unsigned a2 = last ? nA : cA + (unsigned)(t + 2) * kstep, b2 = last ? nB : cB + (unsigned)(t + 2) * kstep;
            const unsigned a3 = a2 + kstep, b3 = b2 + kstep;
            PG8_LDB(B0, 0, 0); PG8_LDB(B1, 0, 1); PG8_SCHED; PG8_LDA(At, 0, 0); PG8_STAGE(PG8_SA(1, 1), a1 + hstepA, voffA);
            PG8_WAIT_V(8); PG8_WAIT_L(0); PG8_BAR; PG8_MMA(0, 0, At, B0); PG8_MMA(0, 1, At, B1); PG8_BAR; PG8_SCHED;
            PG8_LDA(At, 0, 1); PG8_STAGE(PG8_SB(0, 0), b2, voffB); PG8_STAGE(PG8_SB(0, 1), b2 + hstepB, voffB); PG8_STAGE(PG8_SA(0, 0), a2, voffA);
            PG8_WAIT_V(8); PG8_WAIT_L(0); PG8_BAR; PG8_MMA(1, 0, At, B0); PG8_MMA(1, 1, At, B1); PG8_BAR; PG8_SCHED;
            PG8_LDB(B0, 1, 0); PG8_LDB(B1, 1, 1); PG8_SCHED; PG8_LDA(At, 1, 0); PG8_STAGE(PG8_SA(0, 1), a2 + hstepA, voffA);
            PG8_WAIT_V(8); PG8_WAIT_L(0); PG8_BAR; PG8_MMA(0, 0, At, B0); PG8_MMA(0, 1, At, B1); PG8_BAR; PG8_SCHED;
            PG8_LDA(At, 1, 1); PG8_STAGE(PG8_SB(1, 0), b3, voffB); PG8_STAGE(PG8_SB(1, 1), b3 + hstepB, voffB); PG8_STAGE(PG8_SA(1, 0), a3, voffA);
            PG8_WAIT_V(8); PG8_WAIT_L(0); PG8_BAR; PG8_MMA(1, 0, At, B0); PG8_MMA(1, 1, At, B1); PG8_BAR; PG8_SCHED;
        }
        if constexpr (ALIGN_EPI) { if (wr == 0) PG8_BAR; }
        bool zero_acc = true;
        { Unit eu = cur; asm volatile("" : "+s"(eu.pm), "+s"(eu.pn));
          const int lane_o = lane_id(); if constexpr (Epi::INPLACE) zero_acc = E(acc, eu, wr, wc, lane_o & 15, lane_o >> 4, (const LAS u64*)pfslot); else E(acc, eu, wr, wc, lane_o & 15, lane_o >> 4, (const LAS u64*)pfslot); }
        if (!has_next) break;
        PG8_SCHED; PG8_PF(nxt); PG8_SCHED;
        if (zero_acc) {
#pragma unroll
        for (int a = 0; a < 2; ++a)
#pragma unroll
            for (int b = 0; b < 2; ++b)
#pragma unroll
                for (int m = 0; m < 4; ++m)
#pragma unroll
                    for (int n = 0; n < 2; ++n) acc[a][b][m][n] = (f32x4){0.f, 0.f, 0.f, 0.f};
        }
        cur = nxt; cA = nA; cB = nB; ++ui;
        if constexpr (ALIGN_EPI) { if (wr == 1) PG8_BAR; }
    }
    PG8_WAIT_V(0);
    if constexpr (!ALIGN_EPI) { if (wr == 0) PG8_BAR; }
    PG8_BAR;
#undef PG8_PF
#undef PG8_SA
#undef PG8_SB
#undef PG8_STAGE
#undef piecevoffA
#undef piecevoffB
#undef PG8_LDA
#undef PG8_LDB
#undef PG8_MMA
#undef PG8_CAT
#undef PG8_WAIT_V
#undef PG8_WAIT_L
#undef PG8_BAR
#undef PG8_SCHED
}
}
using pg8::Unit;

typedef f32x4 Acc[2][2][4][2];
#define EPI_ROWS(u, wr, fr) const int row0 = (u).pm * 256 + (wr) * 64 + (fr)

__device__ __forceinline__ float ssq_val(const u64* ssq, int row) { return (float)ssq[row] * 2.3283064365386963e-10f; }
__device__ __forceinline__ u64 ssq_fix(float s) { return (u64)(s * 4294967296.0f); }
__device__ __forceinline__ float row_rstd_lds(const LAS u64* pf, int lrow, float invn) { return rsqrtf((float)pf[lrow] * 2.3283064365386963e-10f * invn + EPS); }
__device__ __forceinline__ float row_rstd(const u64* ssq, int row, float invn) { return rsqrtf(ssq_val(ssq, row) * invn + EPS); }
__device__ __forceinline__ void ssq_atomic(u64* ssq, int row, float s, int fr, int fq) {
    const int lane = fr + 16 * fq; s += shflx(s, 16, lane); s += shflx(s, 32, lane);
    if (fq == 0) atomicAdd(ssq + row, ssq_fix(s));
}

struct EpiIn {
    static constexpr bool INPLACE = false, PF = true;
    unsigned char* ws; int l; bool do_ssq; float scale;
    __device__ __forceinline__ unsigned pf_off(const Unit& u) const { return (unsigned)(l == 0 ? WS_SSQA0 : CB_SSQ + (size_t)SSQ_A1 * NTOK * 8) + (u.kind == 1 ? 0u : (unsigned)u.pm * 2048u); }
    __device__ __forceinline__ void operator()(const Acc& acc, const Unit& u, int wr, int wc, int fr, int fq, const LAS u64* pf) const {
        EPI_ROWS(u, wr, fr);
        bf16* proj = (bf16*)(ws + WS_PROJ); float* zf = (float*)(ws + WS_ZF); bf16* mkv = (bf16*)(ws + WS_MKV);
        const u64* ssq_h = l == 0 ? (const u64*)(ws + WS_SSQA0) : (const u64*)(ws + CB_SSQ) + SSQ_A1 * NTOK;
        u64* ssq_cq = (u64*)(ws + CB_SSQ) + (l == 0 ? SSQ_CQ0 : SSQ_CQ1) * NTOK; u64* ssq_ckv = (u64*)(ws + CB_SSQ) + (l == 0 ? SSQ_CKV0 : SSQ_CKV1) * NTOK;
        const float* cosT = (const float*)(ws + WS_COS); const float* sinT = (const float*)(ws + WS_SIN);
        if (u.kind == 1) {
#pragma unroll
            for (int ai = 0; ai < 2; ++ai)
#pragma unroll
                for (int m = 0; m < 4; ++m) { const int row = row0 + ai * 128 + m * 16;
#pragma unroll
                    for (int bj = 0; bj < 2; ++bj) { const int col = u.pn * 256 + bj * 128 + wc * 32 + 8 * fq;
                        *(u32x4*)(mkv + (size_t)row * 2048 + col) = pack8(acc[ai][bj][m][0], acc[ai][bj][m][1]); } }
            return;
        }
        const int pn = u.pn;
        float rsv[2][4];
#pragma unroll
        for (int ai = 0; ai < 2; ++ai)
#pragma unroll
            for (int m = 0; m < 4; ++m) rsv[ai][m] = row_rstd_lds(pf, ai * 128 + wr * 64 + m * 16 + fr, 1.0f / DM) * scale;
#pragma unroll
        for (int ai = 0; ai < 2; ++ai)
#pragma unroll
            for (int m = 0; m < 4; ++m) {
                const int row = row0 + ai * 128 + m * 16;
                const float rs = rsv[ai][m];
                float sq = 0.f;
#pragma unroll
                for (int bj = 0; bj < 2; ++bj) {
                    const int col = pn * 256 + bj * 128 + wc * 32 + 8 * fq;
                    f32x4 v0 = acc[ai][bj][m][0] * rs, v1 = acc[ai][bj][m][1] * rs;
                    if (pn >= 4 && pn < 8) {
                        float* zp = zf + (size_t)row * 1024 + (col - PC_F);
                        *(f32x4*)zp = v0; *(f32x4*)(zp + 4) = v1;
                    } else {
                        if (pn >= 16 && pn < 20) sq += (v0[0] * v0[0] + v0[1] * v0[1]) + (v0[2] * v0[2] + v0[3] * v0[3]) + (v1[0] * v1[0] + v1[1] * v1[1]) + (v1[2] * v1[2] + v1[3] * v1[3]);
                        if (pn == 20 && bj == 0 && wc < 2) {
                            const int j0 = (wc * 32 + 8 * fq) >> 1;
                            const f32x4 cs = *(const f32x4*)(cosT + (size_t)row * 32 + j0), sn = *(const f32x4*)(sinT + (size_t)row * 32 + j0);
                            f32x4 r0, r1;
                            r0[0] = v0[0] * cs[0] - v0[1] * sn[0]; r0[1] = v0[1] * cs[0] + v0[0] * sn[0];
                            r0[2] = v0[2] * cs[1] - v0[3] * sn[1]; r0[3] = v0[3] * cs[1] + v0[2] * sn[1];
                            r1[0] = v1[0] * cs[2] - v1[1] * sn[2]; r1[1] = v1[1] * cs[2] + v1[0] * sn[2];
                            r1[2] = v1[2] * cs[3] - v1[3] * sn[3]; r1[3] = v1[3] * cs[3] + v1[2] * sn[3];
                            v0 = r0; v1 = r1;
                        }
                        if (pn >= 25) {
#pragma unroll
                            for (int j = 0; j < 4; ++j) { v0[j] = EPI_SIGMOID(v0[j]); v1[j] = EPI_SIGMOID(v1[j]); }
                        }
                        *(u32x4*)(proj + (size_t)row * DINP + col) = pack8(v0, v1);
                    }
                }
                if (do_ssq && pn >= 16 && pn < 18) ssq_atomic(ssq_cq, row, sq, fr, fq);
                if (do_ssq && pn >= 18 && pn < 20) ssq_atomic(ssq_ckv, row, sq, fr, fq);
            }
    }
};

struct EpiGateLogit {
    static constexpr bool INPLACE = false, PF = true;
    unsigned char* ws; int l;
    __device__ __forceinline__ unsigned pf_off(const Unit& u) const { return (unsigned)(l == 0 ? WS_SSQA0 : CB_SSQ + (size_t)SSQ_A1 * NTOK * 8) + (unsigned)u.pm * 2048u; }
    __device__ __forceinline__ void operator()(const Acc& acc, const Unit& u, int wr, int wc, int fr, int fq, const LAS u64* pf) const {
        if (MK_LAT_F8 && u.pn >= 24) {
            Unit v = u; v.pn = u.pn - 8; v.kind = 0; const EpiIn e{ws, l, true, 1.0f / (F8_H * F8_WIN)}; e(acc, v, wr, wc, fr, fq, pf); return; }
        EPI_ROWS(u, wr, fr);
        bf16* proj = (bf16*)(ws + WS_PROJ);
        const u64* ssq_h = l == 0 ? (const u64*)(ws + WS_SSQA0) : (const u64*)(ws + CB_SSQ) + SSQ_A1 * NTOK;
        float rsv[2][4];
#pragma unroll
        for (int ai = 0; ai < 2; ++ai)
#pragma unroll
            for (int m = 0; m < 4; ++m) rsv[ai][m] = row_rstd_lds(pf, ai * 128 + wr * 64 + m * 16 + fr, 1.0f / DM) * (1.0f / (F8_H * F8_WIN));
#pragma unroll
        for (int ai = 0; ai < 2; ++ai)
#pragma unroll
            for (int m = 0; m < 4; ++m) {
                const int row = row0 + ai * 128 + m * 16;
                const float rsl = rsv[ai][m] * -1.4426950408889634f;
#pragma unroll
                for (int bj = 0; bj < 2; ++bj) {
                    const int col = u.pn * 256 + bj * 128 + wc * 32 + 8 * fq;
                    f32x4 v0, v1;
#pragma unroll
                    for (int j = 0; j < 4; ++j) { v0[j] = __builtin_amdgcn_rcpf(1.0f + __builtin_amdgcn_exp2f(acc[ai][bj][m][0][j] * rsl)); v1[j] = __builtin_amdgcn_rcpf(1.0f + __builtin_amdgcn_exp2f(acc[ai][bj][m][1][j] * rsl)); }
                    *(u32x4*)(proj + (size_t)row * DINP + PC_GATE + col) = pack8(v0, v1);
                }
            }
    }
};

struct EpiUp {
    static constexpr bool INPLACE = false, PF = true;
    unsigned char* ws; int l;
    __device__ __forceinline__ unsigned pf_off(const Unit& u) const { return (unsigned)(CB_SSQ + (size_t)(u.kind == 0 ? (l == 0 ? SSQ_CQ0 : SSQ_CQ1) : (l == 0 ? SSQ_CKV0 : SSQ_CKV1)) * NTOK * 8) + (unsigned)u.pm * 2048u; }
    __device__ __forceinline__ void operator()(const Acc& acc, const Unit& u, int wr, int wc, int fr, int fq, const LAS u64* pf) const {
        EPI_ROWS(u, wr, fr);
        bf16* qmla = (bf16*)(ws + WS_QMLA); bf16* kvb = (bf16*)(ws + WS_KVB);
        const u64* ssq_cq = (const u64*)(ws + CB_SSQ) + (l == 0 ? SSQ_CQ0 : SSQ_CQ1) * NTOK; const u64* ssq_ckv = (const u64*)(ws + CB_SSQ) + (l == 0 ? SSQ_CKV0 : SSQ_CKV1) * NTOK;
        const float* cosT = (const float*)(ws + WS_COS); const float* sinT = (const float*)(ws + WS_SIN);
        const bool isq = (u.kind == 0);
        float rsv[2][4];
#pragma unroll
        for (int ai = 0; ai < 2; ++ai)
#pragma unroll
            for (int m = 0; m < 4; ++m) rsv[ai][m] = row_rstd_lds(pf, ai * 128 + wr * 64 + m * 16 + fr, 1.0f / 512.0f);
#pragma unroll
        for (int ai = 0; ai < 2; ++ai)
#pragma unroll
            for (int m = 0; m < 4; ++m) {
                const int row = row0 + ai * 128 + m * 16;
                const float rs = rsv[ai][m];
#pragma unroll
                for (int bj = 0; bj < 2; ++bj) {
                    const int col = u.pn * 256 + bj * 128 + wc * 32 + 8 * fq;
                    f32x4 v0 = acc[ai][bj][m][0] * rs, v1 = acc[ai][bj][m][1] * rs;
                    if (isq) {
                        const int c192 = col % QKD;
                        if (c192 >= NOPE) {
                            const int j0 = (c192 - NOPE) >> 1;
                            const f32x4 cs = *(const f32x4*)(cosT + (size_t)row * 32 + j0), sn = *(const f32x4*)(sinT + (size_t)row * 32 + j0);
                            f32x4 r0, r1;
                            r0[0] = v0[0] * cs[0] - v0[1] * sn[0]; r0[1] = v0[1] * cs[0] + v0[0] * sn[0];
                            r0[2] = v0[2] * cs[1] - v0[3] * sn[1]; r0[3] = v0[3] * cs[1] + v0[2] * sn[1];
                            r1[0] = v1[0] * cs[2] - v1[1] * sn[2]; r1[1] = v1[1] * cs[2] + v1[0] * sn[2];
                            r1[2] = v1[2] * cs[3] - v1[3] * sn[3]; r1[3] = v1[3] * cs[3] + v1[2] * sn[3];
                            v0 = r0; v1 = r1;
                        }
                        *(u32x4*)(qmla + (size_t)row * 1536 + col) = pack8(v0, v1);
                    } else {
                        *(u32x4*)(kvb + (size_t)row * 2048 + col) = pack8(v0, v1);
                    }
                }
            }
    }
};

struct EpiGate {
    static constexpr bool INPLACE = true, PF = false;
    unsigned char* ws;
    __device__ __forceinline__ bool operator()(Acc& acc, const Unit& u, int wr, int wc, int fr, int fq, const LAS u64* pf) const {
        EPI_ROWS(u, wr, fr);
        const bf16* proj = (const bf16*)(ws + WS_PROJ); bf16* mrgb = (bf16*)(ws + WS_MRGB);
        const int n = u.kind;
#pragma unroll
        for (int ai = 0; ai < 2; ++ai) {
            u32x4 ga[4][2], gb[4][2];
#pragma unroll
            for (int m = 0; m < 4; ++m)
#pragma unroll
                for (int bj = 0; bj < 2; ++bj) { const int row = row0 + ai * 128 + m * 16, col = u.pn * 256 + bj * 128 + wc * 32 + 8 * fq;
                    const bf16* gp = proj + (size_t)row * DINP + PC_GATE + col;
                    ga[m][bj] = *(const u32x4*)(gp + n * DM);
                    if (n < 2) gb[m][bj] = *(const u32x4*)(gp + (n + 1) * DM); }
#pragma unroll
            for (int m = 0; m < 4; ++m)
#pragma unroll
                for (int bj = 0; bj < 2; ++bj) { const int row = row0 + ai * 128 + m * 16, col = u.pn * 256 + bj * 128 + wc * 32 + 8 * fq;
                    const unsigned aw[4] = {ga[m][bj].x, ga[m][bj].y, ga[m][bj].z, ga[m][bj].w}, bw[4] = {gb[m][bj].x, gb[m][bj].y, gb[m][bj].z, gb[m][bj].w};
                    float f[8];
#pragma unroll
                    for (int j = 0; j < 4; ++j) { float n0 = bflo(aw[j]), n1 = bfhi(aw[j]);
                        if (n > 0) { n0 = fmaxf(n0, 1e-6f); n1 = fmaxf(n1, 1e-6f); }
                        if (n < 2) { n0 *= __builtin_amdgcn_rcpf(fmaxf(bflo(bw[j]), 1e-6f)); n1 *= __builtin_amdgcn_rcpf(fmaxf(bfhi(bw[j]), 1e-6f)); }
                        f[2 * j] = n0; f[2 * j + 1] = n1; }
                    f32x4& v0 = acc[ai][bj][m][0]; f32x4& v1 = acc[ai][bj][m][1];
                    v0[0] *= f[0]; v0[1] *= f[1]; v0[2] *= f[2]; v0[3] *= f[3]; v1[0] *= f[4]; v1[1] *= f[5]; v1[2] *= f[6]; v1[3] *= f[7];
                    if (n == 2) *(u32x4*)(mrgb + (size_t)row * DM + col) = pack8(v0, v1); }
        }
        return n == 2;
    }
};

template <bool SCALED> struct EpiResT {
    static constexpr bool INPLACE = false, PF = false;
    unsigned char* ws; int ssq_idx; bool f8copy;
    __device__ __forceinline__ void operator()(const Acc& acc, const Unit& u, int wr, int wc, int fr, int fq, const LAS u64* pf) const {
        EPI_ROWS(u, wr, fr);
        bf16* hb = (bf16*)(ws + WS_HB); u64* ssq = (u64*)(ws + CB_SSQ) + ssq_idx * NTOK;
        u32x4 bv[2][4][2];
#pragma unroll
        for (int ai = 0; ai < 2; ++ai)
#pragma unroll
            for (int m = 0; m < 4; ++m)
#pragma unroll
                for (int bj = 0; bj < 2; ++bj) bv[ai][m][bj] = *(const u32x4*)(hb + (size_t)(row0 + ai * 128 + m * 16) * DM + u.pn * 256 + bj * 128 + wc * 32 + 8 * fq);
#pragma unroll
        for (int ai = 0; ai < 2; ++ai)
#pragma unroll
            for (int m = 0; m < 4; ++m) {
                const int row = row0 + ai * 128 + m * 16;
                float sq = 0.f;
#pragma unroll
                for (int bj = 0; bj < 2; ++bj) {
                    const int col = u.pn * 256 + bj * 128 + wc * 32 + 8 * fq;
                    const u32x4 b = bv[ai][m][bj];
                    f32x4 v0 = acc[ai][bj][m][0], v1 = acc[ai][bj][m][1];
                    if (SCALED) {
#pragma unroll
                        for (int j = 0; j < 4; ++j) { v0[j] = __builtin_ldexpf(v0[j], -14); v1[j] = __builtin_ldexpf(v1[j], -14); } }
                    v0 = v0 + (f32x4){bflo(b.x), bfhi(b.x), bflo(b.y), bfhi(b.y)}; v1 = v1 + (f32x4){bflo(b.z), bfhi(b.z), bflo(b.w), bfhi(b.w)};
                    *(u32x4*)(hb + (size_t)row * DM + col) = pack8(v0, v1);
                    if (f8copy) *(u32x2*)(ws + WS_HB8 + (size_t)row * DM + col) = pack8_f8(v0 * F8_H, v1 * F8_H);
                    sq += (v0[0] * v0[0] + v0[1] * v0[1]) + (v0[2] * v0[2] + v0[3] * v0[3]) + (v1[0] * v1[0] + v1[1] * v1[1]) + (v1[2] * v1[2] + v1[3] * v1[3]);
                }
                ssq_atomic(ssq, row, sq, fr, fq);
            }
    }
};

typedef EpiResT<false> EpiRes;
static_assert(F8_ACT * F8_WDN == 16384.0f && F8_H * F8_WGU == 32768.0f, "power-of-two fp8 scales");
template <bool RSTD, bool IN8 = false, bool OUT8 = false> struct EpiSwiglu {
    static constexpr bool INPLACE = false, PF = RSTD;
    unsigned char* ws; unsigned act_off; int ldc; int ssq_idx;
    __device__ __forceinline__ unsigned pf_off(const Unit& u) const { return (unsigned)(CB_SSQ + (size_t)ssq_idx * NTOK * 8) + (unsigned)u.pm * 2048u; }
    __device__ __forceinline__ void operator()(const Acc& acc, const Unit& u, int wr, int wc, int fr, int fq, const LAS u64* pf) const {
        EPI_ROWS(u, wr, fr);
        bf16* act = (bf16*)(ws + act_off); const u64* ssq = (const u64*)(ws + CB_SSQ) + ssq_idx * NTOK;
        float rsv[2][4];
#pragma unroll
        for (int ai = 0; ai < 2; ++ai)
#pragma unroll
            for (int m = 0; m < 4; ++m) { rsv[ai][m] = RSTD ? row_rstd_lds(pf, ai * 128 + wr * 64 + m * 16 + fr, 1.0f / DM) : 1.0f; if (IN8) rsv[ai][m] = __builtin_ldexpf(rsv[ai][m], -15); }
#pragma unroll
        for (int ai = 0; ai < 2; ++ai)
#pragma unroll
            for (int m = 0; m < 4; ++m) {
                const int row = row0 + ai * 128 + m * 16;
                const float rs = rsv[ai][m], rsl = rs * -1.4426950408889634f, rs2 = OUT8 ? __builtin_ldexpf(rs * rs, 3) : rs * rs;
                f32x4 o[2];
#pragma unroll
                for (int n = 0; n < 2; ++n)
#pragma unroll
                    for (int j = 0; j < 4; ++j) { const float ag = acc[ai][0][m][n][j];
                        o[n][j] = ag * __builtin_amdgcn_rcpf(1.0f + __builtin_amdgcn_exp2f(ag * rsl)) * acc[ai][1][m][n][j] * rs2; }
                if (MK_PROBE_MODE == 9 && act_off == 1u) { const u32x4 pk = pack8(o[0], o[1]); asm volatile("" :: "v"(pk)); } else
                if (OUT8) *(u32x2*)((unsigned char*)act + (size_t)row * ldc + u.pn * 128 + wc * 32 + 8 * fq) = pack8_f8(o[0], o[1]); else
                *(u32x4*)(act + (size_t)row * ldc + u.pn * 128 + wc * 32 + 8 * fq) = pack8(o[0], o[1]);
            }
    }
};

struct EpiNull {
    static constexpr bool INPLACE = false, PF = false;
    unsigned char* ws;
    __device__ __forceinline__ void operator()(const Acc& acc, const Unit& u, int wr, int wc, int fr, int fq, const LAS u64* pf) const {
#pragma unroll
        for (int ai = 0; ai < 2; ++ai)
#pragma unroll
            for (int bj = 0; bj < 2; ++bj)
#pragma unroll
                for (int m = 0; m < 4; ++m) { asm volatile("" :: "v"(acc[ai][bj][m][0])); asm volatile("" :: "v"(acc[ai][bj][m][1])); }
    }
};

struct EpiSwigluF8 {
    static constexpr bool INPLACE = false, PF = false;
    unsigned char* ws;
    __device__ __forceinline__ void operator()(const Acc& acc, const Unit& u, int wr, int wc, int fr, int fq, const LAS u64* pf) const {
        EPI_ROWS(u, wr, fr);
        unsigned char* act = ws + WS_ACTE; constexpr int ldc = FFE;
        const float inv = 1.0f / (F8_XS * F8_WGU);
#pragma unroll
        for (int ai = 0; ai < 2; ++ai)
#pragma unroll
            for (int m = 0; m < 4; ++m) {
                const int row = row0 + ai * 128 + m * 16;
                f32x4 o[2];
#pragma unroll
                for (int n = 0; n < 2; ++n)
#pragma unroll
                    for (int j = 0; j < 4; ++j) { const float ag = acc[ai][0][m][n][j];
                        o[n][j] = ag * __builtin_amdgcn_rcpf(1.0f + __builtin_amdgcn_exp2f(ag * (inv * -1.4426950408889634f))) * acc[ai][1][m][n][j] * (inv * inv * F8_ACT); }
                *(u32x2*)(act + (size_t)row * ldc + u.pn * 128 + wc * 32 + 8 * fq) = pack8_f8(o[0], o[1]);
            }
    }
};
struct EpiMoeDown {
    static constexpr bool INPLACE = false, PF = true;
    unsigned char* ws; float oscale;
    __device__ __forceinline__ unsigned pf_off(const Unit& u) const { return (unsigned)WS_RASS + (unsigned)u.pm * 2048u; }
    __device__ __forceinline__ void operator()(const Acc& acc, const Unit& u, int wr, int wc, int fr, int fq, const LAS u64* pf) const {
        EPI_ROWS(u, wr, fr);
        bf16* ys = (bf16*)(ws + WS_YS); const int* rass = (const int*)(ws + WS_RASS); const float* topw = (const float*)(ws + WS_TOPW);
        int rav[2][4]; float wv[2][4];
#pragma unroll
        for (int ai = 0; ai < 2; ++ai)
#pragma unroll
            for (int m = 0; m < 4; ++m) { const u64 v = pf[ai * 128 + wr * 64 + m * 16 + fr]; rav[ai][m] = (int)(unsigned)v; wv[ai][m] = __uint_as_float((unsigned)(v >> 32)) * oscale; }
#pragma unroll
        for (int ai = 0; ai < 2; ++ai)
#pragma unroll
            for (int m = 0; m < 4; ++m) {
                const int ra = rav[ai][m];
                if (ra >= 0) {
                    const float w = wv[ai][m];
#pragma unroll
                    for (int bj = 0; bj < 2; ++bj) {
                        const int col = u.pn * 256 + bj * 128 + wc * 32 + 8 * fq;
                        bf16* dst = u.aux ? (bf16*)(ws + WS_YSQ) + ((size_t)(u.aux - 1) * 2048 + (size_t)(row0 + ai * 128 + m * 16 - 64 * 256)) * DM + col : ys + (size_t)ra * DM + col;
                        *(u32x4*)dst = pack8(acc[ai][bj][m][0] * w, acc[ai][bj][m][1] * w);
                    }
                }
            }
    }
};

struct SchedPlain {
    unsigned A, B; int nM, nN, G, c; unsigned a_tile, b_tile;
    __device__ __forceinline__ bool next(int i, Unit& u) const {
        const int total = nM * nN; const int L = i * G + c; if (L >= total) return false;
        int pm, pn; pg8::tile_decode(pg8::xcd_remap(L, total), nM, nN, pm, pn);
        u.pm = pm; u.pn = pn; u.kind = 0; u.aux = 0; u.A = A + (unsigned)pm * a_tile; u.B = B + (unsigned)pn * b_tile; return true;
    }
};
struct SchedIn {
    unsigned hb, win, memn, wmkv; int G, c, nN1; bool memkv;
    __device__ __forceinline__ bool next(int i, Unit& u) const {
        const int T0 = 32 * nN1, TOT = memkv ? T0 + 32 : T0; const int L = i * G + c; if (L >= TOT) return false;
        const int w = pg8::xcd_remap(L, TOT); int pm, pn;
        if (w < T0) { pg8::tile_decode(w, 32, nN1, pm, pn); u.kind = 0; u.A = hb + (unsigned)pm * 256u * DM * 2u; u.B = win + (unsigned)pn * 256u * DM * 2u; }
        else { pg8::tile_decode(w - T0, 4, 8, pm, pn); u.kind = 1; u.A = memn + (unsigned)pm * 256u * DM * 2u; u.B = wmkv + (unsigned)pn * 256u * DM * 2u; }
        u.pm = pm; u.pn = pn; u.aux = 0; return true;
    }
};
struct SchedIn2 {
    unsigned hb, win, memn, wmkv; int G, c, pnx;
    __device__ __forceinline__ bool next(int i, Unit& u) const {
        const int L = c - (G - 64); if (i != 0 || L < 0) return false;
        if (L < 32) { u.kind = 0; u.pm = L; u.pn = pnx; u.A = hb + (unsigned)L * 256u * DM * 2u; u.B = win + (unsigned)pnx * 256u * DM * 2u; }
        else { const int t = L - 32; u.kind = 1; u.pm = t & 3; u.pn = t >> 2; u.A = memn + (unsigned)(t & 3) * 256u * DM * 2u; u.B = wmkv + (unsigned)(t >> 2) * 256u * DM * 2u; }
        u.aux = 0; return true;
    }
};
struct SchedUp {
    unsigned proj, wq, wkv; int G, c;
    __device__ __forceinline__ bool next(int i, Unit& u) const {
        constexpr int T0 = 32 * 6, TOT = T0 + 32 * 8; const int L = i * G + c; if (L >= TOT) return false;
        const int w = pg8::xcd_remap(L, TOT); int pm, pn;
        if (w < T0) { pg8::tile_decode(w, 32, 6, pm, pn); u.kind = 0; u.A = proj + ((unsigned)pm * 256u * DINP + PC_CQ) * 2u; u.B = wq + (unsigned)pn * 256u * 512u * 2u; }
        else { pg8::tile_decode(w - T0, 32, 8, pm, pn); u.kind = 1; u.A = proj + ((unsigned)pm * 256u * DINP + PC_CKV) * 2u; u.B = wkv + (unsigned)pn * 256u * 512u * 2u; }
        u.pm = pm; u.pn = pn; u.aux = 0; return true;
    }
};
struct SchedGate {
    unsigned y, wbr; int G, c;
    __device__ __forceinline__ bool next(int i, Unit& u) const {
        const int ti = i / 3, n = i - 3 * ti; const int L = ti * G + c; if (L >= 256) return false;
        int pm, pn; pg8::tile_decode(pg8::xcd_remap(L, 256), 32, 8, pm, pn);
        u.pm = pm; u.pn = pn; u.kind = n; u.aux = 0;
        u.A = y + ((unsigned)pm * 256u * 3072u + n * 1024u) * 2u; u.B = wbr + ((unsigned)n * 2048u + pn * 256u) * 1024u * 2u; return true;
    }
};
struct SchedMoe {
    unsigned A, B; const unsigned char* ws; int nrt, nN, G, c; unsigned a_tile, b_tile, b_exp;
    __device__ __forceinline__ bool next(int i, Unit& u) const {
        const int total = nrt * nN; const int L = i * G + c; if (L >= total) return false;
        int pm, pn; pg8::tile_decode(pg8::xcd_remap(L, total), nrt, nN, pm, pn);
        const int e = __builtin_amdgcn_readfirstlane(__hip_atomic_load((const int*)(ws + WS_TEXP) + pm, __ATOMIC_RELAXED, __HIP_MEMORY_SCOPE_AGENT));
        u.pm = pm; u.pn = pn; u.kind = e; u.aux = 0; u.A = A + (unsigned)pm * a_tile; u.B = B + (unsigned)e * b_exp + (unsigned)pn * b_tile; return true;
    }
};

struct SchedMoeTail {
    unsigned A, B; const unsigned char* ws; int nrt, G, c; unsigned a_tile, b_tile, b_exp, kq_bytes;
    __device__ __forceinline__ bool next(int i, Unit& u) const {
        const int total = (nrt - 64) * 8 * 4; const int L = i * G + c; if (L >= total) return false;
        const int kq = L & 3, tile = L >> 2, pm = 64 + (tile >> 3), pn = tile & 7;
        const int e = __builtin_amdgcn_readfirstlane(__hip_atomic_load((const int*)(ws + WS_TEXP) + pm, __ATOMIC_RELAXED, __HIP_MEMORY_SCOPE_AGENT));
        u.pm = pm; u.pn = pn; u.kind = e; u.aux = kq + 1; u.A = A + (unsigned)pm * a_tile + (unsigned)kq * kq_bytes; u.B = B + (unsigned)e * b_exp + (unsigned)pn * b_tile + (unsigned)kq * kq_bytes; return true;
    }
};

namespace att {
__device__ __forceinline__ int crow(int r, int hi) { return (r & 3) + 8 * (r >> 2) + 4 * hi; }
__device__ __forceinline__ int v_st(int k, int c) { const int kk = (k & ~0xC) | ((k & 4) << 1) | ((k & 8) >> 1); return ((kk >> 3) * 4 + (c >> 5)) * 512 + ((kk & 7) * 32 + (c & 31)) * 2; }
__device__ __forceinline__ int v_rd_base(int lane) { return ((lane & 3) << 3) | (((lane >> 2) & 3) << 6) | (((lane >> 4) & 1) << 5) | (((lane >> 5) & 1) << 8); }
constexpr int v_rd_off(int d0, int ks, int half) { return d0 * 512 + ks * 4096 + half * 2048; }
template <int OFF> __device__ __forceinline__ s16x4 tr_read(unsigned vb) {
    s16x4 r; asm volatile("ds_read_b64_tr_b16 %0, %1 offset:%2" : "=&v"(r) : "v"(vb), "i"(OFF) : "memory"); return r;
}
template <int D0> __device__ __forceinline__ void pv_one(f32x16& od, unsigned vb, bf16x8 pa0, bf16x8 pa1, bf16x8 pa2, bf16x8 pa3) {
    const s16x4 l0 = tr_read<v_rd_off(D0, 0, 0)>(vb), h0 = tr_read<v_rd_off(D0, 0, 1)>(vb), l1 = tr_read<v_rd_off(D0, 1, 0)>(vb), h1 = tr_read<v_rd_off(D0, 1, 1)>(vb);
    const s16x4 l2 = tr_read<v_rd_off(D0, 2, 0)>(vb), h2 = tr_read<v_rd_off(D0, 2, 1)>(vb), l3 = tr_read<v_rd_off(D0, 3, 0)>(vb), h3 = tr_read<v_rd_off(D0, 3, 1)>(vb);
    asm volatile("s_waitcnt lgkmcnt(0)" ::: "memory"); SBAR();
#define ATT_PK(L, H) (bf16x8){L[0], L[1], L[2], L[3], H[0], H[1], H[2], H[3]}
    od = __builtin_amdgcn_mfma_f32_32x32x16_bf16(pa0, ATT_PK(l0, h0), od, 0, 0, 0);
    od = __builtin_amdgcn_mfma_f32_32x32x16_bf16(pa1, ATT_PK(l1, h1), od, 0, 0, 0);
    od = __builtin_amdgcn_mfma_f32_32x32x16_bf16(pa2, ATT_PK(l2, h2), od, 0, 0, 0);
    od = __builtin_amdgcn_mfma_f32_32x32x16_bf16(pa3, ATT_PK(l3, h3), od, 0, 0, 0);
#undef ATT_PK
}

template <int DK, int K1DIM, bool CAUSAL>
__device__ __forceinline__ void attn_unit(LAS unsigned char* lds, const int tid, const bf16* __restrict__ Qb, int ldq, const bf16* __restrict__ K1, int ldk1, const bf16* __restrict__ K2, int ldk2,
                                          const bf16* __restrict__ Vp, int ldv, bf16* __restrict__ Ob, int ldo, int NT, int q0, float C) {
    constexpr int NKS = DK / 16, KROWB = DK * 2 + 16  , SHM_K = 64 * KROWB, SHM_V = 64 * 128 * 2;
    constexpr int NC1 = K1DIM / 8, NC2 = (DK - K1DIM) / 8, KC1 = NC1 / 8, KC2 = NC2 / 8;
    static_assert(NC2 == 0 || NC2 == 8, "K2 part is 0 or 64 wide");
    const int wid = tid >> 6, lane = tid & 63, r32 = lane & 31, hi = lane >> 5;
    LAS unsigned char* V_lds = lds; LAS unsigned char* K_lds = lds + 3 * SHM_V;
    LAS float* wsp = (LAS float*)(lds + 3 * SHM_V + 2 * SHM_K) + wid * 64;
    static_assert(3 * SHM_V + 2 * SHM_K + 8 * 64 * 4 <= RING_BYTES, "attention LDS");
    const bool grpB = wid >= 4; LAS float* li_l = wsp; LAS float* al_l = wsp + 32;
    float m_reg = -1e30f, l_reg = 0.f; f32x16 o[4] = {}; bf16x8 qr[NKS];
    { const bf16* Qw = Qb + (unsigned)((wid * 32 + r32) * ldq + hi * 8);
#pragma unroll
      for (int d0 = 0; d0 < NKS; ++d0) qr[d0] = *(const bf16x8*)(Qw + d0 * 16); }
    const int sr = tid >> 4, sc = (tid & 15) * 8, vst0 = v_st(sr, sc), vst1 = v_st(32 + sr, sc);
    const unsigned vb0 = (unsigned)(uintptr_t)V_lds + v_rd_base(lane);
    const unsigned voffv = (unsigned)(sr * ldv + sc);
    unsigned koff1[KC1], kw1[KC1];
#pragma unroll
    for (int i = 0; i < KC1; ++i) { const int c = tid + 512 * i, row = c / NC1, cc = (c % NC1) * 8; koff1[i] = (unsigned)(row * ldk1 + cc); kw1[i] = (unsigned)(row * KROWB + cc * 2); }
    const unsigned koff2 = (unsigned)((tid >> 3) * ldk2 + (tid & 7) * 8), kw2 = (unsigned)((tid >> 3) * KROWB + (K1DIM + (tid & 7) * 8) * 2);
    const unsigned kr0 = (unsigned)(r32 * KROWB + hi * 16);
    bf16x8 ks1[KC1], ks2, vs0, vs1;
#define ATT_SLOAD(k0) do { const bf16* kb_ = K1 + (size_t)(k0) * ldk1; _Pragma("unroll") for (int i_ = 0; i_ < KC1; ++i_) ks1[i_] = *(const bf16x8*)(kb_ + koff1[i_]); \
        if (KC2) { const bf16* k2_ = K2 + (size_t)(k0) * ldk2; ks2 = *(const bf16x8*)(k2_ + koff2); } \
        const bf16* vb_ = Vp + (size_t)(k0) * ldv; vs0 = *(const bf16x8*)(vb_ + voffv); vs1 = *(const bf16x8*)(vb_ + (size_t)32 * ldv + voffv); } while (0)
#define ATT_SWRITE(b, vbuf) do { _Pragma("unroll") for (int i_ = 0; i_ < KC1; ++i_) *(LAS bf16x8*)(K_lds + (b) * SHM_K + kw1[i_]) = ks1[i_]; \
        if (KC2) *(LAS bf16x8*)(K_lds + (b) * SHM_K + kw2) = ks2; \
        *(LAS bf16x8*)(V_lds + (vbuf) * SHM_V + vst0) = vs0; *(LAS bf16x8*)(V_lds + (vbuf) * SHM_V + vst1) = vs1; } while (0)
#define ATT_PV(vbuf) do { const unsigned vb = vb0 + (vbuf) * SHM_V; \
          pv_one<0>(o[0], vb, pa0, pa1, pa2, pa3); pv_one<1>(o[1], vb, pa0, pa1, pa2, pa3); pv_one<2>(o[2], vb, pa0, pa1, pa2, pa3); pv_one<3>(o[3], vb, pa0, pa1, pa2, pa3); } while (0)
    __syncthreads();
    ATT_SLOAD(0); ATT_SWRITE(0, 0); __syncthreads();
    bf16x8 pa0 = {}, pa1 = {}, pa2 = {}, pa3 = {};
    int vcur = 0, vprev = 0;
#pragma unroll 1
    for (int j = 0; j < NT; ++j) {
        const int bsel = j & 1;
        if (grpB && j > 0) ATT_PV(vprev);
        if (j + 1 < NT) ATT_SLOAD((j + 1) * 64);
        f32x16 p0 = {}, p1 = {};
        { const LAS unsigned char* Kb = K_lds + bsel * SHM_K + kr0;
#pragma unroll
          for (int d0 = 0; d0 < NKS; ++d0) {
            const bf16x8 b0 = *(const LAS bf16x8*)(Kb + d0 * 32);
            const bf16x8 b1 = *(const LAS bf16x8*)(Kb + 32 * KROWB + d0 * 32);
            p0 = __builtin_amdgcn_mfma_f32_32x32x16_bf16(b0, qr[d0], p0, 0, 0, 0);
            p1 = __builtin_amdgcn_mfma_f32_32x32x16_bf16(b1, qr[d0], p1, 0, 0, 0); } }
        if (CAUSAL && j >= NT - 4) {
            const int qpos = q0 + wid * 32 + r32, kb = j * 64;
#pragma unroll
            for (int r = 0; r < 16; ++r) { const int kp = kb + crow(r, hi); p0[r] = (kp <= qpos) ? p0[r] : -1e30f; p1[r] = (kp + 32 <= qpos) ? p1[r] : -1e30f; }
        }
        float pmax = p0[0];
#pragma unroll
        for (int r = 1; r < 16; ++r) pmax = fmaxf(pmax, p0[r]);
#pragma unroll
        for (int r = 0; r < 16; ++r) pmax = fmaxf(pmax, p1[r]);
        { auto rr = __builtin_amdgcn_permlane32_swap(__float_as_uint(pmax), __float_as_uint(pmax), false, false); pmax = fmaxf(__uint_as_float(rr[0]), __uint_as_float(rr[1])); }
        if (!__all(pmax <= m_reg)) {
            const float mn = fmaxf(m_reg, pmax), alpha = __builtin_amdgcn_exp2f((m_reg - mn) * C); m_reg = mn; l_reg *= alpha;
            if (hi == 0) al_l[r32] = alpha;
            asm volatile("s_waitcnt lgkmcnt(0)" ::: "memory");
#pragma unroll
            for (int r = 0; r < 16; ++r) { const float a = al_l[crow(r, hi)];
#pragma unroll
                for (int d = 0; d < 4; ++d) o[d][r] *= a; }
        }
        const float mnC = -m_reg * C; float ps = 0.f;
#pragma unroll
        for (int r = 0; r < 16; ++r) { p0[r] = __builtin_amdgcn_exp2f(fmaf(p0[r], C, mnC)); p1[r] = __builtin_amdgcn_exp2f(fmaf(p1[r], C, mnC)); ps += p0[r] + p1[r]; }
        { auto rr = __builtin_amdgcn_permlane32_swap(__float_as_uint(ps), __float_as_uint(ps), false, false); ps = __uint_as_float(rr[0]) + __uint_as_float(rr[1]); }
        l_reg += ps;
#define ATT_PK4(P, BASE, OUT) do { unsigned a0 = cvt_pk_bf16(P[BASE + 0], P[BASE + 1]), a1 = cvt_pk_bf16(P[BASE + 2], P[BASE + 3]); \
        unsigned b0_ = cvt_pk_bf16(P[BASE + 4], P[BASE + 5]), b1_ = cvt_pk_bf16(P[BASE + 6], P[BASE + 7]); \
        auto r0_ = __builtin_amdgcn_permlane32_swap(a0, b0_, false, false); auto r1_ = __builtin_amdgcn_permlane32_swap(a1, b1_, false, false); \
        u32x4 w_ = {r0_[0], r1_[0], r0_[1], r1_[1]}; OUT = *reinterpret_cast<bf16x8*>(&w_); } while (0)
        ATT_PK4(p0, 0, pa0); ATT_PK4(p0, 8, pa1); ATT_PK4(p1, 0, pa2); ATT_PK4(p1, 8, pa3);
#undef ATT_PK4
        if (!grpB) ATT_PV(vcur);
        const int vnext = vcur == 2 ? 0 : vcur + 1;
        if (j + 1 < NT) ATT_SWRITE(bsel ^ 1, vnext);
        vprev = vcur; vcur = vnext;
        __syncthreads();
    }
    if (grpB) ATT_PV(vprev);
    if (hi == 0) li_l[r32] = l_reg;
    asm volatile("s_waitcnt lgkmcnt(0)" ::: "memory");
    int ldo_o = ldo, hi_o = hi; asm volatile("" : "+v"(hi_o), "+s"(ldo_o));
    bf16* Ow = Ob + (unsigned)((wid * 32) * ldo_o + r32);
#pragma unroll
    for (int r = 0; r < 16; ++r) { const int orow = crow(r, hi_o); const float rl = __builtin_amdgcn_rcpf(li_l[orow]);
        bf16* op = Ow + (unsigned)(orow * ldo_o);
#pragma unroll
        for (int d0 = 0; d0 < 4; ++d0) op[d0 * 32] = f2bf(o[d0][r] * rl); }
#undef ATT_SLOAD
#undef ATT_SWRITE
#undef ATT_PV
}
}

namespace hg {
__device__ __forceinline__ int crow(int r, int hi) { return (r & 3) + 8 * (r >> 2) + 4 * hi; }
__device__ __forceinline__ void mma32(f32x16& acc, const LAS bf16* A, int lda, const LAS bf16* Bt, int ldb, int K, int r32, int hi) {
    for (int k0 = 0; k0 < K; k0 += 16) {
        const bf16x8 a = *(const LAS bf16x8*)(A + r32 * lda + k0 + hi * 8);
        const bf16x8 b = *(const LAS bf16x8*)(Bt + r32 * ldb + k0 + hi * 8);
        acc = __builtin_amdgcn_mfma_f32_32x32x16_bf16(a, b, acc, 0, 0, 0);
    }
}
constexpr int LD_D = 136, LD_S = 72, LD_O = 132;
constexpr int L_TOT = 0;
constexpr int L_VT = 2048;
constexpr int L_KT = L_VT + 128 * LD_S * 2;
constexpr int L_QT = L_KT + 128 * LD_S * 2;
constexpr int L_QH = L_QT + 64 * LD_D * 2;
constexpr int L_P = L_QH + 64 * LD_D * 2;
constexpr int L_O = L_P + 64 * LD_S * 2;
constexpr int L_END = L_O + 64 * LD_O * 4;
static_assert(L_END <= RING_BYTES, "hgrn LDS");

__device__ __forceinline__ void gate_scan(LAS unsigned char* lds, const float (&z)[16], float lb, int d, int jq, float (&kk)[16], float (&bl)[16], float& bref, float& b63) {
    LAS float* tot = (LAS float*)(lds + L_TOT);
    float run = 0.f;
#pragma unroll
    for (int i = 0; i < 16; ++i) {
        const float f = lb + (1.0f - lb) * HG_SIGMOID(z[i]);
        run += __logf(fmaxf(f, 1e-20f)); bl[i] = run; kk[i] = 1.0f - f;
    }
    tot[jq * 128 + d] = run;
    __syncthreads();
    const float t0 = tot[d], t1 = tot[128 + d], t2 = tot[256 + d], t3 = tot[384 + d];
    const float off = (jq > 0 ? t0 : 0.f) + (jq > 1 ? t1 : 0.f) + (jq > 2 ? t2 : 0.f);
#pragma unroll
    for (int i = 0; i < 16; ++i) bl[i] += off;
    bref = t0 + t1; b63 = (t0 + t1) + (t2 + t3);
}
__device__ __forceinline__ void stage_vt(LAS unsigned char* lds, const bf16x8 (&vch)[2], int tid) {
    LAS bf16* VT = (LAS bf16*)(lds + L_VT);
#pragma unroll
    for (int i = 0; i < 2; ++i) { const int id = tid + 512 * i, s = id >> 4, e8 = (id & 15) * 8;
#pragma unroll
        for (int q = 0; q < 8; ++q) VT[(e8 + q) * LD_S + s] = (bf16)vch[i][q]; }
}
__device__ __forceinline__ void pass1_unit(LAS unsigned char* lds, const int tid, int unit, const float* zf, const bf16* proj, const float* lbv, float* hu, float* hdec) {
    const int wid = tid >> 6, lane = tid & 63, r32 = lane & 31, hi = lane >> 5;
    const int bh = unit >> 5, c = unit & 31, b = bh >> 3, hh = bh & 7, tok0 = b * SEQ + c * CHUNK;
    const int d = tid & 127, jq = tid >> 7;
    float z[16], kk[16], bl[16], bref, b63; bf16x8 vch[2];
    const float lb = lbv[hh * 128 + d];
#pragma unroll
    for (int i = 0; i < 16; ++i) z[i] = zf[(size_t)(tok0 + jq * 16 + i) * 1024 + hh * 128 + d];
#pragma unroll
    for (int i = 0; i < 2; ++i) { const int id = tid + 512 * i, s = id >> 4, e8 = (id & 15) * 8; vch[i] = *(const bf16x8*)(proj + (size_t)(tok0 + s) * DINP + PC_I + hh * 128 + e8); }
    __syncthreads();
    gate_scan(lds, z, lb, d, jq, kk, bl, bref, b63);
    LAS bf16* KT = (LAS bf16*)(lds + L_KT);
#pragma unroll
    for (int i = 0; i < 16; ++i) KT[d * LD_S + jq * 16 + i] = f2bf(kk[i] * __expf(b63 - bl[i]));
    stage_vt(lds, vch, tid);
    if (jq == 0) hdec[(size_t)unit * 128 + d] = __expf(b63);
    __syncthreads();
    const LAS bf16* VT = (const LAS bf16*)(lds + L_VT);
    const int eb = wid >> 1;
#pragma unroll
    for (int q = 0; q < 2; ++q) { const int db = (wid & 1) * 2 + q; f32x16 acc = {};
        mma32(acc, VT + eb * 32 * LD_S, LD_S, KT + db * 32 * LD_S, LD_S, 64, r32, hi);
#pragma unroll
        for (int r = 0; r < 16; ++r) hu[(size_t)unit * 16384 + (size_t)(eb * 32 + crow(r, hi)) * 128 + db * 32 + r32] = acc[r]; }
}
__device__ __forceinline__ void pass2_task(int task, const float* hu, const float* hdec, bf16* hs) {
    const int bh = task >> 12, g = task & 4095, d4 = (g & 31) * 4;
    f32x4 st = {0.f, 0.f, 0.f, 0.f};
    const float* p = hu + (size_t)bh * 32 * 16384 + (size_t)g * 4;
    bf16* q = hs + (size_t)bh * 32 * 16384 + (size_t)g * 4;
    const float* dp = hdec + (size_t)bh * 32 * 128 + d4;
#pragma unroll 8
    for (int c = 0; c < 32; ++c) { const f32x4 u = *(const f32x4*)(p + (size_t)c * 16384); const f32x4 dv = *(const f32x4*)(dp + c * 128);
        u32x2 o; o.x = cvt_pk_bf16(st[0], st[1]); o.y = cvt_pk_bf16(st[2], st[3]); *(u32x2*)(q + (size_t)c * 16384) = o; st = dv * st + u; }
}
struct P3In { float z[16]; bf16 qraw[16]; bf16x8 vch[2]; float lb; };
__device__ __forceinline__ void pass3_load(P3In& R, const int tid, int unit, const float* zf, const bf16* proj, const float* lbv, const bf16* hs) {
    const int bh = unit >> 5, c = unit & 31, b = bh >> 3, hh = bh & 7, tok0 = b * SEQ + c * CHUNK;
    const unsigned d = tid & 127, jq = tid >> 7;
    const float* zb = zf + (size_t)tok0 * 1024 + hh * 128; const unsigned zo = jq * 16u * 1024u + d;
    const bf16* qb = proj + (size_t)tok0 * DINP + PC_Q + hh * 128; const unsigned qo = jq * 16u * (unsigned)DINP + d;
    const bf16* vb = proj + (size_t)tok0 * DINP + PC_I + hh * 128; const unsigned vo = ((unsigned)tid >> 4) * (unsigned)DINP + ((unsigned)tid & 15u) * 8u;
    R.lb = (lbv + hh * 128)[d];
#pragma unroll
    for (int i = 0; i < 16; ++i) R.z[i] = (zb + i * 1024)[zo];
#pragma unroll
    for (int i = 0; i < 16; ++i) R.qraw[i] = (qb + i * DINP)[qo];
#pragma unroll
    for (int i = 0; i < 2; ++i) R.vch[i] = *(const bf16x8*)((vb + 32 * i * DINP) + vo);
}
__device__ __forceinline__ void pass3_compute(LAS unsigned char* lds, const int tid, int unit, P3In& R, int next_unit, const float* zf, const bf16* proj, const float* lbv, const bf16* hs, const float* hgn, bf16* y) {
    const int wid = tid >> 6, lane = tid & 63, r32 = lane & 31, hi = lane >> 5;
    const int bh = unit >> 5, c = unit & 31, b = bh >> 3, hh = bh & 7, tok0 = b * SEQ + c * CHUNK;
    const int d = tid & 127, jq = tid >> 7;
    const int tb = wid >> 2, eb = wid & 3;
    const int tn = tid >> 3, part = tid & 7;
    float kk[16], bl[16], bref, b63;
    const float (&z)[16] = R.z; const bf16 (&qraw)[16] = R.qraw; const bf16x8 (&vch)[2] = R.vch; const float lb = R.lb;
    bf16x8 st[8]; u32x4 g0, g1;
    { const bf16* sp = hs + (size_t)unit * 16384 + (size_t)(eb * 32 + r32) * 128 + hi * 8;
#pragma unroll
      for (int k = 0; k < 8; ++k) st[k] = *(const bf16x8*)(sp + 16 * k); }
    { const bf16* gp = proj + (size_t)(tok0 + tn) * DINP + PC_G + hh * 128 + part * 16; g0 = *(const u32x4*)gp; g1 = *(const u32x4*)(gp + 8); }
    __syncthreads();
    gate_scan(lds, z, lb, d, jq, kk, bl, bref, b63);
    LAS bf16* KT = (LAS bf16*)(lds + L_KT); LAS bf16* QT = (LAS bf16*)(lds + L_QT); LAS bf16* QH = (LAS bf16*)(lds + L_QH);
    const float eref = __expf(bref);
#pragma unroll
    for (int i = 0; i < 16; ++i) { const int t = jq * 16 + i;
        const float qv = bf2f(qraw[i]), er = __expf(bl[i] - bref);
        QT[t * LD_D + d] = f2bf(qv * er);
        QH[t * LD_D + d] = f2bf(qv * (er * eref));
        KT[t * LD_D + d] = f2bf(kk[i] * __builtin_amdgcn_rcpf(er)); }
    stage_vt(lds, vch, tid);
    if (next_unit >= 0) pass3_load(R, tid, next_unit, zf, proj, lbv, hs);
    __syncthreads();
    LAS bf16* PL = (LAS bf16*)(lds + L_P);
    if (wid < 4) {
        const int tb2 = wid >> 1, sb = wid & 1; f32x16 acc = {};
        if (!(tb2 == 0 && sb == 1)) mma32(acc, QT + tb2 * 32 * LD_D, LD_D, KT + sb * 32 * LD_D, LD_D, 128, r32, hi);
#pragma unroll
        for (int r = 0; r < 16; ++r) { const int t = tb2 * 32 + crow(r, hi), s2 = sb * 32 + r32; PL[t * LD_S + s2] = f2bf(s2 <= t ? acc[r] : 0.f); }
    }
    __syncthreads();
    {
        f32x16 acc = {};
        mma32(acc, PL + tb * 32 * LD_S, LD_S, (const LAS bf16*)(lds + L_VT) + eb * 32 * LD_S, LD_S, 64, r32, hi);
#pragma unroll
        for (int k = 0; k < 8; ++k) {
            const bf16x8 a = *(const LAS bf16x8*)(QH + (tb * 32 + r32) * LD_D + 16 * k + hi * 8);
            acc = __builtin_amdgcn_mfma_f32_32x32x16_bf16(a, st[k], acc, 0, 0, 0);
        }
        LAS float* OL = (LAS float*)(lds + L_O);
#pragma unroll
        for (int r = 0; r < 16; ++r) OL[(tb * 32 + crow(r, hi)) * LD_O + eb * 32 + r32] = acc[r];
    }
    __syncthreads();
    {
        const LAS float* orow = (const LAS float*)(lds + L_O) + tn * LD_O + part * 16;
        float v[16]; float ss = 0.f;
#pragma unroll
        for (int i = 0; i < 16; ++i) { v[i] = orow[i]; ss += v[i] * v[i]; }
        ss += shflx(ss, 1, lane); ss += shflx(ss, 2, lane); ss += shflx(ss, 4, lane);
        const float rs = rsqrtf(ss * (1.0f / 128.0f) + EPS);
        const unsigned gw[8] = {g0.x, g0.y, g0.z, g0.w, g1.x, g1.y, g1.z, g1.w};
        float ov[16];
#pragma unroll
        for (int i = 0; i < 8; ++i) { const float ga = bflo(gw[i]), gb = bfhi(gw[i]);
            ov[2 * i] = v[2 * i] * rs * hgn[part * 16 + 2 * i] * (ga * HG_SIGMOID(ga));
            ov[2 * i + 1] = v[2 * i + 1] * rs * hgn[part * 16 + 2 * i + 1] * (gb * HG_SIGMOID(gb)); }
        bf16* yp = y + (size_t)(tok0 + tn) * 3072 + hh * 128 + part * 16;
        u32x4 w0, w1;
        w0.x = cvt_pk_bf16(ov[0], ov[1]); w0.y = cvt_pk_bf16(ov[2], ov[3]); w0.z = cvt_pk_bf16(ov[4], ov[5]); w0.w = cvt_pk_bf16(ov[6], ov[7]);
        w1.x = cvt_pk_bf16(ov[8], ov[9]); w1.y = cvt_pk_bf16(ov[10], ov[11]); w1.z = cvt_pk_bf16(ov[12], ov[13]); w1.w = cvt_pk_bf16(ov[14], ov[15]);
        *(u32x4*)yp = w0; *(u32x4*)(yp + 8) = w1;
    }
}
__device__ __forceinline__ void pass3_unit(LAS unsigned char* lds, const int tid, int unit, const float* zf, const bf16* proj, const float* lbv, const bf16* hs, const float* hgn, bf16* y) {
    P3In R; pass3_load(R, tid, unit, zf, proj, lbv, hs); pass3_compute(lds, tid, unit, R, -1, zf, proj, lbv, hs, hgn, y);
}
}

struct TDesc { const float* src; bf16* dst; const float* gain; size_t sstride, dstride; int gstride, nbatch, K, ld, Ndst, map; float f8scale; };
enum { MAP_ID = 0, MAP_WIN = 1, MAP_QUP = 2, MAP_GU_D = 3, MAP_GU_E = 4, MAP_GATE = 5, MAP_WIN4K = 6, MAP_WIN6K = 7 };
__device__ __forceinline__ int src_col(int map, int n) {
    switch (map) {
    case MAP_WIN6K: n += 2048; [[fallthrough]];
    case MAP_WIN4K: n += 4096; [[fallthrough]];
    case MAP_WIN:
        if (n < PC_KR) return n;
        if (n < PC_KR + 64) { const int p = n - PC_KR; return 5120 + (p & 1) * 32 + (p >> 1); }
        if (n < PC_QM) return -1;
        return n - 192;
    case MAP_QUP: { const int hd = n / QKD, c = n % QKD; if (c < NOPE) return n; const int p = c - NOPE; return hd * QKD + NOPE + (p & 1) * 32 + (p >> 1); }
    case MAP_GU_D: { const int t = n >> 8, r = n & 255; return r < 128 ? 128 * t + r : FF + 128 * t + (r - 128); }
    case MAP_GATE: return n + 6208;
    case MAP_GU_E: { const int t = n >> 8, r = n & 255; return r < 128 ? 128 * t + r : FFE + 128 * t + (r - 128); }
    default: return n;
    }
}
__device__ __forceinline__ void transpose_item(const TDesc& D, int item, LAS float* scr, int lane) {
    const int nblk = D.Ndst / 32, per = (D.K / 64) * nblk, bt = item / per, r = item % per, kb = r / nblk, nb = r % nblk, k0 = 64 * kb, n0 = 32 * nb;
    const float* W = D.src + (size_t)bt * D.sstride; bf16* WT = D.dst + (size_t)bt * D.dstride; const float* gn = D.gain ? D.gain + (size_t)bt * D.gstride : nullptr;
    const int sc = src_col(D.map, n0 + (lane & 31));
    const float msk = sc < 0 ? 0.f : 1.f;
    const float* wp = W + (size_t)(k0 + (lane >> 5)) * D.ld + (sc < 0 ? 0 : sc);
    float v[32];
#pragma unroll
    for (int i = 0; i < 32; ++i) v[i] = __builtin_nontemporal_load(wp + (size_t)(2 * i) * D.ld);
#pragma unroll
    for (int i = 0; i < 32; ++i) scr[(2 * i + (lane >> 5)) * 33 + (lane & 31)] = v[i] * msk;
    LDS_WAIT(); asm volatile("" ::: "memory");
    const int c = lane & 7;
    f32x4 g0 = {1.f, 1.f, 1.f, 1.f}, g1 = g0;
    if (gn) { g0 = *(const f32x4*)(gn + k0 + 8 * c); g1 = *(const f32x4*)(gn + k0 + 8 * c + 4); }
    if (D.f8scale != 0.f) {
        g0 = g0 * D.f8scale; g1 = g1 * D.f8scale; unsigned char* W8 = (unsigned char*)D.dst + (size_t)bt * D.dstride;
#pragma unroll
        for (int j = 0; j < 4; ++j) { const int n = (lane >> 3) + 8 * j; const LAS float* s = scr + (8 * c) * 33 + n;
            const f32x4 a = {s[0 * 33] * g0[0], s[1 * 33] * g0[1], s[2 * 33] * g0[2], s[3 * 33] * g0[3]}, b = {s[4 * 33] * g1[0], s[5 * 33] * g1[1], s[6 * 33] * g1[2], s[7 * 33] * g1[3]};
            *(u32x2*)(W8 + (size_t)(n0 + n) * D.K + k0 + 8 * c) = pack8_f8(a, b); }
    } else {
#pragma unroll
    for (int j = 0; j < 4; ++j) { const int n = (lane >> 3) + 8 * j; const LAS float* s = scr + (8 * c) * 33 + n;
        u32x4 o; o.x = cvt_pk_bf16(s[0 * 33] * g0[0], s[1 * 33] * g0[1]); o.y = cvt_pk_bf16(s[2 * 33] * g0[2], s[3 * 33] * g0[3]);
        o.z = cvt_pk_bf16(s[4 * 33] * g1[0], s[5 * 33] * g1[1]); o.w = cvt_pk_bf16(s[6 * 33] * g1[2], s[7 * 33] * g1[3]);
        *(u32x4*)(WT + (size_t)(n0 + n) * D.K + k0 + 8 * c) = o; }
    }
    LDS_WAIT(); asm volatile("" ::: "memory");
}
constexpr int TL_LD = 260, TL_K = 128, TL_RW = TL_K / 8;
__device__ __forceinline__ void tl_decode(const TDesc& D, int tile, int& bt, int& k0, int& n0) {
    const int nblk = D.Ndst / 256, per = (D.K / TL_K) * nblk; bt = tile / per; const int r = tile % per; k0 = TL_K * (r / nblk); n0 = 256 * (r % nblk);
}
__device__ __forceinline__ void tl_load(const TDesc& D, int tile, f32x4 (&v)[TL_RW], int wave, int lane) {
    int bt, k0, n0; tl_decode(D, tile, bt, k0, n0);
    const int sc = src_col(D.map, n0 + 4 * lane);
    const float* wp = D.src + (size_t)bt * D.sstride + (size_t)(k0 + wave * TL_RW) * D.ld + sc;
#pragma unroll
    for (int i = 0; i < TL_RW; ++i) v[i] = __builtin_nontemporal_load((const f32x4*)(wp + (size_t)i * D.ld));
}
__device__ __forceinline__ void tl_store(const TDesc& D, int tile, const f32x4 (&v)[TL_RW], LAS float* scr, int tid, int wave, int lane) {
    int bt, k0, n0; tl_decode(D, tile, bt, k0, n0);
#pragma unroll
    for (int i = 0; i < TL_RW; ++i) *(LAS f32x4*)(scr + (wave * TL_RW + i) * TL_LD + 4 * lane) = v[i];
    __syncthreads();
    constexpr int HK = TL_K / 2;
    const int n = tid >> 1, h = tid & 1; const LAS float* s = scr + (HK * h) * TL_LD + n;
    const float* gn = D.gain ? D.gain + (size_t)bt * D.gstride + k0 + HK * h : nullptr;
    const float sc = D.f8scale != 0.f ? D.f8scale : 1.0f;
#pragma unroll
    for (int p = 0; p < HK / 16; ++p) {
        f32x4 x[4];
#pragma unroll
        for (int q = 0; q < 4; ++q) { f32x4 g = {sc, sc, sc, sc}; if (gn) g = g * *(const f32x4*)(gn + 16 * p + 4 * q);
            const LAS float* sq = s + (16 * p + 4 * q) * TL_LD;
            x[q] = (f32x4){sq[0] * g[0], sq[TL_LD] * g[1], sq[2 * TL_LD] * g[2], sq[3 * TL_LD] * g[3]}; }
        if (D.f8scale != 0.f) {
            unsigned char* W8 = (unsigned char*)D.dst + (size_t)bt * D.dstride + (size_t)(n0 + n) * D.K + k0 + HK * h + 16 * p;
            const u32x2 a = pack8_f8(x[0], x[1]), b = pack8_f8(x[2], x[3]);
            *(u32x4*)W8 = (u32x4){a.x, a.y, b.x, b.y};
        } else {
            bf16* WT = D.dst + (size_t)bt * D.dstride + (size_t)(n0 + n) * D.K + k0 + HK * h + 16 * p;
            *(u32x4*)WT = pack8(x[0], x[1]); *(u32x4*)(WT + 8) = pack8(x[2], x[3]);
        }
    }
    __syncthreads();
}
__device__ __forceinline__ float row_to_bf16(const float* xrow, bf16* orow, const float* gain, bool normalize, int lane, unsigned char* o8 = nullptr) {
    f32x4 v[8]; float s = 0.f;
#pragma unroll
    for (int j = 0; j < 8; ++j) { v[j] = *(const f32x4*)(xrow + 4 * lane + 256 * j); s += (v[j][0] * v[j][0] + v[j][1] * v[j][1]) + (v[j][2] * v[j][2] + v[j][3] * v[j][3]); }
    s = wave_sum(s, lane);
    const float rs = normalize ? rsqrtf(s * (1.0f / DM) + EPS) : 1.0f;
#pragma unroll
    for (int j = 0; j < 8; ++j) { f32x4 w = v[j] * rs; if (gain) w = w * *(const f32x4*)(gain + 4 * lane + 256 * j);
        u32x2 o; o.x = cvt_pk_bf16(w[0], w[1]); o.y = cvt_pk_bf16(w[2], w[3]); *(u32x2*)(orow + 4 * lane + 256 * j) = o;
        if (o8) { const f32x4 z = w * F8_H; int q = 0; q = __builtin_amdgcn_cvt_pk_fp8_f32(clamp448(z[0]), clamp448(z[1]), q, false); q = __builtin_amdgcn_cvt_pk_fp8_f32(clamp448(z[2]), clamp448(z[3]), q, true); *(int*)(o8 + 4 * lane + 256 * j) = q; } }
    return s;
}

struct Args { const void* in[22]; float* out; unsigned char* ws; int ph_lo, ph_hi; };
static_assert(sizeof(Args) == 200 && offsetof(Args, out) == 176 && offsetof(Args, ws) == 184, "Args layout");
constexpr int PH_FINAL = 19, N_PHASES = 20;

__global__ void __launch_bounds__(NTHR, 2) trunk_fwd(Args args) {
    extern __shared__ __attribute__((aligned(16))) unsigned char lds_raw[];
    LAS unsigned char* lds = (LAS unsigned char*)lds_raw;
    const int wave0 = __builtin_amdgcn_readfirstlane((int)threadIdx.x >> 6);
#define PHASE_IDS int tid = wave0 * 64 + lane_id(); const CAS char* kargs = (const CAS char*)__builtin_amdgcn_kernarg_segment_ptr(); asm volatile("" : "+s"(kargs)); \
    GAS unsigned char* wsg = *(GAS unsigned char* const CAS*)(kargs + 184); int G = gridDim.x, bx = blockIdx.x; asm volatile("" : "+v"(tid), "+s"(wsg), "+s"(G), "+s"(bx)); unsigned char* wsl = (unsigned char*)wsg; const int lane = tid & 63, wave = __builtin_amdgcn_readfirstlane(tid >> 6); (void)lane; (void)wave
    unsigned* ctl = (unsigned*)(args.ws + WS_CTL);
    XcdBarrier bar; bar.bar = ctl + CW_BAR; bar.x = 0; bar.st = nullptr; bar.nloc = 0u; bar.nx = 0u;
    const int lo = args.ph_lo, hi = args.ph_hi;
    const bool multi = (hi - lo) > 1;
    if (multi) bar = xcd_barrier_post(ctl + CW_BAR, nullptr, wave0 * 64 + lane_id());
#define IN(k) (lo <= (k) && (k) < hi && ((k) <= MK_LAST_PHASE || (k) == PH_FINAL))
#ifndef MK_KIND_MASK
#define MK_KIND_MASK 0xFFFFFFFFu
#endif
#define KIND(k) ((MK_KIND_MASK >> (k)) & 1u)
#ifndef MK_PROBE_MFMA
#define MK_PROBE_MFMA 0
#endif
#ifndef MK_REPEAT_MASK
#define MK_REPEAT_MASK (MK_PROBE_MODE >= 0 ? (1u << 7) : 0u)
#endif
#define NREP(k) (((MK_REPEAT_MASK >> (k)) & 1u) ? 2 : 1)
#define SEAM(k) do { if (IN(k) && (k) + 1 < hi) xcd_barrier(bar, wave0 * 64 + lane_id()); } while (0)

#define X_IN ((const float*)(*(const GAS float* const CAS*)(kargs + 0)))
#define MEM_IN ((const float*)(*(const GAS float* const CAS*)(kargs + 8)))
#define positions ((const int*)(*(const GAS int* const CAS*)(kargs + 16)))
#define hg_lb ((const float*)(*(const GAS float* const CAS*)(kargs + 24)))
#define attn_norm ((const float*)(*(const GAS float* const CAS*)(kargs + 32)))
#define w_in ((const float*)(*(const GAS float* const CAS*)(kargs + 40)))
#define hg_norm ((const float*)(*(const GAS float* const CAS*)(kargs + 48)))
#define mla_q_norm ((const float*)(*(const GAS float* const CAS*)(kargs + 56)))
#define w_q_up ((const float*)(*(const GAS float* const CAS*)(kargs + 64)))
#define mla_kv_norm ((const float*)(*(const GAS float* const CAS*)(kargs + 72)))
#define w_kv_up ((const float*)(*(const GAS float* const CAS*)(kargs + 80)))
#define mem_norm ((const float*)(*(const GAS float* const CAS*)(kargs + 88)))
#define w_mem_kv ((const float*)(*(const GAS float* const CAS*)(kargs + 96)))
#define w_branch ((const float*)(*(const GAS float* const CAS*)(kargs + 104)))
#define w_o ((const float*)(*(const GAS float* const CAS*)(kargs + 112)))
#define ffn_norm ((const float*)(*(const GAS float* const CAS*)(kargs + 120)))
#define w_dense_gu ((const float*)(*(const GAS float* const CAS*)(kargs + 128)))
#define w_dense_down ((const float*)(*(const GAS float* const CAS*)(kargs + 136)))
#define w_router ((const float*)(*(const GAS float* const CAS*)(kargs + 144)))
#define w_expert_gu ((const float*)(*(const GAS float* const CAS*)(kargs + 152)))
#define w_expert_down ((const float*)(*(const GAS float* const CAS*)(kargs + 160)))
#define final_norm ((const float*)(*(const GAS float* const CAS*)(kargs + 168)))
#define RSRC wsl
#define WIN ((bf16*)(wsl + WS_WIN))
#define WMKV ((bf16*)(wsl + WS_WMKV))
#define WQUP ((bf16*)(wsl + WS_WQUP))
#define WKVUP ((bf16*)(wsl + WS_WKVUP))
#define WBR ((bf16*)(wsl + WS_WBR))
#define WO ((bf16*)(wsl + WS_WO))
#define WGU ((bf16*)(wsl + WS_WGU))
#define WDN ((bf16*)(wsl + WS_WDN))
#define WEGU ((bf16*)(wsl + WS_WEGU))
#define WEDN ((bf16*)(wsl + WS_WEDN))
#define H ((float*)(wsl + WS_H))
#define HB ((bf16*)(wsl + WS_HB))
#define PROJ ((bf16*)(wsl + WS_PROJ))
#define ZF ((float*)(wsl + WS_ZF))
#define MEMN ((bf16*)(wsl + WS_MEMN))
#define MKV ((bf16*)(wsl + WS_MKV))
#define QMLA ((bf16*)(wsl + WS_QMLA))
#define KVB ((bf16*)(wsl + WS_KVB))
#define Y ((bf16*)(wsl + WS_Y))
#define HU ((float*)(wsl + WS_HU))
#define HDEC ((float*)(wsl + WS_HDEC))
#define MRG ((float*)(wsl + WS_MRG))
#define MRGB ((bf16*)(wsl + WS_MRGB))
#define ACT ((bf16*)(wsl + WS_ACT))
#define XS ((bf16*)(wsl + WS_XS))
#define ACTE ((bf16*)(wsl + WS_ACTE))
#define YS ((float*)(wsl + WS_YS))
#define COS ((float*)(wsl + WS_COS))
#define SIN ((float*)(wsl + WS_SIN))
#define LB ((float*)(wsl + WS_LB))
#define SSQA0 ((u64*)(wsl + WS_SSQA0))
#define TOPI ((int*)(wsl + WS_TOPI))
#define TOPW ((float*)(wsl + WS_TOPW))
#define RASS ((int*)(wsl + WS_RASS))
#define TEXP ((int*)(wsl + WS_TEXP))
#define SSQ ((u64*)(wsl + CB_SSQ))
#define BLKCNT ((int*)(wsl + CB_BLKCNT))

    if (KIND(0) && IN(0)) for (int rep = 0; rep < NREP(0); ++rep) { PHASE_IDS;
        LAS float* scr = (LAS float*)(lds + wave * 16384);
        const int gw = bx * NWAVES + wave, NGW = G * NWAVES;
#define TDESC(i) ((i) == 0 ? TDesc{w_in, WIN, attn_norm, (size_t)DM * DIN, (size_t)DINP * DM, DM, 2, DM, DIN, MK_GATE_F8 ? (MK_LAT_F8 ? 4096 : 6400) : DINP, MAP_WIN, 0.f} : \
                  (i) == 1 ? TDesc{w_mem_kv, WMKV, nullptr, (size_t)DM * 2048, (size_t)2048 * DM, 0, 2, DM, 2048, 2048, MAP_ID, 0.f} : \
                  (i) == 2 ? TDesc{w_q_up, WQUP, mla_q_norm, (size_t)512 * 1536, (size_t)1536 * 512, 512, 2, 512, 1536, 1536, MAP_QUP, 0.f} : \
                  (i) == 3 ? TDesc{w_kv_up, WKVUP, mla_kv_norm, (size_t)512 * 2048, (size_t)2048 * 512, 512, 2, 512, 2048, 2048, MAP_ID, 0.f} : \
                  (i) == 4 ? TDesc{w_branch, WBR, nullptr, (size_t)1024 * 2048, (size_t)2048 * 1024, 0, 6, 1024, 2048, 2048, MAP_ID, 0.f} : \
                  (i) == 5 ? TDesc{w_o, WO, nullptr, (size_t)DM * DM, (size_t)DM * DM, 0, 2, DM, DM, DM, MAP_ID, 0.f} : \
                  (i) == 6 ? TDesc{w_dense_gu, WGU, ffn_norm, 0, 0, 0, 1, DM, 2 * FF, 2 * FF, MAP_GU_D, MK_P7_F8 ? F8_WGU : 0.f} : \
                  (i) == 7 ? TDesc{w_dense_down, WDN, nullptr, 0, 0, 0, 1, FF, DM, DM, MAP_ID, MK_P8_F8 ? F8_WDN : 0.f} : \
                  (i) == 8 ? TDesc{w_expert_gu, WEGU, ffn_norm + DM, (size_t)DM * 2 * FFE, (size_t)2 * FFE * DM, 0, 8, DM, 2 * FFE, 2 * FFE, MAP_GU_E, MK_MOE_F8 ? F8_WGU : 0.f} : \
                             TDesc{w_expert_down, WEDN, nullptr, (size_t)FFE * DM, (size_t)DM * FFE, 0, 8, FFE, DM, DM, MAP_ID, MK_MOE_F8 ? F8_WDN : 0.f})
        constexpr int F8K = 64;
        constexpr int cnt[10] = {2 * (DM / 64) * ((MK_GATE_F8 ? (MK_LAT_F8 ? 4096 : 6400) : DINP) / 32), 2 * (DM / 64) * (2048 / 32), 2 * (512 / 64) * (1536 / 32), 2 * (512 / 64) * (2048 / 32), 6 * (1024 / 64) * (2048 / 32), 2 * (DM / 64) * (DM / 32),
                                 (DM / 64) * (2 * FF / 32), (FF / 64) * (DM / 32), 8 * (DM / F8K) * (2 * FFE / 32), 8 * (FFE / F8K) * (DM / 32)};
        int total = 0;
#pragma unroll
        for (int i = 0; i < 8; ++i) total += cnt[i];
        for (int it = gw; it < total; it += NGW) {
            int r = it;
#pragma unroll
            for (int i = 0; i < 8; ++i) { if (r >= 0 && r < cnt[i]) { const TDesc D = TDESC(i); transpose_item(D, r, scr, lane); r = -1; } else if (r >= 0) r -= cnt[i]; }
        }
        if (MK_LAT_F8) { const TDesc DL = TDesc{w_in, (bf16*)(wsl + WS_WIN8 + (size_t)6144 * DM), attn_norm, (size_t)DM * DIN, (size_t)WIN8_ROWS * DM, DM, 2, DM, DIN, 2048, MAP_WIN4K, F8_WIN};
            for (int it = gw; it < 2 * (DM / 64) * (2048 / 32); it += NGW) transpose_item(DL, it, scr, lane);
            const TDesc D24 = TDesc{w_in, WIN + (size_t)6144 * DM, attn_norm, (size_t)DM * DIN, (size_t)DINP * DM, DM, 2, DM, DIN, 256, MAP_WIN6K, 0.f};
            for (int it = gw; it < 2 * (DM / 64) * (256 / 32); it += NGW) transpose_item(D24, it, scr, lane); }
        __syncthreads();
        {
            LAS float* tscr = (LAS float*)lds;
            constexpr int NT8 = 8 * (DM / TL_K) * (2 * FFE / 256), NT9 = 8 * (FFE / TL_K) * (DM / 256) + (MK_GATE_F8 ? 2 * (DM / TL_K) * (6144 / 256) : 0);
            constexpr int NT9E = 8 * (FFE / TL_K) * (DM / 256);
            const TDesc D8 = TDESC(8), D9e = TDESC(9);
            const TDesc DG = TDesc{w_in, (bf16*)(wsl + WS_WIN8), attn_norm, (size_t)DM * DIN, (size_t)WIN8_ROWS * DM, DM, 2, DM, DIN, 6144, MAP_GATE, F8_WIN};
            f32x4 va[TL_RW], vb[TL_RW];
            constexpr int NTT = NT8 + NT9;
#define TL_LOAD(tt, buf) do { if ((tt) < NTT) { if ((tt) < NT8) tl_load(D8, (tt), buf, wave, lane); else if ((tt) < NT8 + NT9E) tl_load(D9e, (tt) - NT8, buf, wave, lane); else tl_load(DG, (tt) - NT8 - NT9E, buf, wave, lane); } } while (0)
#define TL_STORE(tt, buf) do { if ((tt) < NTT) { if ((tt) < NT8) tl_store(D8, (tt), buf, tscr, tid, wave, lane); else if ((tt) < NT8 + NT9E) tl_store(D9e, (tt) - NT8, buf, tscr, tid, wave, lane); else tl_store(DG, (tt) - NT8 - NT9E, buf, tscr, tid, wave, lane); } } while (0)
            int t = bx;
            TL_LOAD(t, va);
            for (; t < NTT; t += 2 * G) {
                TL_LOAD(t + G, vb); TL_STORE(t, va);
                TL_LOAD(t + 2 * G, va); TL_STORE(t + G, vb);
            }
#undef TL_LOAD
#undef TL_STORE
        }
        for (int m0 = gw; m0 < NTOK; m0 += 4 * NGW) {
            f32x4 xv[4][8];
#pragma unroll
            for (int r = 0; r < 4; ++r) { const int m = m0 + r * NGW; if (m < NTOK) {
#pragma unroll
                for (int j = 0; j < 8; ++j) xv[r][j] = __builtin_nontemporal_load((const f32x4*)(X_IN + (size_t)m * DM + 4 * lane + 256 * j)); } }
#pragma unroll
            for (int r = 0; r < 4; ++r) { const int m = m0 + r * NGW; if (m < NTOK) { float sx = 0.f;
#pragma unroll
                for (int j = 0; j < 8; ++j) { const f32x4 w = xv[r][j]; sx += (w[0] * w[0] + w[1] * w[1]) + (w[2] * w[2] + w[3] * w[3]);
                    u32x2 o; o.x = cvt_pk_bf16(w[0], w[1]); o.y = cvt_pk_bf16(w[2], w[3]); *(u32x2*)(HB + (size_t)m * DM + 4 * lane + 256 * j) = o;
                    if (MK_GATE_F8) { const f32x4 z = w * F8_H; int q = 0; q = __builtin_amdgcn_cvt_pk_fp8_f32(clamp448(z[0]), clamp448(z[1]), q, false); q = __builtin_amdgcn_cvt_pk_fp8_f32(clamp448(z[2]), clamp448(z[3]), q, true); *(int*)(wsl + WS_HB8 + (size_t)m * DM + 4 * lane + 256 * j) = q; } }
                sx = wave_sum(sx, lane); if (lane == 0) SSQA0[m] = ssq_fix(sx); } }
        }
        for (int m = gw; m < NBATCH * NMEM; m += NGW) (void)row_to_bf16(MEM_IN + (size_t)m * DM, MEMN + (size_t)m * DM, mem_norm, true, lane);
        for (int i = bx * NTHR + tid; i < NTOK * 32; i += G * NTHR) { const int tok = i >> 5, j = i & 31;
            const float inv = powf(10000.0f, -((float)j / 32.0f)); const float ang = (float)positions[tok] * inv; COS[i] = cosf(ang); SIN[i] = sinf(ang); }
        for (int i = bx * NTHR + tid; i < 1024; i += G * NTHR) { const float l0 = hg_lb[i], l1 = hg_lb[1024 + i], mx = fmaxf(l0, l1), e0 = expf(l0 - mx), e1 = expf(l1 - mx);
            const float s0 = e0 / (e0 + e1), s1 = e1 / (e0 + e1); LB[i] = 0.f; LB[1024 + i] = fminf(fmaxf((s0 + s1) - s0, 0.f), 1.f); }
    }
    SEAM(0);

    for (int l = 0; l < 2; ++l) {
        const int pb = 1 + 8 * l;
#define ssq_attn ((l == 0) ? SSQA0 : SSQ + SSQ_A1 * NTOK)
#define ssq_cq (SSQ + (l == 0 ? SSQ_CQ0 : SSQ_CQ1) * NTOK)
#define ssq_ckv (SSQ + (l == 0 ? SSQ_CKV0 : SSQ_CKV1) * NTOK)
#define ssq_ffn (SSQ + (l == 0 ? SSQ_F0 : SSQ_F1) * NTOK)
#define lbv (LB + l * 1024)
        if (KIND(1) && IN(pb + 0)) for (int rep = 0; rep < NREP(1); ++rep) { PHASE_IDS;
            const bool deal = (G == 256);
            if (MK_GATE_F8) {
                SchedIn S{(unsigned)WS_HB, (unsigned)(WS_WIN + (size_t)l * DINP * DM * 2), (unsigned)WS_MEMN, (unsigned)(WS_WMKV + (size_t)l * 2048 * DM * 2), G, bx, deal ? (MK_LAT_F8 ? 16 : 24) : 25, !deal};
                EpiIn E{wsl, l, rep == 0, 1.0f};
                pg8::gemm_run<EpiIn, SchedIn>(lds, tid, RSRC, DM, DM, DM, S, E);
                SchedPlain S8{(unsigned)WS_HB8, (unsigned)(WS_WIN8 + (size_t)l * WIN8_ROWS * DM), 32, MK_LAT_F8 ? 32 : 24, G, bx, 256u * DM, 256u * DM};
                EpiGateLogit E8{wsl, l};
                pg8::gemm_run<EpiGateLogit, SchedPlain, true, true>(lds, tid, RSRC, DM / 2, DM / 2, DM / 2, S8, E8);
            } else {
                SchedIn S{(unsigned)WS_HB, (unsigned)(WS_WIN + (size_t)l * DINP * DM * 2), (unsigned)WS_MEMN, (unsigned)(WS_WMKV + (size_t)l * 2048 * DM * 2), G, bx, deal ? 48 : 49, !deal};
                EpiIn E{wsl, l, rep == 0, 1.0f};
                pg8::gemm_run<EpiIn, SchedIn>(lds, tid, RSRC, DM, DM, DM, S, E);
            }
        }
        SEAM(pb + 0);
        if (KIND(2) && IN(pb + 1)) for (int rep = 0; rep < NREP(2); ++rep) { PHASE_IDS;
            SchedUp S{(unsigned)WS_PROJ, (unsigned)(WS_WQUP + (size_t)l * 1536 * 512 * 2), (unsigned)(WS_WKVUP + (size_t)l * 2048 * 512 * 2), G, bx};
            EpiUp E{wsl, l};
            pg8::gemm_run<EpiUp, SchedUp>(lds, tid, RSRC, 512, DINP, 512, S, E);
            if (G == 256) {
                SchedIn2 S2{(unsigned)WS_HB, (unsigned)(WS_WIN + (size_t)l * DINP * DM * 2), (unsigned)WS_MEMN, (unsigned)(WS_WMKV + (size_t)l * 2048 * DM * 2), G, bx, MK_GATE_F8 ? 24 : 48};
                EpiIn E2{wsl, l, false, 1.0f};
                pg8::gemm_run<EpiIn, SchedIn2>(lds, tid, RSRC, DM, DM, DM, S2, E2);
                if (bx >= 192) hg::pass1_unit(lds, tid, bx - 192, ZF, PROJ, lbv, HU, HDEC);
                else for (int j = 0; j < 5; ++j) hg::pass1_unit(lds, tid, 64 + bx + 192 * j, ZF, PROJ, lbv, HU, HDEC);
            } else for (int u = (G - 1 - bx); u < 1024; u += G) hg::pass1_unit(lds, tid, u, ZF, PROJ, lbv, HU, HDEC);
        }
        SEAM(pb + 1);
        if (KIND(3) && IN(pb + 2)) for (int rep = 0; rep < NREP(3); ++rep) { PHASE_IDS;
            const float c_mla = 0.07216878364870322f * 1.4426950408889634f, c_mem = 0.0625f * 1.4426950408889634f;
            for (int vc = bx; vc < 256; vc += G) {
                int nm = 0, q_a = 0, q_b = 0, bh = 0;
                if (vc < 32) { nm = 1; bh = vc; q_a = 7; }
                else if (vc < 64) { nm = 1; bh = vc - 32; q_a = 6; }
                else if (vc < 96) { nm = 2; bh = vc - 64; q_a = 5; q_b = 1; }
                else if (vc < 128) { nm = 2; bh = vc - 96; q_a = 4; q_b = 2; }
                else if (vc < 160) { nm = 2; bh = vc - 128; q_a = 3; q_b = 0; }
#ifndef NO_MLA
                for (int k = 0; k < nm; ++k) { const int b = bh >> 3, h = bh & 7, qb = k ? q_b : q_a; const size_t t0 = (size_t)b * SEQ;
                    att::attn_unit<QKD, NOPE, true>(lds, tid, QMLA + (t0 + qb * 256) * 1536 + h * QKD, 1536, KVB + t0 * 2048 + h * 256, 2048, PROJ + t0 * DINP + PC_KR, DINP,
                                                    KVB + t0 * 2048 + h * 256 + 128, 2048, Y + (t0 + qb * 256) * 3072 + 1024 + h * 128, 3072, 4 * (qb + 1), qb * 256, c_mla); }
#endif
            }
            { int tid2 = tid; asm volatile("" : "+v"(tid2));
            for (int vc = bx; vc < 256; vc += G) {
                int nx = 0, x_a = 0, x_b = 0;
                if (vc >= 32 && vc < 64) { nx = 1; x_a = vc - 32; }
                else if (vc >= 128 && vc < 160) { nx = 2; x_a = 32 + 2 * (vc - 128); x_b = x_a + 1; }
                else if (vc >= 160) { const int j = vc - 160; nx = (j < 64) ? 2 : 1; x_a = 96 + j; x_b = 192 + j; }
#ifndef NO_MEM
                for (int k = 0; k < nx; ++k) { const int uu = k ? x_b : x_a, half = uu & 1, qb = (uu >> 1) & 7, bh = uu >> 4, b = bh >> 2, h = bh & 3; const size_t t0 = (size_t)b * SEQ;
                    att::attn_unit<MEMD, MEMD, false>(lds, tid2, PROJ + (t0 + qb * 256) * DINP + PC_QM + h * 256, DINP, MKV + (size_t)b * 256 * 2048 + h * 256, 2048, nullptr, 0,
                                                      MKV + (size_t)b * 256 * 2048 + 1024 + h * 256 + half * 128, 2048, Y + (t0 + qb * 256) * 3072 + 2048 + h * 256 + half * 128, 3072, 4, 0, c_mem); }
#endif
            } }
#ifndef NO_P2
            if (rep == 0) { int tid3 = tid; asm volatile("" : "+v"(tid3));
            for (int vc = bx; vc < 256; vc += G) if (vc >= 160) { for (int task = (vc - 160) * NTHR + tid3; task < 32 * 4096; task += 96 * NTHR) hg::pass2_task(task, HU, HDEC, (bf16*)(wsl + WS_HS)); } }
#endif
        }
        SEAM(pb + 2);
        if (KIND(4) && IN(pb + 3)) { PHASE_IDS; const int NU = 1024 * NREP(4);
            hg::P3In ra; int u = bx;
            hg::pass3_load(ra, tid, u & 1023, ZF, PROJ, lbv, (const bf16*)(wsl + WS_HS));
            for (; u < NU; u += G) { int tid_u = tid; asm volatile("" : "+v"(tid_u));
                hg::pass3_compute(lds, tid_u, u & 1023, ra, (u + G < NU) ? ((u + G) & 1023) : -1, ZF, PROJ, lbv, (const bf16*)(wsl + WS_HS), hg_norm + l * 128, Y); } }
        SEAM(pb + 3);
        if (KIND(5) && IN(pb + 4)) for (int rep = 0; rep < NREP(5); ++rep) { PHASE_IDS;
            SchedGate S{(unsigned)WS_Y, (unsigned)(WS_WBR + (size_t)l * 3 * 2048 * 1024 * 2), G, bx};
            EpiGate E{wsl};
            pg8::gemm_run<EpiGate, SchedGate>(lds, tid, RSRC, 1024, 3072, 1024, S, E);
        }
        SEAM(pb + 4);
        if (KIND(6) && IN(pb + 5)) { PHASE_IDS;
            SchedPlain S{(unsigned)WS_MRGB, (unsigned)(WS_WO + (size_t)l * DM * DM * 2), 32, 8, G, bx, 256u * DM * 2u, 256u * DM * 2u};
            EpiRes E{wsl, l == 0 ? SSQ_F0 : SSQ_F1, MK_P7_F8 && l == 0};
            pg8::gemm_run<EpiRes, SchedPlain>(lds, tid, RSRC, DM, DM, DM, S, E);
        }
        SEAM(pb + 5);
        if (l == 0) {
            if (KIND(7) && IN(7)) for (int rep = 0; rep < NREP(7); ++rep) { PHASE_IDS;
                if ((MK_P7_F8 || MK_P8_F8) && MK_PROBE_MODE < 0) {
                    EpiSwiglu<true, MK_P7_F8 != 0, MK_P8_F8 != 0> E8{wsl, (unsigned)WS_ACT, FF, SSQ_F0};
                    if (MK_P7_F8) { SchedPlain S8{(unsigned)WS_HB8, (unsigned)WS_WGU, 32, 44, G, bx, 256u * DM, 256u * DM};
                        pg8::gemm_run<EpiSwiglu<true, MK_P7_F8 != 0, MK_P8_F8 != 0>, SchedPlain, true, MK_P7_F8 != 0>(lds, tid, RSRC, DM / 2, DM / 2, DM / 2, S8, E8); }
                    else { SchedPlain S8{(unsigned)WS_HB, (unsigned)WS_WGU, 32, 44, G, bx, 256u * DM * 2u, 256u * DM * 2u};
                        pg8::gemm_run<EpiSwiglu<true, MK_P7_F8 != 0, MK_P8_F8 != 0>, SchedPlain, true, MK_P7_F8 != 0>(lds, tid, RSRC, DM, DM, DM, S8, E8); }
                    continue; }
                SchedPlain S{(unsigned)WS_HB, (unsigned)WS_WGU, 32, 44, G, bx, 256u * DM * 2u, 256u * DM * 2u};
                EpiSwiglu<true> E{wsl, (unsigned)WS_ACT, FF, SSQ_F0};
                if (MK_PROBE_MODE == 8 && rep == 0) { EpiSwiglu<false> EN{wsl, (unsigned)WS_ACT, FF, SSQ_F0}; pg8::gemm_run<EpiSwiglu<false>, SchedPlain, true, false, 0>(lds, tid, RSRC, 128, DM, DM, S, EN); }
                else if (MK_PROBE_MODE == 9 && rep == 0) { EpiSwiglu<true> EN{wsl, 1u, FF, SSQ_F0}; pg8::gemm_run<EpiSwiglu<true>, SchedPlain, true, false, 0>(lds, tid, RSRC, 128, DM, DM, S, EN); }
                else if (MK_PROBE_MODE == 6 && rep == 0) { EpiNull EN{wsl}; pg8::gemm_run<EpiNull, SchedPlain, true, false, 0>(lds, tid, RSRC, 128, DM, DM, S, EN); }
                else if (MK_PROBE_MODE == 7 && rep == 0) { EpiNull EN{wsl}; pg8::gemm_run<EpiNull, SchedPlain, true, false, 0>(lds, tid, RSRC, DM, DM, DM, S, EN); }
                else if (MK_PROBE_MODE == 5 && rep == 0) pg8::gemm_run<EpiSwiglu<true>, SchedPlain, true, false, 0>(lds, tid, RSRC, 128, DM, DM, S, E);
                else if (MK_PROBE_MODE > 0 && MK_PROBE_MODE < 5 && rep == 0) pg8::gemm_run<EpiSwiglu<true>, SchedPlain, true, false, MK_PROBE_MODE % 5>(lds, tid, RSRC, DM, DM, DM, S, E);
                else pg8::gemm_run<EpiSwiglu<true>, SchedPlain>(lds, tid, RSRC, DM, DM, DM, S, E);
            }
            SEAM(7);
            if (KIND(8) && IN(8)) { PHASE_IDS;
                SchedPlain S{(unsigned)WS_ACT, (unsigned)WS_WDN, 32, 8, G, bx, 256u * FF * 2u, 256u * FF * 2u};
                if (MK_P8_F8) { SchedPlain S8{(unsigned)WS_ACT, (unsigned)WS_WDN, 32, 8, G, bx, 256u * FF, 256u * FF};
                    EpiResT<true> E8{wsl, SSQ_A1, MK_GATE_F8 != 0};
                    pg8::gemm_run<EpiResT<true>, SchedPlain, true, true>(lds, tid, RSRC, FF / 2, FF / 2, FF / 2, S8, E8); }
                else {
                EpiRes E{wsl, SSQ_A1, MK_GATE_F8 != 0};
                pg8::gemm_run<EpiRes, SchedPlain>(lds, tid, RSRC, FF, FF, FF, S, E); }
#if MK_PROBE_MFMA
                { f32x4 pa[16]; bf16x8 px, py;
#pragma unroll
                  for (int j = 0; j < 8; ++j) { px[j] = (__bf16)(float)(tid + j); py[j] = (__bf16)(float)(tid - j); }
#pragma unroll
                  for (int j = 0; j < 16; ++j) pa[j] = (f32x4){0.f, 0.f, 0.f, 0.f};
                  for (int it = 0; it < 352; ++it) {
#pragma unroll
                      for (int j = 0; j < 16; ++j) pa[j] = __builtin_amdgcn_mfma_f32_16x16x32_bf16(px, py, pa[j], 0, 0, 0);
                  }
#pragma unroll
                  for (int j = 0; j < 16; ++j) asm volatile("" :: "v"(pa[j]));
                }
#endif
            }
            SEAM(8);
        }
    }
    if (KIND(15) && IN(15)) for (int rep = 0; rep < NREP(15); ++rep) { PHASE_IDS;
        LAS float* wr = (LAS float*)lds;
        LAS int* lcnt = (LAS int*)(lds + 65536);
        const u64* ssq = SSQ + SSQ_F1 * NTOK;
        for (int i = tid; i < DM * 8; i += NTHR) wr[i] = w_router[i] * ffn_norm[DM + (i >> 3)];
        for (int vc = bx; vc < 256; vc += G) {
            if (tid < 8) lcnt[tid] = 0;
            __syncthreads();
            u32x2 hrow[4][8]; float rsq[4];
#pragma unroll
            for (int q = 0; q < 4; ++q) { const int t = vc * 32 + wave * 4 + q;
#pragma unroll
                for (int j = 0; j < 8; ++j) hrow[q][j] = *(const u32x2*)(HB + (size_t)t * DM + 4 * lane + 256 * j); }
#pragma unroll
            for (int q = 0; q < 4; ++q) rsq[q] = row_rstd(ssq, vc * 32 + wave * 4 + q, 1.0f / DM);
#pragma unroll
            for (int q = 0; q < 4; ++q) {
                const int t = vc * 32 + wave * 4 + q;
                float a[8] = {0.f, 0.f, 0.f, 0.f, 0.f, 0.f, 0.f, 0.f};
#pragma unroll
                for (int j = 0; j < 8; ++j) { const int k = 4 * lane + 256 * j; const u32x2 hw = hrow[q][j]; const f32x4 hv = (f32x4){bflo(hw.x), bfhi(hw.x), bflo(hw.y), bfhi(hw.y)};
#pragma unroll
                    for (int kk = 0; kk < 4; ++kk) { const f32x4 w0 = *(const LAS f32x4*)(wr + (k + kk) * 8), w1 = *(const LAS f32x4*)(wr + (k + kk) * 8 + 4);
                        a[0] += hv[kk] * w0[0]; a[1] += hv[kk] * w0[1]; a[2] += hv[kk] * w0[2]; a[3] += hv[kk] * w0[3];
                        a[4] += hv[kk] * w1[0]; a[5] += hv[kk] * w1[1]; a[6] += hv[kk] * w1[2]; a[7] += hv[kk] * w1[3]; } }
                const float rs = rsq[q];
#pragma unroll
                for (int e = 0; e < 8; ++e) a[e] = wave_sum(a[e], lane) * rs;
                int i0 = 0; float l0 = a[0];
#pragma unroll
                for (int e = 1; e < 8; ++e) if (a[e] > l0) { l0 = a[e]; i0 = e; }
                int i1 = -1; float l1 = -3.0e38f;
#pragma unroll
                for (int e = 0; e < 8; ++e) if (e != i0 && a[e] > l1) { l1 = a[e]; i1 = e; }
                if (lane == 0) { const float ex = expf(l1 - l0), w0 = 1.0f / (1.0f + ex); TOPI[2 * t] = i0; TOPI[2 * t + 1] = i1; TOPW[2 * t] = w0; TOPW[2 * t + 1] = ex * w0;
                    __hip_atomic_fetch_add(&lcnt[i0], 1, __ATOMIC_RELAXED, __HIP_MEMORY_SCOPE_WORKGROUP); __hip_atomic_fetch_add(&lcnt[i1], 1, __ATOMIC_RELAXED, __HIP_MEMORY_SCOPE_WORKGROUP); }
            }
            __syncthreads();
            if (tid < 8) BLKCNT[vc * 8 + tid] = lcnt[tid];
            __syncthreads();
        }
    }
    SEAM(15);
    if (KIND(16) && IN(16)) for (int rep = 0; rep < NREP(16); ++rep) { PHASE_IDS;
        LAS int* bc = (LAS int*)lds;
        LAS int* pst = (LAS int*)(lds + 8192);
        LAS int* posl = (LAS int*)(lds + 8192 + 256);
        const u64* ssq = SSQ + SSQ_F1 * NTOK;
        for (int i = tid; i < 2048; i += NTHR) bc[i] = BLKCNT[i];
        __syncthreads();
        for (int vc = bx; vc < 256; vc += G) {
            {
                const int e = wave; int part = 0, mine = 0;
#pragma unroll
                for (int q = 0; q < 4; ++q) { const int i = 4 * lane + q, v = bc[i * 8 + e]; part += v; if (i < vc) mine += v; }
                float tf = wave_sum((float)part, lane), mf = wave_sum((float)mine, lane);
                if (lane == 0) { pst[8 + e] = (int)tf; pst[16 + e] = (int)mf; }
            }
            __syncthreads();
            if (tid == 0) { int s = 0; for (int e = 0; e < 8; ++e) { pst[e] = s; s += (pst[8 + e] + 255) / 256 * 256; }
                if (vc == 0) { int rt = 0; for (int e = 0; e < 8; ++e) { const int n = (pst[8 + e] + 255) / 256; for (int k = 0; k < n; ++k) TEXP[rt++] = e; } TEXP[100] = rt; } }
            __syncthreads();
            if (wave == 0) {
                const int t = vc * 32 + (lane >> 1), e = TOPI[2 * t + (lane & 1)];
                int rank = 0;
#pragma unroll
                for (int ee = 0; ee < 8; ++ee) { const unsigned long long mk = __ballot(e == ee); if (e == ee) rank = __popcll(mk & ((1ull << lane) - 1ull)); }
                const int pos = pst[e] + pst[16 + e] + rank;
                posl[lane] = pos; *(u32x2*)(RASS + 2 * pos) = (u32x2){(unsigned)(2 * t + (lane & 1)), __float_as_uint(TOPW[2 * t + (lane & 1)])}; ((int*)(wsl + WS_POS))[2 * t + (lane & 1)] = pos;
            }
            if (vc < 8 && wave == 1) { const int e = vc, s = pst[e] + pst[8 + e], en = pst[e] + (pst[8 + e] + 255) / 256 * 256; for (int p = s + lane; p < en; p += 64) *(u32x2*)(RASS + 2 * p) = (u32x2){0xffffffffu, 0u}; }
            if (vc < 8 && wave >= 2) { const int e = vc, s = pst[e] + pst[8 + e], en = pst[e] + (pst[8 + e] + 255) / 256 * 256;
                for (int p = s + (wave - 2); p < en; p += 6) for (int j = 0; j < 8; ++j) { if (MK_MOE_F8) *(int*)((unsigned char*)XS + (size_t)p * DM + 4 * lane + 256 * j) = 0; else *(u32x2*)(XS + (size_t)p * DM + 4 * lane + 256 * j) = (u32x2){0u, 0u}; } }
            __syncthreads();
            {
                u32x2 hv[4][8]; float rsv[4];
#pragma unroll
                for (int i4 = 0; i4 < 4; ++i4) { const int t = vc * 32 + wave * 4 + i4;
#pragma unroll
                    for (int j = 0; j < 8; ++j) hv[i4][j] = *(const u32x2*)(HB + (size_t)t * DM + 4 * lane + 256 * j); }
#pragma unroll
                for (int i4 = 0; i4 < 4; ++i4) rsv[i4] = row_rstd(ssq, vc * 32 + wave * 4 + i4, 1.0f / DM);
#pragma unroll
                for (int i4 = 0; i4 < 4; ++i4) { const int p0 = posl[wave * 8 + 2 * i4], p1 = posl[wave * 8 + 2 * i4 + 1]; const float rs = rsv[i4];
#pragma unroll
                    for (int j = 0; j < 8; ++j) { const u32x2 hw = hv[i4][j]; const f32x4 v = (f32x4){bflo(hw.x), bfhi(hw.x), bflo(hw.y), bfhi(hw.y)} * rs;
                        if (MK_MOE_F8) { const f32x4 w = v * F8_XS; int q = 0; q = __builtin_amdgcn_cvt_pk_fp8_f32(clamp448(w[0]), clamp448(w[1]), q, false); q = __builtin_amdgcn_cvt_pk_fp8_f32(clamp448(w[2]), clamp448(w[3]), q, true);
                            *(int*)((unsigned char*)XS + (size_t)p0 * DM + 4 * lane + 256 * j) = q; *(int*)((unsigned char*)XS + (size_t)p1 * DM + 4 * lane + 256 * j) = q; }
                        else { u32x2 o; o.x = cvt_pk_bf16(v[0], v[1]); o.y = cvt_pk_bf16(v[2], v[3]); *(u32x2*)(XS + (size_t)p0 * DM + 4 * lane + 256 * j) = o; *(u32x2*)(XS + (size_t)p1 * DM + 4 * lane + 256 * j) = o; } } }
            }
            __syncthreads();
        }
    }
    SEAM(16);
    if (KIND(17) && IN(17)) for (int rep = 0; rep < NREP(17); ++rep) { PHASE_IDS;
        const int nrt = __builtin_amdgcn_readfirstlane(__hip_atomic_load(TEXP + 100, __ATOMIC_RELAXED, __HIP_MEMORY_SCOPE_AGENT));
        if (MK_MOE_F8) {
            SchedMoe S{(unsigned)WS_XS, (unsigned)WS_WEGU, wsl, nrt, 56, G, bx, 256u * DM, 256u * DM, 2u * FFE * DM};
            EpiSwigluF8 E{wsl};
            pg8::gemm_run<EpiSwigluF8, SchedMoe, true, true>(lds, tid, RSRC, DM / 2, DM / 2, DM / 2, S, E);
        } else {
            SchedMoe S{(unsigned)WS_XS, (unsigned)WS_WEGU, wsl, nrt, 56, G, bx, 256u * DM * 2u, 256u * DM * 2u, 2u * FFE * DM * 2u};
            EpiSwiglu<false> E{wsl, (unsigned)WS_ACTE, FFE, 0};
            pg8::gemm_run<EpiSwiglu<false>, SchedMoe>(lds, tid, RSRC, DM, DM, DM, S, E);
        }
    }
    SEAM(17);
    if (KIND(18) && IN(18)) for (int rep = 0; rep < NREP(18); ++rep) { PHASE_IDS;
        const int nrt = __builtin_amdgcn_readfirstlane(__hip_atomic_load(TEXP + 100, __ATOMIC_RELAXED, __HIP_MEMORY_SCOPE_AGENT));
        if (MK_MOE_F8) {
            SchedMoe S{(unsigned)WS_ACTE, (unsigned)WS_WEDN, wsl, 64, 8, G, bx, 256u * FFE, 256u * FFE, (unsigned)DM * FFE};
            EpiMoeDown E{wsl, 1.0f / (F8_ACT * F8_WDN)};
            pg8::gemm_run<EpiMoeDown, SchedMoe, true, true>(lds, tid, RSRC, FFE / 2, FFE / 2, FFE / 2, S, E);
            SchedMoeTail ST{(unsigned)WS_ACTE, (unsigned)WS_WEDN, wsl, nrt, G, bx, 256u * FFE, 256u * FFE, (unsigned)DM * FFE, (unsigned)FFE / 4};
            const int tid_t = wave0 * 64 + lane_id();
            pg8::gemm_run<EpiMoeDown, SchedMoeTail, true, true>(lds, tid_t, RSRC, FFE / 8, FFE / 2, FFE / 2, ST, E);
        } else {
            SchedMoe S{(unsigned)WS_ACTE, (unsigned)WS_WEDN, wsl, nrt, 8, G, bx, 256u * FFE * 2u, 256u * FFE * 2u, (unsigned)DM * FFE * 2u};
            EpiMoeDown E{wsl, 1.0f};
            pg8::gemm_run<EpiMoeDown, SchedMoe>(lds, tid, RSRC, FFE, FFE, FFE, S, E);
        }
    }
    SEAM(18);
    if (IN(PH_FINAL)) { PHASE_IDS;
        const int gw = bx * NWAVES + wave, NGW = G * NWAVES;
        const bool have_moe = (MK_LAST_PHASE >= 18), have_h = (MK_LAST_PHASE >= 6); float* out_p = (float*)*(GAS float* const CAS*)(kargs + 176);
        for (int m0 = gw; m0 < NTOK; m0 += 2 * NGW) {
            int pos[2][2];
#pragma unroll
            for (int r = 0; r < 2; ++r) { const int m = m0 + r * NGW;
#pragma unroll
                for (int kk = 0; kk < 2; ++kk) pos[r][kk] = (have_moe && m < NTOK) ? __hip_atomic_load((const int*)(wsl + WS_POS) + 2 * m + kk, __ATOMIC_RELAXED, __HIP_MEMORY_SCOPE_AGENT) : 0; }
#pragma unroll
            for (int r = 0; r < 2; ++r)
#pragma unroll
                for (int kk = 0; kk < 2; ++kk) pos[r][kk] = __builtin_amdgcn_readfirstlane(pos[r][kk]);
            u32x2 hbv[2][8], yv[2][2][8];
#pragma unroll
            for (int r = 0; r < 2; ++r) { const int m = m0 + r * NGW; if (m < NTOK) {
#pragma unroll
                for (int j = 0; j < 8; ++j) { const int k = 4 * lane + 256 * j; hbv[r][j] = *(const u32x2*)(HB + (size_t)m * DM + k);
#pragma unroll
                    for (int kk = 0; kk < 2; ++kk) { const bool tl = MK_MOE_F8 && pos[r][kk] >= 64 * 256;
                        const bf16* yp = tl ? (const bf16*)(wsl + WS_YSQ) + (size_t)(pos[r][kk] - 64 * 256) * DM : (const bf16*)YS + (size_t)(2 * m + kk) * DM;
                        yv[r][kk][j] = have_moe ? *(const u32x2*)(yp + k) : (u32x2){0u, 0u}; } } } }
#pragma unroll
            for (int r = 0; r < 2; ++r) { const int m = m0 + r * NGW; if (m < NTOK) {
                f32x4 v[8]; float sx = 0.f;
#pragma unroll
                for (int j = 0; j < 8; ++j) { const int k = 4 * lane + 256 * j; const u32x2 hw = hbv[r][j];
                    v[j] = have_h ? (f32x4){bflo(hw.x), bfhi(hw.x), bflo(hw.y), bfhi(hw.y)} : *(const f32x4*)(X_IN + (size_t)m * DM + k);
#pragma unroll
                    for (int kk = 0; kk < 2; ++kk) { const u32x2 ya = yv[r][kk][j]; v[j][0] += bflo(ya.x); v[j][1] += bfhi(ya.x); v[j][2] += bflo(ya.y); v[j][3] += bfhi(ya.y);
                        if (MK_MOE_F8 && have_moe && pos[r][kk] >= 64 * 256) {
#pragma unroll
                            for (int q = 1; q < 4; ++q) { const u32x2 yb = *(const u32x2*)((const bf16*)(wsl + WS_YSQ) + ((size_t)q * 2048 + (pos[r][kk] - 64 * 256)) * DM + k);
                                v[j][0] += bflo(yb.x); v[j][1] += bfhi(yb.x); v[j][2] += bflo(yb.y); v[j][3] += bfhi(yb.y); } } }
                    sx += (v[j][0] * v[j][0] + v[j][1] * v[j][1]) + (v[j][2] * v[j][2] + v[j][3] * v[j][3]); }
                const float rs = rsqrtf(wave_sum(sx, lane) * (1.0f / DM) + EPS);
#pragma unroll
                for (int j = 0; j < 8; ++j) { const int k = 4 * lane + 256 * j; *(f32x4*)(out_p + (size_t)m * DM + k) = v[j] * rs * *(const f32x4*)(final_norm + k); }
            } }
        }
    }
#undef IN
#undef SEAM
}

extern "C" void kernel_launch(void* const* d_in, const int* in_sizes, int n_in, void* d_out, int out_size, void* d_ws, size_t ws_size, hipStream_t stream) {
    static int grid = 0;
    if (grid == 0) {
        if (n_in != 22 || out_size != NTOK * DM || ws_size < WS_END) { fprintf(stderr, "kernel_launch: unexpected shapes (n_in %d, out %d, ws %zu < %zu); nothing launched\n", n_in, out_size, ws_size, (size_t)WS_END); grid = -1; return; }
        int dev = 0, cus = 0, per_cu = 0;
        if (hipGetDevice(&dev) != hipSuccess || hipDeviceGetAttribute(&cus, hipDeviceAttributeMultiprocessorCount, dev) != hipSuccess) { grid = -1; return; }
        if (hipFuncSetAttribute((const void*)trunk_fwd, hipFuncAttributeMaxDynamicSharedMemorySize, LDS_BYTES) != hipSuccess) { fprintf(stderr, "kernel_launch: hipFuncSetAttribute failed\n"); grid = -1; return; }
        if (hipOccupancyMaxActiveBlocksPerMultiprocessor(&per_cu, (const void*)trunk_fwd, NTHR, LDS_BYTES) != hipSuccess || per_cu < 1) fprintf(stderr, "kernel_launch: occupancy query reports %d\n", per_cu);
        (void)hipGetLastError();
        grid = cus;
    }
    if (grid < 0) return;
    (void)hipMemsetAsync((char*)d_ws + WS_CTL, 0, CTL_BYTES, stream);
    Args a{};
    for (int i = 0; i < 22; ++i) a.in[i] = d_in[i];
    a.out = (float*)d_out; a.ws = (unsigned char*)d_ws;
    if (MK_N_LAUNCHES == 1) { a.ph_lo = 0; a.ph_hi = N_PHASES; hipLaunchKernelGGL(trunk_fwd, dim3(grid), dim3(NTHR), LDS_BYTES, stream, a); }
    else { for (int p = 0; p < N_PHASES; ++p) { if (p > MK_LAST_PHASE && p != PH_FINAL) continue; a.ph_lo = p; a.ph_hi = p + 1; hipLaunchKernelGGL(trunk_fwd, dim3(grid), dim3(NTHR), LDS_BYTES, stream, a); } }
    const hipError_t le = hipPeekAtLastError();
    if (le != hipSuccess) fprintf(stderr, "kernel_launch: launch failed: %s\n", hipGetErrorName(le));
}
```

```cpp
#include <hip/hip_runtime.h>
#ifndef MK_PROBE_MODE
#define MK_PROBE_MODE -1
#endif
#include <cstdio>
#include <cstdint>
#include <cstddef>

#ifndef MK_N_LAUNCHES
#define MK_N_LAUNCHES 1
#endif
#ifndef MK_MOE_F8
#define MK_MOE_F8 1
#endif
#ifndef MK_GATE_F8
#define MK_GATE_F8 1
#endif
#ifndef MK_LAST_PHASE
#define MK_LAST_PHASE 99
#endif
#ifndef MK_LAT_F8
#define MK_LAT_F8 1
#endif
#ifndef MK_BR_F8
#define MK_BR_F8 1
#endif
#ifndef MK_P7_F8
#define MK_P7_F8 0
#endif
#ifndef MK_P8_F8
#define MK_P8_F8 1
#endif

#define GAS __attribute__((address_space(1)))
#define LAS __attribute__((address_space(3)))
#define CAS __attribute__((address_space(4)))
#ifndef HG_SIGMOID
#define HG_SIGMOID fast_sigmoid
#endif
#ifndef EPI_SIGMOID
#define EPI_SIGMOID fast_sigmoid
#endif
typedef unsigned short bf16;
typedef short bf16x8 __attribute__((ext_vector_type(8)));
typedef short s16x4 __attribute__((ext_vector_type(4)));
typedef float f32x2 __attribute__((ext_vector_type(2)));
typedef float f32x4 __attribute__((ext_vector_type(4)));
typedef float f32x16 __attribute__((ext_vector_type(16)));
typedef unsigned u32x2 __attribute__((ext_vector_type(2)));
typedef unsigned u32x4 __attribute__((ext_vector_type(4)));

constexpr int DM = 2048, NBATCH = 4, SEQ = 2048, NTOK = NBATCH * SEQ, NMEM = 256;
constexpr int HGH = 8, HGD = 128, CHUNK = 64, NCHUNK = SEQ / CHUNK;
constexpr int MLAH = 8, QRANK = 512, KVRANK = 512, NOPE = 128, ROPE = 64, QKD = NOPE + ROPE, MLAV = 128;
constexpr int MEMH = 4, MEMD = 256;
constexpr int DIN = 12352, DINP = 12544;
constexpr int FF = 5632, NEXP = 8, FFE = 7168;
constexpr float EPS = 1e-6f;
constexpr int PC_Q = 0, PC_F = 1024, PC_I = 2048, PC_G = 3072, PC_CQ = 4096, PC_CKV = 4608, PC_KR = 5120, PC_QM = 5376, PC_GATE = 6400;
constexpr int MAXRT = 72;

constexpr size_t MiB = 1u << 20;
constexpr size_t WS_CTL = 0, CTL_BYTES = 1 * MiB;
constexpr int CW_BAR = 4096;
constexpr size_t CB_SSQ = 65536;
constexpr int SSQ_F0 = 0, SSQ_A1 = 1, SSQ_F1 = 2, SSQ_CQ0 = 3, SSQ_CKV0 = 4, SSQ_CQ1 = 5, SSQ_CKV1 = 6;
constexpr size_t CB_BLKCNT = 65536 + 7 * 65536;
constexpr size_t W0 = 1 * MiB;
constexpr size_t WS_WIN = W0;
constexpr size_t WS_WMKV = WS_WIN + 2ull * DINP * 2048 * 2;
constexpr size_t WS_WQUP = WS_WMKV + 2ull * 2048 * 2048 * 2;
constexpr size_t WS_WKVUP = WS_WQUP + 2ull * 1536 * 512 * 2;
constexpr size_t WS_WBR = WS_WKVUP + 2ull * 2048 * 512 * 2;
constexpr size_t WS_WO = WS_WBR + 6ull * 2048 * 1024 * 2;
constexpr size_t WS_WGU = WS_WO + 2ull * 2048 * 2048 * 2;
constexpr size_t WS_WDN = WS_WGU + 11264ull * 2048 * 2;
constexpr size_t WS_WEGU = WS_WDN + 2048ull * 5632 * 2;
constexpr size_t WS_WEDN = WS_WEGU + 8ull * 14336 * 2048 * 2;
constexpr size_t WS_WEND = WS_WEDN + 8ull * 2048 * 7168 * 2;
constexpr size_t A0 = (WS_WEND + MiB - 1) / MiB * MiB;
constexpr size_t WS_H = A0;
constexpr size_t WS_HB = WS_H + (size_t)NTOK * DM * 4;
constexpr size_t WS_PROJ = WS_HB + (size_t)NTOK * DM * 2;
constexpr size_t WS_ZF = WS_PROJ + (size_t)NTOK * DINP * 2;
constexpr size_t WS_MEMN = WS_ZF + (size_t)NTOK * 1024 * 4;
constexpr size_t WS_MKV = WS_MEMN + 1024ull * 2048 * 2;
constexpr size_t WS_QMLA = WS_MKV + 1024ull * 2048 * 2;
constexpr size_t WS_KVB = WS_QMLA + (size_t)NTOK * 1536 * 2;
constexpr size_t WS_Y = WS_KVB + (size_t)NTOK * 2048 * 2;
constexpr size_t WS_HU = WS_Y + (size_t)NTOK * 3072 * 2;
constexpr size_t WS_HDEC = WS_HU + 1024ull * 128 * 128 * 4;
constexpr size_t WS_MRG = WS_HDEC + 1024ull * 128 * 4;
constexpr size_t WS_MRGB = WS_MRG + (size_t)NTOK * DM * 4;
constexpr size_t WS_ACT = WS_MRGB + (size_t)NTOK * DM * 2;
constexpr size_t WS_XS = WS_ACT + (size_t)NTOK * FF * 2;
constexpr size_t WS_ACTE = WS_XS + (size_t)MAXRT * 256 * DM * 2;
constexpr size_t WS_YS = WS_ACTE + (size_t)MAXRT * 256 * FFE * 2;
constexpr size_t WS_COS = WS_YS + 2ull * NTOK * DM * 4;
constexpr size_t WS_SIN = WS_COS + (size_t)NTOK * 32 * 4;
constexpr size_t WS_LB = WS_SIN + (size_t)NTOK * 32 * 4;
constexpr size_t WS_SSQA0 = WS_LB + 2 * 1024 * 4;
constexpr size_t WS_TOPI = WS_SSQA0 + (size_t)NTOK * 8;
constexpr size_t WS_TOPW = WS_TOPI + (size_t)NTOK * 8;
constexpr size_t WS_RASS = WS_TOPW + (size_t)NTOK * 8;
constexpr size_t WS_TEXP = WS_RASS + (size_t)MAXRT * 256 * 8;
constexpr size_t WS_POS = WS_TEXP + 512;
constexpr size_t WS_YSQ = WS_POS + 2ull * NTOK * 4;
constexpr size_t WS_HS = WS_YSQ + 4ull * 2048 * DM * 2;
constexpr size_t WS_HB8 = WS_HS + 1024ull * 128 * 128 * 2;
constexpr size_t WS_WIN8 = WS_HB8 + (size_t)NTOK * DM;
constexpr int WIN8_ROWS = MK_LAT_F8 ? 8192 : 6144;
constexpr size_t WS_Y8 = WS_WIN8 + 2ull * WIN8_ROWS * DM;
constexpr size_t WS_WBR8 = WS_Y8 + (size_t)NTOK * 2048;
constexpr size_t WS_END = WS_WBR8 + 2ull * 2 * 2048 * 1024;

constexpr int RING_BYTES = 131072;
constexpr int MISC_OFF = RING_BYTES;
constexpr int LDS_BYTES = 163840;
constexpr int NWAVES = 8, NTHR = 512;

#define RLX_AGENT __ATOMIC_RELAXED, __HIP_MEMORY_SCOPE_AGENT
#define LDS_WAIT() asm volatile("s_waitcnt lgkmcnt(0)" ::: "memory")
#define VM_WAIT() asm volatile("s_waitcnt vmcnt(0)" ::: "memory")
#define SBAR() __builtin_amdgcn_sched_barrier(0)
__device__ __forceinline__ unsigned cvt_pk_bf16(float lo, float hi) { unsigned r; asm volatile("s_nop 0\n\tv_cvt_pk_bf16_f32 %0, %1, %2" : "=v"(r) : "v"(lo), "v"(hi)); return r; }
__device__ __forceinline__ bf16 f2bf(float f) { return (bf16)(cvt_pk_bf16(f, 0.f) & 0xffffu); }
__device__ __forceinline__ float bf2f(bf16 b) { return __uint_as_float(((unsigned)b) << 16); }
__device__ __forceinline__ float bflo(unsigned w) { return __uint_as_float(w << 16); }
__device__ __forceinline__ float bfhi(unsigned w) { return __uint_as_float(w & 0xffff0000u); }
__device__ __forceinline__ f32x4 ld4h(const bf16* p) { const u32x2 w = *(const u32x2*)p; return (f32x4){bflo(w.x), bfhi(w.x), bflo(w.y), bfhi(w.y)}; }
__device__ __forceinline__ float fast_sigmoid(float x) { return __builtin_amdgcn_rcpf(1.0f + __builtin_amdgcn_exp2f(x * -1.4426950408889634f)); }
__device__ __forceinline__ float ieee_sigmoid(float x) { return 1.0f / (1.0f + __expf(-x)); }
__device__ __forceinline__ int lane_id() { int r; asm volatile("v_mbcnt_lo_u32_b32 %0, -1, 0\n\tv_mbcnt_hi_u32_b32 %0, -1, %0" : "=v"(r)); return r; }
__device__ __forceinline__ float shflx(float v, int mask, int lane) { return __int_as_float(__builtin_amdgcn_ds_bpermute((lane ^ mask) << 2, __float_as_int(v))); }
__device__ __forceinline__ float wave_sum(float v, int lane) {
#pragma unroll
    for (int o = 1; o < 64; o <<= 1) v += shflx(v, o, lane);
    return v;
}
constexpr float F8_XS = 32.0f, F8_WGU = 1024.0f, F8_ACT = 8.0f, F8_WDN = 2048.0f, F8_H = 32.0f, F8_WIN = 1024.0f;
constexpr float F8_Y = 32.0f, F8_WBR = 1024.0f;
typedef int i32x8 __attribute__((ext_vector_type(8)));
__device__ __forceinline__ float clamp448(float v) { return fminf(fmaxf(v, -448.0f), 448.0f); }
__device__ __forceinline__ u32x2 pack8_f8(const f32x4& a, const f32x4& b) {
    int w0 = 0, w1 = 0;
    w0 = __builtin_amdgcn_cvt_pk_fp8_f32(clamp448(a[0]), clamp448(a[1]), w0, false); w0 = __builtin_amdgcn_cvt_pk_fp8_f32(clamp448(a[2]), clamp448(a[3]), w0, true);
    w1 = __builtin_amdgcn_cvt_pk_fp8_f32(clamp448(b[0]), clamp448(b[1]), w1, false); w1 = __builtin_amdgcn_cvt_pk_fp8_f32(clamp448(b[2]), clamp448(b[3]), w1, true);
    u32x2 r; r.x = (unsigned)w0; r.y = (unsigned)w1; return r;
}
__device__ __forceinline__ u32x4 pack8(const f32x4& a, const f32x4& b) {
    u32x4 w; w.x = cvt_pk_bf16(a[0], a[1]); w.y = cvt_pk_bf16(a[2], a[3]); w.z = cvt_pk_bf16(b[0], b[1]); w.w = cvt_pk_bf16(b[2], b[3]); return w;
}

#define XB_TMO      128
#define XB_XCNT(j)  (256  + 64 * (j))
#define XB_XSUB(j)  (1280 + 64 * (j))
#define XB_XGEN(j)  (2304 + 64 * (j))
#define XB_TOP      3328
#define XB_TOPGEN   3392
#define XCD_BAR_WORDS 3456
#define XB_SPIN_CAP (1u << 18)
__device__ __forceinline__ unsigned xb_ld(unsigned* p)              { return __hip_atomic_load(p, __ATOMIC_RELAXED, __HIP_MEMORY_SCOPE_AGENT); }
__device__ __forceinline__ unsigned xb_add(unsigned* p, unsigned v) { return __hip_atomic_fetch_add(p, v, __ATOMIC_RELAXED, __HIP_MEMORY_SCOPE_AGENT); }
__device__ __forceinline__ unsigned xb_xcc_id() { return (unsigned)__builtin_amdgcn_s_getreg((3 << 11) | 20) & 0xFu; }
#define XB_SPIN(cond, bar) do { unsigned _sp = 0; while (cond) { __builtin_amdgcn_s_sleep(1); \
    if ((++_sp & 255u) == 0u) { if (xb_ld(&(bar)[XB_TMO])) break; if (_sp > XB_SPIN_CAP) { atomicAdd(&(bar)[XB_TMO], 1u); break; } } } } while (0)
struct XcdBarrier { unsigned* bar; unsigned x; volatile LAS unsigned* st; unsigned nloc, nx; };
__device__ __forceinline__ XcdBarrier xcd_barrier_post(unsigned* bar, volatile LAS unsigned* st, int tid) {
    XcdBarrier b; b.bar = bar; b.x = xb_xcc_id(); b.st = st; b.nloc = 0u; b.nx = 0u;
    if (tid == 0) (void)xb_add(&bar[XB_XCNT(b.x)], 1u);
    return b;
}
__device__ __forceinline__ void xcd_barrier_complete(unsigned* bar, unsigned x, unsigned& nloc, unsigned& nx) {
    const unsigned G = gridDim.x * gridDim.y * gridDim.z;
    unsigned sum, cnt, mine, sp = 0u;
    for (;;) {
        sum = 0u; cnt = 0u; mine = 0u;
#pragma unroll
        for (unsigned j = 0; j < 16; ++j) { const unsigned c = xb_ld(&bar[XB_XCNT(j)]); sum += c; cnt += (c > 0u) ? 1u : 0u; mine = (j == x) ? c : mine; }
        if (sum == G) break;
        __builtin_amdgcn_s_sleep(1);
        if ((++sp & 255u) == 0u) { if (xb_ld(&bar[XB_TMO])) break; if (sp > XB_SPIN_CAP) { atomicAdd(&bar[XB_TMO], 1u); break; } }
    }
    nloc = mine > 0u ? mine : 1u; nx = cnt > 0u ? cnt : 1u;
}
__device__ __forceinline__ void xcd_barrier(XcdBarrier& b, int tid) {
    asm volatile("s_waitcnt vmcnt(0)" ::: "memory");
    __syncthreads();
    unsigned nloc_new = b.nloc, nx_new = b.nx;
    if (tid == 0) {
        unsigned* bar = b.bar; unsigned bxx = b.x; asm volatile("" : "+s"(bar), "+s"(bxx));
        __builtin_amdgcn_s_waitcnt(0);
        unsigned nloc = b.nloc, nx = b.nx;
        if (nloc == 0u) { xcd_barrier_complete(bar, bxx, nloc, nx); nloc_new = nloc; nx_new = nx; }
        const unsigned old = xb_add(&bar[XB_XSUB(bxx)], 1u);
        const unsigned gen = old / nloc;
        if (old + 1u == (gen + 1u) * nloc) {
            __builtin_amdgcn_fence(__ATOMIC_RELEASE, "agent");
            asm volatile("s_waitcnt vmcnt(0)" ::: "memory");
            const unsigned og = xb_add(&bar[XB_TOP], 1u);
            const unsigned tg = og / nx;
            if (og + 1u != (tg + 1u) * nx) XB_SPIN(xb_ld(&bar[XB_TOP]) < (tg + 1u) * nx, bar);
            __builtin_amdgcn_fence(__ATOMIC_ACQUIRE, "agent");
            xb_add(&bar[XB_XGEN(bxx)], 1u);
            asm volatile("s_waitcnt vmcnt(0)" ::: "memory");
        } else {
            XB_SPIN(xb_ld(&bar[XB_XGEN(bxx)]) == gen, bar);
            __builtin_amdgcn_fence(__ATOMIC_ACQUIRE, "agent");
            asm volatile("s_waitcnt vmcnt(0)" ::: "memory");
        }
    }
    b.nloc = __builtin_amdgcn_readfirstlane(nloc_new); b.nx = __builtin_amdgcn_readfirstlane(nx_new);
    __syncthreads();
}

typedef unsigned long long u64;
namespace pg8 {
typedef int i32x4v __attribute__((ext_vector_type(4)));
constexpr int BM = 256, BK = 64, HALF = 128, HTB = HALF * BK * 2, STAGE_BYTES = 8 * HTB, NXCD = 8, WGM = 8;
__device__ __forceinline__ int lds_byte(int r, int c) { const int st = (r >> 4) * 2 + (c >> 5), rr = r & 15, cc = c & 31, ob = rr * 64 + cc * 2; return st * 1024 + (ob ^ (((ob >> 9) & 1) << 5)); }
__device__ __forceinline__ void stage_rc(int b, int& R, int& C) { const int st = b / 1024, sb = b % 1024, swz = sb ^ (((sb >> 9) & 1) << 5); R = (st >> 1) * 16 + swz / 64; C = (st & 1) * 32 + (swz % 64) / 2; }
__device__ __forceinline__ int perm32(int rho) { const int n = rho >> 4, i = rho & 15; return 8 * (i >> 2) + 4 * n + (i & 3); }

struct Unit { unsigned A, B; int pm, pn, kind, aux; };

__device__ __forceinline__ int xcd_remap(int L, int nwg) { const int q = nwg / NXCD, r = nwg % NXCD, xcd = L % NXCD, off = L / NXCD; return (xcd < r ? xcd * (q + 1) : r * (q + 1) + (xcd - r) * q) + off; }
__device__ __forceinline__ void tile_decode(int wgid, int nM, int nN, int& pm, int& pn) {
    const int nig = WGM * nN, gid = wgid / nig, fm = gid * WGM, gsz = (nM - fm) < WGM ? (nM - fm) : WGM;
    pm = fm + ((wgid % nig) % gsz); pn = (wgid % nig) / gsz;
}

template <class Epi, class Sched, bool ALIGN_EPI = true, bool F8 = false, int PM = 0>
__device__ __forceinline__ void gemm_run(LAS unsigned char* lds, const int tid, const unsigned char* wsbase, const int K, const int lda, const int ldb, const Sched& S, const Epi& E) {
    const int wid = __builtin_amdgcn_readfirstlane(tid >> 6), lane = tid & 63, wr = wid >> 2, wc = wid & 3, fr = lane & 15, fq = lane >> 4;
    const int nt = K / BK;
    const unsigned long long wsb = (unsigned long long)wsbase; const unsigned wlo = __builtin_amdgcn_readfirstlane((unsigned)wsb), whi = __builtin_amdgcn_readfirstlane((unsigned)(wsb >> 32));
    const __amdgpu_buffer_rsrc_t rsrc = __builtin_amdgcn_make_buffer_rsrc((void*)(((unsigned long long)whi << 32) | wlo), 0, 0xFFFFF000u, 0x00020000);
    unsigned voffA, voffB;
    { int R, C; stage_rc(tid * 16, R, C); const int Rb = (R & ~31) + perm32(R & 31); voffA = (unsigned)(R * lda + C) * 2u; voffB = (unsigned)(Rb * ldb + C) * 2u; }
    const unsigned pieceA = 64u * lda * 2u, pieceB = 64u * ldb * 2u;
    const unsigned kstep = BK * 2;
    const unsigned hstepA = (unsigned)HALF * lda * 2u, hstepB = (unsigned)HALF * ldb * 2u;
    const unsigned ldsw = (unsigned)wid * 1024u;
    const int aoff = lds_byte(wr * 64 + fr, fq * 8), boff = lds_byte(wc * 32 + fr, fq * 8);
#define PG8_SA(b, h) (((b) * 2 + (h)) * HTB)
#define PG8_SB(b, h) ((4 + (b) * 2 + (h)) * HTB)
#define PG8_STAGE(bufoff, goff, voff) do { if constexpr (PM == 2) break; \
        __builtin_amdgcn_raw_ptr_buffer_load_lds(rsrc, (LAS void*)(lds + (bufoff) + ldsw), 16, (int)(voff), (int)(goff), 0, 0); \
        __builtin_amdgcn_raw_ptr_buffer_load_lds(rsrc, (LAS void*)(lds + (bufoff) + ldsw + 8192), 16, (int)(voff), (int)((goff) + piece##voff), 0, 0); } while (0)
#define piecevoffA pieceA
#define piecevoffB pieceB
#define PG8_LDA(dst, b, h) do { if constexpr (PM == 1) break; _Pragma("unroll") for (int m = 0; m < 4; ++m) _Pragma("unroll") for (int k = 0; k < 2; ++k) dst[m][k] = *(const LAS bf16x8*)(lds + PG8_SA(b, h) + aoff + m * 2048 + k * 1024); } while (0)
#define PG8_LDB(dst, b, h) do { if constexpr (PM == 1) break; _Pragma("unroll") for (int n = 0; n < 2; ++n) _Pragma("unroll") for (int k = 0; k < 2; ++k) dst[n][k] = *(const LAS bf16x8*)(lds + PG8_SB(b, h) + boff + n * 2048 + k * 1024); } while (0)
#define PG8_CAT(lo, hi) __builtin_shufflevector(__builtin_bit_cast(i32x4v, lo), __builtin_bit_cast(i32x4v, hi), 0, 1, 2, 3, 4, 5, 6, 7)
#define PG8_MMA(ai, bj, At, Bt) do { if constexpr (PM == 3) break; __builtin_amdgcn_s_setprio(1); if constexpr (F8) { _Pragma("unroll") for (int m = 0; m < 4; ++m) _Pragma("unroll") for (int n = 0; n < 2; ++n) \
        acc[ai][bj][m][n] = __builtin_amdgcn_mfma_scale_f32_16x16x128_f8f6f4(PG8_CAT(Bt[n][0], Bt[n][1]), PG8_CAT(At[m][0], At[m][1]), acc[ai][bj][m][n], 0, 0, 0, 0x7F7F7F7F, 0, 0x7F7F7F7F); } \
      else { _Pragma("unroll") for (int m = 0; m < 4; ++m) _Pragma("unroll") for (int n = 0; n < 2; ++n) _Pragma("unroll") for (int k = 0; k < 2; ++k) \
        acc[ai][bj][m][n] = __builtin_amdgcn_mfma_f32_16x16x32_bf16(Bt[n][k], At[m][k], acc[ai][bj][m][n], 0, 0, 0); } __builtin_amdgcn_s_setprio(0); } while (0)
#define PG8_WAIT_V(n) asm volatile("s_waitcnt vmcnt(" #n ")" ::: "memory")
#define PG8_WAIT_L(n) asm volatile("s_waitcnt lgkmcnt(" #n ")" ::: "memory")
#define PG8_BAR __builtin_amdgcn_s_barrier()
#define PG8_SCHED __builtin_amdgcn_sched_barrier(0)
    Unit cur, nxt; int ui = 0;
    if (!S.next(0, cur)) return;
    LAS unsigned char* pfslot = lds + STAGE_BYTES + ldsw * 2u;
#define PG8_PF(unit) do { if constexpr (Epi::PF) { const int po = __builtin_amdgcn_readfirstlane((int)E.pf_off(unit)); \
        __builtin_amdgcn_raw_ptr_buffer_load_lds(rsrc, (LAS void*)pfslot, 16, lane * 16, po, 0, 0); \
        __builtin_amdgcn_raw_ptr_buffer_load_lds(rsrc, (LAS void*)(pfslot + 1024), 16, lane * 16, po + 1024, 0, 0); } } while (0)
    PG8_PF(cur);
    f32x4 acc[2][2][4][2];
#pragma unroll
    for (int a = 0; a < 2; ++a)
#pragma unroll
        for (int b = 0; b < 2; ++b)
#pragma unroll
            for (int m = 0; m < 4; ++m)
#pragma unroll
                for (int n = 0; n < 2; ++n) acc[a][b][m][n] = (f32x4){0.f, 0.f, 0.f, 0.f};
    bf16x8 At[4][2], B0[2][2], B1[2][2];
    if constexpr (PM == 1) {
#pragma unroll
        for (int m = 0; m < 4; ++m) { asm volatile("" : "=v"(At[m][0])); asm volatile("" : "=v"(At[m][1])); }
#pragma unroll
        for (int m = 0; m < 2; ++m) { asm volatile("" : "=v"(B0[m][0])); asm volatile("" : "=v"(B0[m][1])); asm volatile("" : "=v"(B1[m][0])); asm volatile("" : "=v"(B1[m][1])); }
    }
    unsigned cA = cur.A, cB = cur.B;
    PG8_STAGE(PG8_SB(0, 0), cB, voffB); PG8_STAGE(PG8_SB(0, 1), cB + hstepB, voffB); PG8_STAGE(PG8_SA(0, 0), cA, voffA); PG8_STAGE(PG8_SA(0, 1), cA + hstepA, voffA);
    if (wr == 1) PG8_BAR;
    PG8_WAIT_V(2); PG8_BAR;
    PG8_STAGE(PG8_SB(1, 0), cB + kstep, voffB); PG8_STAGE(PG8_SA(1, 0), cA + kstep, voffA); PG8_STAGE(PG8_SB(1, 1), cB + hstepB + kstep, voffB);
    PG8_WAIT_V(6); PG8_BAR;
    for (;;) {
        const bool has_next = S.next(ui + 1, nxt);
        const unsigned nA = has_next ? nxt.A : cA, nB = has_next ? nxt.B : cB;
        for (int t = 0; t < nt; t += 2) {
            const bool last = (t == nt - 2);
            const unsigned a1 = cA + (unsigned)(t + 1) * kstep;
            const unsigned a2 = last ? nA : cA + (unsigned)(t + 2) * kstep, b2 = last ? nB : cB + (unsigned)(t + 2) * kstep;
            const unsigned a3 = a2 + kstep, b3 = b2 + kstep;
            PG8_LDB(B0, 0, 0); PG8_LDB(B1, 0, 1); PG8_SCHED; PG8_LDA(At, 0, 0); PG8_STAGE(PG8_SA(1, 1), a1 + hstepA, voffA);
            PG8_WAIT_V(8); PG8_WAIT_L(0); PG8_BAR; PG8_MMA(0, 0, At, B0); PG8_MMA(0, 1, At, B1); PG8_BAR; PG8_SCHED;
            PG8_LDA(At, 0, 1); PG8_STAGE(PG8_SB(0, 0), b2, voffB); PG8_STAGE(PG8_SB(0, 1), b2 + hstepB, voffB); PG8_STAGE(PG8_SA(0, 0), a2, voffA);
            PG8_WAIT_V(8); PG8_WAIT_L(0); PG8_BAR; PG8_MMA(1, 0, At, B0); PG8_MMA(1, 1, At, B1); PG8_BAR; PG8_SCHED;
            PG8_LDB(B0, 1, 0); PG8_LDB(B1, 1, 1); PG8_SCHED; PG8_LDA(At, 1, 0); PG8_STAGE(PG8_SA(0, 1), a2 + hstepA, voffA);
            PG8_WAIT_V(8); PG8_WAIT_L(0); PG8_BAR; PG8_MMA(0, 0, At, B0); PG8_MMA(0, 1, At, B1); PG8_BAR; PG8_SCHED;
            PG8_LDA(At, 1, 1); PG8_STAGE(PG8_SB(1, 0), b3, voffB); PG8_STAGE(PG8_SB(1, 1), b3 + hstepB, voffB); PG8_STAGE(PG8_SA(1, 0), a3, voffA);
            PG8_WAIT_V(8); PG8_WAIT_L(0); PG8_BAR; PG8_MMA(1, 0, At, B0); PG8_MMA(1, 1, At, B1); PG8_BAR; PG8_SCHED;
        }
        if constexpr (ALIGN_EPI) { if (wr == 0) PG8_BAR; }
        bool zero_acc = true;
        { Unit eu = cur; asm volatile("" : "+s"(eu.pm), "+s"(eu.pn));
          const int lane_o = lane_id(); if constexpr (Epi::INPLACE) zero_acc = E(acc, eu, wr, wc, lane_o & 15, lane_o >> 4, (const LAS u64*)pfslot); else E(acc, eu, wr, wc, lane_o & 15, lane_o >> 4, (const LAS u64*)pfslot); }
        if (!has_next) break;
        PG8_SCHED; PG8_PF(nxt); PG8_SCHED;
        if (zero_acc) {
#pragma unroll
        for (int a = 0; a < 2; ++a)
#pragma unroll
            for (int b = 0; b < 2; ++b)
#pragma unroll
                for (int m = 0; m < 4; ++m)
#pragma unroll
                    for (int n = 0; n < 2; ++n) acc[a][b][m][n] = (f32x4){0.f, 0.f, 0.f, 0.f};
        }
        cur = nxt; cA = nA; cB = nB; ++ui;
        if constexpr (ALIGN_EPI) { if (wr == 1) PG8_BAR; }
    }
    PG8_WAIT_V(0);
    if constexpr (!ALIGN_EPI) { if (wr == 0) PG8_BAR; }
    PG8_BAR;
#undef PG8_PF
#undef PG8_SA
#undef PG8_SB
#undef PG8_STAGE
#undef piecevoffA
#undef piecevoffB
#undef PG8_LDA
#undef PG8_LDB
#undef PG8_MMA
#undef PG8_CAT
#undef PG8_WAIT_V
#undef PG8_WAIT_L
#undef PG8_BAR
#undef PG8_SCHED
}
}
using pg8::Unit;

typedef f32x4 Acc[2][2][4][2];
#define EPI_ROWS(u, wr, fr) const int row0 = (u).pm * 256 + (wr) * 64 + (fr)

__device__ __forceinline__ float ssq_val(const u64* ssq, int row) { return (float)ssq[row] * 2.3283064365386963e-10f; }
__device__ __forceinline__ u64 ssq_fix(float s) { return (u64)(s * 4294967296.0f); }
__device__ __forceinline__ float row_rstd_lds(const LAS u64* pf, int lrow, float invn) { return rsqrtf((float)pf[lrow] * 2.3283064365386963e-10f * invn + EPS); }
__device__ __forceinline__ float row_rstd(const u64* ssq, int row, float invn) { return rsqrtf(ssq_val(ssq, row) * invn + EPS); }
__device__ __forceinline__ void ssq_atomic(u64* ssq, int row, float s, int fr, int fq) {
    const int lane = fr + 16 * fq; s += shflx(s, 16, lane); s += shflx(s, 32, lane);
    if (fq == 0) atomicAdd(ssq + row, ssq_fix(s));
}

struct EpiIn {
    static constexpr bool INPLACE = false, PF = true;
    unsigned char* ws; int l; bool do_ssq; float scale;
    __device__ __forceinline__ unsigned pf_off(const Unit& u) const { return (unsigned)(l == 0 ? WS_SSQA0 : CB_SSQ + (size_t)SSQ_A1 * NTOK * 8) + (u.kind == 1 ? 0u : (unsigned)u.pm * 2048u); }
    __device__ __forceinline__ void operator()(const Acc& acc, const Unit& u, int wr, int wc, int fr, int fq, const LAS u64* pf) const {
        EPI_ROWS(u, wr, fr);
        bf16* proj = (bf16*)(ws + WS_PROJ); float* zf = (float*)(ws + WS_ZF); bf16* mkv = (bf16*)(ws + WS_MKV);
        const u64* ssq_h = l == 0 ? (const u64*)(ws + WS_SSQA0) : (const u64*)(ws + CB_SSQ) + SSQ_A1 * NTOK;
        u64* ssq_cq = (u64*)(ws + CB_SSQ) + (l == 0 ? SSQ_CQ0 : SSQ_CQ1) * NTOK; u64* ssq_ckv = (u64*)(ws + CB_SSQ) + (l == 0 ? SSQ_CKV0 : SSQ_CKV1) * NTOK;
        const float* cosT = (const float*)(ws + WS_COS); const float* sinT = (const float*)(ws + WS_SIN);
        if (u.kind == 1) {
#pragma unroll
            for (int ai = 0; ai < 2; ++ai)
#pragma unroll
                for (int m = 0; m < 4; ++m) { const int row = row0 + ai * 128 + m * 16;
#pragma unroll
                    for (int bj = 0; bj < 2; ++bj) { const int col = u.pn * 256 + bj * 128 + wc * 32 + 8 * fq;
                        *(u32x4*)(mkv + (size_t)row * 2048 + col) = pack8(acc[ai][bj][m][0], acc[ai][bj][m][1]); } }
            return;
        }
        const int pn = u.pn;
        float rsv[2][4];
#pragma unroll
        for (int ai = 0; ai < 2; ++ai)
#pragma unroll
            for (int m = 0; m < 4; ++m) rsv[ai][m] = row_rstd_lds(pf, ai * 128 + wr * 64 + m * 16 + fr, 1.0f / DM) * scale;
#pragma unroll
        for (int ai = 0; ai < 2; ++ai)
#pragma unroll
            for (int m = 0; m < 4; ++m) {
                const int row = row0 + ai * 128 + m * 16;
                const float rs = rsv[ai][m];
                float sq = 0.f;
#pragma unroll
                for (int bj = 0; bj < 2; ++bj) {
                    const int col = pn * 256 + bj * 128 + wc * 32 + 8 * fq;
                    f32x4 v0 = acc[ai][bj][m][0] * rs, v1 = acc[ai][bj][m][1] * rs;
                    if (pn >= 4 && pn < 8) {
                        float* zp = zf + (size_t)row * 1024 + (col - PC_F);
                        *(f32x4*)zp = v0; *(f32x4*)(zp + 4) = v1;
                    } else {
                        if (pn >= 16 && pn < 20) sq += (v0[0] * v0[0] + v0[1] * v0[1]) + (v0[2] * v0[2] + v0[3] * v0[3]) + (v1[0] * v1[0] + v1[1] * v1[1]) + (v1[2] * v1[2] + v1[3] * v1[3]);
                        if (pn == 20 && bj == 0 && wc < 2) {
                            const int j0 = (wc * 32 + 8 * fq) >> 1;
                            const f32x4 cs = *(const f32x4*)(cosT + (size_t)row * 32 + j0), sn = *(const f32x4*)(sinT + (size_t)row * 32 + j0);
                            f32x4 r0, r1;
                            r0[0] = v0[0] * cs[0] - v0[1] * sn[0]; r0[1] = v0[1] * cs[0] + v0[0] * sn[0];
                            r0[2] = v0[2] * cs[1] - v0[3] * sn[1]; r0[3] = v0[3] * cs[1] + v0[2] * sn[1];
                            r1[0] = v1[0] * cs[2] - v1[1] * sn[2]; r1[1] = v1[1] * cs[2] + v1[0] * sn[2];
                            r1[2] = v1[2] * cs[3] - v1[3] * sn[3]; r1[3] = v1[3] * cs[3] + v1[2] * sn[3];
                            v0 = r0; v1 = r1;
                        }
                        if (pn >= 25) {
#pragma unroll
                            for (int j = 0; j < 4; ++j) { v0[j] = EPI_SIGMOID(v0[j]); v1[j] = EPI_SIGMOID(v1[j]); }
                        }
                        *(u32x4*)(proj + (size_t)row * DINP + col) = pack8(v0, v1);
                    }
                }
                if (do_ssq && pn >= 16 && pn < 18) ssq_atomic(ssq_cq, row, sq, fr, fq);
                if (do_ssq && pn >= 18 && pn < 20) ssq_atomic(ssq_ckv, row, sq, fr, fq);
            }
    }
};

struct EpiGateLogit {
    static constexpr bool INPLACE = false, PF = true;
    unsigned char* ws; int l;
    __device__ __forceinline__ unsigned pf_off(const Unit& u) const { return (unsigned)(l == 0 ? WS_SSQA0 : CB_SSQ + (size_t)SSQ_A1 * NTOK * 8) + (unsigned)u.pm * 2048u; }
    __device__ __forceinline__ void operator()(const Acc& acc, const Unit& u, int wr, int wc, int fr, int fq, const LAS u64* pf) const {
        if (MK_LAT_F8 && u.pn >= 24) {
            Unit v = u; v.pn = u.pn - 8; v.kind = 0; const EpiIn e{ws, l, true, 1.0f / (F8_H * F8_WIN)}; e(acc, v, wr, wc, fr, fq, pf); return; }
        EPI_ROWS(u, wr, fr);
        bf16* proj = (bf16*)(ws + WS_PROJ);
        const u64* ssq_h = l == 0 ? (const u64*)(ws + WS_SSQA0) : (const u64*)(ws + CB_SSQ) + SSQ_A1 * NTOK;
        float rsv[2][4];
#pragma unroll
        for (int ai = 0; ai < 2; ++ai)
#pragma unroll
            for (int m = 0; m < 4; ++m) rsv[ai][m] = row_rstd_lds(pf, ai * 128 + wr * 64 + m * 16 + fr, 1.0f / DM) * (1.0f / (F8_H * F8_WIN));
#pragma unroll
        for (int ai = 0; ai < 2; ++ai)
#pragma unroll
            for (int m = 0; m < 4; ++m) {
                const int row = row0 + ai * 128 + m * 16;
                const float rsl = rsv[ai][m] * -1.4426950408889634f;
#pragma unroll
                for (int bj = 0; bj < 2; ++bj) {
                    const int col = u.pn * 256 + bj * 128 + wc * 32 + 8 * fq;
                    f32x4 v0, v1;
#pragma unroll
                    for (int j = 0; j < 4; ++j) { v0[j] = __builtin_amdgcn_rcpf(1.0f + __builtin_amdgcn_exp2f(acc[ai][bj][m][0][j] * rsl)); v1[j] = __builtin_amdgcn_rcpf(1.0f + __builtin_amdgcn_exp2f(acc[ai][bj][m][1][j] * rsl)); }
                    *(u32x4*)(proj + (size_t)row * DINP + PC_GATE + col) = pack8(v0, v1);
                }
            }
    }
};

struct EpiUp {
    static constexpr bool INPLACE = false, PF = true;
    unsigned char* ws; int l;
    __device__ __forceinline__ unsigned pf_off(const Unit& u) const { return (unsigned)(CB_SSQ + (size_t)(u.kind == 0 ? (l == 0 ? SSQ_CQ0 : SSQ_CQ1) : (l == 0 ? SSQ_CKV0 : SSQ_CKV1)) * NTOK * 8) + (unsigned)u.pm * 2048u; }
    __device__ __forceinline__ void operator()(const Acc& acc, const Unit& u, int wr, int wc, int fr, int fq, const LAS u64* pf) const {
        EPI_ROWS(u, wr, fr);
        bf16* qmla = (bf16*)(ws + WS_QMLA); bf16* kvb = (bf16*)(ws + WS_KVB);
        const u64* ssq_cq = (const u64*)(ws + CB_SSQ) + (l == 0 ? SSQ_CQ0 : SSQ_CQ1) * NTOK; const u64* ssq_ckv = (const u64*)(ws + CB_SSQ) + (l == 0 ? SSQ_CKV0 : SSQ_CKV1) * NTOK;
        const float* cosT = (const float*)(ws + WS_COS); const float* sinT = (const float*)(ws + WS_SIN);
        const bool isq = (u.kind == 0);
        float rsv[2][4];
#pragma unroll
        for (int ai = 0; ai < 2; ++ai)
#pragma unroll
            for (int m = 0; m < 4; ++m) rsv[ai][m] = row_rstd_lds(pf, ai * 128 + wr * 64 + m * 16 + fr, 1.0f / 512.0f);
#pragma unroll
        for (int ai = 0; ai < 2; ++ai)
#pragma unroll
            for (int m = 0; m < 4; ++m) {
                const int row = row0 + ai * 128 + m * 16;
                const float rs = rsv[ai][m];
#pragma unroll
                for (int bj = 0; bj < 2; ++bj) {
                    const int col = u.pn * 256 + bj * 128 + wc * 32 + 8 * fq;
                    f32x4 v0 = acc[ai][bj][m][0] * rs, v1 = acc[ai][bj][m][1] * rs;
                    if (isq) {
                        const int c192 = col % QKD;
                        if (c192 >= NOPE) {
                            const int j0 = (c192 - NOPE) >> 1;
                            const f32x4 cs = *(const f32x4*)(cosT + (size_t)row * 32 + j0), sn = *(const f32x4*)(sinT + (size_t)row * 32 + j0);
                            f32x4 r0, r1;
                            r0[0] = v0[0] * cs[0] - v0[1] * sn[0]; r0[1] = v0[1] * cs[0] + v0[0] * sn[0];
                            r0[2] = v0[2] * cs[1] - v0[3] * sn[1]; r0[3] = v0[3] * cs[1] + v0[2] * sn[1];
                            r1[0] = v1[0] * cs[2] - v1[1] * sn[2]; r1[1] = v1[1] * cs[2] + v1[0] * sn[2];
                            r1[2] = v1[2] * cs[3] - v1[3] * sn[3]; r1[3] = v1[3] * cs[3] + v1[2] * sn[3];
                            v0 = r0; v1 = r1;
                        }
                        *(u32x4*)(qmla + (size_t)row * 1536 + col) = pack8(v0, v1);
                    } else {
                        *(u32x4*)(kvb + (size_t)row * 2048 + col) = pack8(v0, v1);
                    }
                }
            }
    }
};

struct EpiGate {
    static constexpr bool INPLACE = true, PF = false;
    unsigned char* ws;
    __device__ __forceinline__ bool operator()(Acc& acc, const Unit& u, int wr, int wc, int fr, int fq, const LAS u64* pf) const {
        EPI_ROWS(u, wr, fr);
        const bf16* proj = (const bf16*)(ws + WS_PROJ); bf16* mrgb = (bf16*)(ws + WS_MRGB);
        const int n = u.kind;
#pragma unroll
        for (int ai = 0; ai < 2; ++ai) {
            u32x4 ga[4][2], gb[4][2];
#pragma unroll
            for (int m = 0; m < 4; ++m)
#pragma unroll
                for (int bj = 0; bj < 2; ++bj) { const int row = row0 + ai * 128 + m * 16, col = u.pn * 256 + bj * 128 + wc * 32 + 8 * fq;
                    const bf16* gp = proj + (size_t)row * DINP + PC_GATE + col;
                    ga[m][bj] = *(const u32x4*)(gp + n * DM);
                    if (n < 2) gb[m][bj] = *(const u32x4*)(gp + (n + 1) * DM); }
#pragma unroll
            for (int m = 0; m < 4; ++m)
#pragma unroll
                for (int bj = 0; bj < 2; ++bj) { const int row = row0 + ai * 128 + m * 16, col = u.pn * 256 + bj * 128 + wc * 32 + 8 * fq;
                    const unsigned aw[4] = {ga[m][bj].x, ga[m][bj].y, ga[m][bj].z, ga[m][bj].w}, bw[4] = {gb[m][bj].x, gb[m][bj].y, gb[m][bj].z, gb[m][bj].w};
                    float f[8];
#pragma unroll
                    for (int j = 0; j < 4; ++j) { float n0 = bflo(aw[j]), n1 = bfhi(aw[j]);
                        if (n > 0) { n0 = fmaxf(n0, 1e-6f); n1 = fmaxf(n1, 1e-6f); }
                        if (n < 2) { n0 *= __builtin_amdgcn_rcpf(fmaxf(bflo(bw[j]), 1e-6f)); n1 *= __builtin_amdgcn_rcpf(fmaxf(bfhi(bw[j]), 1e-6f)); }
                        f[2 * j] = n0; f[2 * j + 1] = n1; }
                    f32x4& v0 = acc[ai][bj][m][0]; f32x4& v1 = acc[ai][bj][m][1];
                    v0[0] *= f[0]; v0[1] *= f[1]; v0[2] *= f[2]; v0[3] *= f[3]; v1[0] *= f[4]; v1[1] *= f[5]; v1[2] *= f[6]; v1[3] *= f[7];
                    if (n == 2) *(u32x4*)(mrgb + (size_t)row * DM + col) = pack8(v0, v1); }
        }
        return n == 2;
    }
};

struct EpiGate0 {
    static constexpr bool INPLACE = false, PF = false;
    unsigned char* ws;
    __device__ __forceinline__ void operator()(const Acc& acc, const Unit& u, int wr, int wc, int fr, int fq, const LAS u64* pf) const {
        EPI_ROWS(u, wr, fr);
        const bf16* proj = (const bf16*)(ws + WS_PROJ); bf16* mrgb = (bf16*)(ws + WS_MRGB);
#pragma unroll
        for (int ai = 0; ai < 2; ++ai) {
            u32x4 ga[4][2];
#pragma unroll
            for (int m = 0; m < 4; ++m)
#pragma unroll
                for (int bj = 0; bj < 2; ++bj) ga[m][bj] = *(const u32x4*)(proj + (size_t)(row0 + ai * 128 + m * 16) * DINP + PC_GATE + u.pn * 256 + bj * 128 + wc * 32 + 8 * fq);
#pragma unroll
            for (int m = 0; m < 4; ++m)
#pragma unroll
                for (int bj = 0; bj < 2; ++bj) { const int row = row0 + ai * 128 + m * 16, col = u.pn * 256 + bj * 128 + wc * 32 + 8 * fq;
                    const u32x4 g = ga[m][bj];
                    const f32x4 v0 = acc[ai][bj][m][0] * (f32x4){bflo(g.x), bfhi(g.x), bflo(g.y), bfhi(g.y)}, v1 = acc[ai][bj][m][1] * (f32x4){bflo(g.z), bfhi(g.z), bflo(g.w), bfhi(g.w)};
                    *(u32x4*)(mrgb + (size_t)row * DM + col) = pack8(v0, v1); }
        }
    }
};
struct EpiGate8 {
    static constexpr bool INPLACE = true, PF = false;
    unsigned char* ws;
    __device__ __forceinline__ bool operator()(Acc& acc, const Unit& u, int wr, int wc, int fr, int fq, const LAS u64* pf) const {
        EPI_ROWS(u, wr, fr);
        const bf16* proj = (const bf16*)(ws + WS_PROJ); bf16* mrgb = (bf16*)(ws + WS_MRGB);
        const int n = u.kind;
        const bf16* bbase = (n == 1) ? proj + PC_GATE + 2 * DM : (const bf16*)mrgb; const unsigned bld = (n == 1) ? (unsigned)DINP : (unsigned)DM;
#pragma unroll
        for (int ai = 0; ai < 2; ++ai) {
            u32x4 ga[4][2], gb[4][2];
#pragma unroll
            for (int m = 0; m < 4; ++m)
#pragma unroll
                for (int bj = 0; bj < 2; ++bj) { const int row = row0 + ai * 128 + m * 16, col = u.pn * 256 + bj * 128 + wc * 32 + 8 * fq;
                    ga[m][bj] = *(const u32x4*)(proj + (size_t)row * DINP + PC_GATE + n * DM + col);
                    gb[m][bj] = *(const u32x4*)(bbase + (size_t)row * bld + col); }
#pragma unroll
            for (int m = 0; m < 4; ++m)
#pragma unroll
                for (int bj = 0; bj < 2; ++bj) { const int row = row0 + ai * 128 + m * 16, col = u.pn * 256 + bj * 128 + wc * 32 + 8 * fq;
                    const unsigned aw[4] = {ga[m][bj].x, ga[m][bj].y, ga[m][bj].z, ga[m][bj].w}, bw[4] = {gb[m][bj].x, gb[m][bj].y, gb[m][bj].z, gb[m][bj].w};
                    f32x4& v0 = acc[ai][bj][m][0]; f32x4& v1 = acc[ai][bj][m][1];
                    if (n == 1) {
#pragma unroll
                        for (int j = 0; j < 4; ++j) { const float f0 = fmaxf(bflo(aw[j]), 1e-6f) * __builtin_amdgcn_rcpf(fmaxf(bflo(bw[j]), 1e-6f)), f1 = fmaxf(bfhi(aw[j]), 1e-6f) * __builtin_amdgcn_rcpf(fmaxf(bfhi(bw[j]), 1e-6f));
                            if (j < 2) { v0[2 * j] *= f0; v0[2 * j + 1] *= f1; } else { v1[2 * j - 4] *= f0; v1[2 * j - 3] *= f1; } }
                    } else {
#pragma unroll
                        for (int j = 0; j < 4; ++j) { const float f0 = __builtin_ldexpf(fmaxf(bflo(aw[j]), 1e-6f), -15), f1 = __builtin_ldexpf(fmaxf(bfhi(aw[j]), 1e-6f), -15);
                            if (j < 2) { v0[2 * j] = v0[2 * j] * f0 + bflo(bw[j]); v0[2 * j + 1] = v0[2 * j + 1] * f1 + bfhi(bw[j]); } else { v1[2 * j - 4] = v1[2 * j - 4] * f0 + bflo(bw[j]); v1[2 * j - 3] = v1[2 * j - 3] * f1 + bfhi(bw[j]); } }
                    }
                    if (n == 2) *(u32x4*)(mrgb + (size_t)row * DM + col) = pack8(v0, v1); }
        }
        return n == 2;
    }
};
static_assert(F8_Y * F8_WBR == 32768.0f, "power-of-two fp8 scales");

template <bool SCALED> struct EpiResT {
    static constexpr bool INPLACE = false, PF = false;
    unsigned char* ws; int ssq_idx; bool f8copy;
    __device__ __forceinline__ void operator()(const Acc& acc, const Unit& u, int wr, int wc, int fr, int fq, const LAS u64* pf) const {
        EPI_ROWS(u, wr, fr);
        bf16* hb = (bf16*)(ws + WS_HB); u64* ssq = (u64*)(ws + CB_SSQ) + ssq_idx * NTOK;
        u32x4 bv[2][4][2];
#pragma unroll
        for (int ai = 0; ai < 2; ++ai)
#pragma unroll
            for (int m = 0; m < 4; ++m)
#pragma unroll
                for (int bj = 0; bj < 2; ++bj) bv[ai][m][bj] = *(const u32x4*)(hb + (size_t)(row0 + ai * 128 + m * 16) * DM + u.pn * 256 + bj * 128 + wc * 32 + 8 * fq);
#pragma unroll
        for (int ai = 0; ai < 2; ++ai)
#pragma unroll
            for (int m = 0; m < 4; ++m) {
                const int row = row0 + ai * 128 + m * 16;
                float sq = 0.f;
#pragma unroll
                for (int bj = 0; bj < 2; ++bj) {
                    const int col = u.pn * 256 + bj * 128 + wc * 32 + 8 * fq;
                    const u32x4 b = bv[ai][m][bj];
                    f32x4 v0 = acc[ai][bj][m][0], v1 = acc[ai][bj][m][1];
                    if (SCALED) {
#pragma unroll
                        for (int j = 0; j < 4; ++j) { v0[j] = __builtin_ldexpf(v0[j], -14); v1[j] = __builtin_ldexpf(v1[j], -14); } }
                    v0 = v0 + (f32x4){bflo(b.x), bfhi(b.x), bflo(b.y), bfhi(b.y)}; v1 = v1 + (f32x4){bflo(b.z), bfhi(b.z), bflo(b.w), bfhi(b.w)};
                    *(u32x4*)(hb + (size_t)row * DM + col) = pack8(v0, v1);
                    if (f8copy) *(u32x2*)(ws + WS_HB8 + (size_t)row * DM + col) = pack8_f8(v0 * F8_H, v1 * F8_H);
                    sq += (v0[0] * v0[0] + v0[1] * v0[1]) + (v0[2] * v0[2] + v0[3] * v0[3]) + (v1[0] * v1[0] + v1[1] * v1[1]) + (v1[2] * v1[2] + v1[3] * v1[3]);
                }
                ssq_atomic(ssq, row, sq, fr, fq);
            }
    }
};

typedef EpiResT<false> EpiRes;
static_assert(F8_ACT * F8_WDN == 16384.0f && F8_H * F8_WGU == 32768.0f, "power-of-two fp8 scales");
template <bool RSTD, bool IN8 = false, bool OUT8 = false> struct EpiSwiglu {
    static constexpr bool INPLACE = false, PF = RSTD;
    unsigned char* ws; unsigned act_off; int ldc; int ssq_idx;
    __device__ __forceinline__ unsigned pf_off(const Unit& u) const { return (unsigned)(CB_SSQ + (size_t)ssq_idx * NTOK * 8) + (unsigned)u.pm * 2048u; }
    __device__ __forceinline__ void operator()(const Acc& acc, const Unit& u, int wr, int wc, int fr, int fq, const LAS u64* pf) const {
        EPI_ROWS(u, wr, fr);
        bf16* act = (bf16*)(ws + act_off); const u64* ssq = (const u64*)(ws + CB_SSQ) + ssq_idx * NTOK;
        float rsv[2][4];
#pragma unroll
        for (int ai = 0; ai < 2; ++ai)
#pragma unroll
            for (int m = 0; m < 4; ++m) { rsv[ai][m] = RSTD ? row_rstd_lds(pf, ai * 128 + wr * 64 + m * 16 + fr, 1.0f / DM) : 1.0f; if (IN8) rsv[ai][m] = __builtin_ldexpf(rsv[ai][m], -15); }
#pragma unroll
        for (int ai = 0; ai < 2; ++ai)
#pragma unroll
            for (int m = 0; m < 4; ++m) {
                const int row = row0 + ai * 128 + m * 16;
                const float rs = rsv[ai][m], rsl = rs * -1.4426950408889634f, rs2 = OUT8 ? __builtin_ldexpf(rs * rs, 3) : rs * rs;
                f32x4 o[2];
#pragma unroll
                for (int n = 0; n < 2; ++n)
#pragma unroll
                    for (int j = 0; j < 4; ++j) { const float ag = acc[ai][0][m][n][j];
                        o[n][j] = ag * __builtin_amdgcn_rcpf(1.0f + __builtin_amdgcn_exp2f(ag * rsl)) * acc[ai][1][m][n][j] * rs2; }
                if (MK_PROBE_MODE == 9 && act_off == 1u) { const u32x4 pk = pack8(o[0], o[1]); asm volatile("" :: "v"(pk)); } else
                if (OUT8) *(u32x2*)((unsigned char*)act + (size_t)row * ldc + u.pn * 128 + wc * 32 + 8 * fq) = pack8_f8(o[0], o[1]); else
                *(u32x4*)(act + (size_t)row * ldc + u.pn * 128 + wc * 32 + 8 * fq) = pack8(o[0], o[1]);
            }
    }
};

struct EpiNull {
    static constexpr bool INPLACE = false, PF = false;
    unsigned char* ws;
    __device__ __forceinline__ void operator()(const Acc& acc, const Unit& u, int wr, int wc, int fr, int fq, const LAS u64* pf) const {
#pragma unroll
        for (int ai = 0; ai < 2; ++ai)
#pragma unroll
            for (int bj = 0; bj < 2; ++bj)
#pragma unroll
                for (int m = 0; m < 4; ++m) { asm volatile("" :: "v"(acc[ai][bj][m][0])); asm volatile("" :: "v"(acc[ai][bj][m][1])); }
    }
};

struct EpiSwigluF8 {
    static constexpr bool INPLACE = false, PF = false;
    unsigned char* ws;
    __device__ __forceinline__ void operator()(const Acc& acc, const Unit& u, int wr, int wc, int fr, int fq, const LAS u64* pf) const {
        EPI_ROWS(u, wr, fr);
        unsigned char* act = ws + WS_ACTE; constexpr int ldc = FFE;
        const float inv = 1.0f / (F8_XS * F8_WGU);
#pragma unroll
        for (int ai = 0; ai < 2; ++ai)
#pragma unroll
            for (int m = 0; m < 4; ++m) {
                const int row = row0 + ai * 128 + m * 16;
                f32x4 o[2];
#pragma unroll
                for (int n = 0; n < 2; ++n)
#pragma unroll
                    for (int j = 0; j < 4; ++j) { const float ag = acc[ai][0][m][n][j];
                        o[n][j] = ag * __builtin_amdgcn_rcpf(1.0f + __builtin_amdgcn_exp2f(ag * (inv * -1.4426950408889634f))) * acc[ai][1][m][n][j] * (inv * inv * F8_ACT); }
                *(u32x2*)(act + (size_t)row * ldc + u.pn * 128 + wc * 32 + 8 * fq) = pack8_f8(o[0], o[1]);
            }
    }
};
struct EpiMoeDown {
    static constexpr bool INPLACE = false, PF = true;
    unsigned char* ws; float oscale;
    __device__ __forceinline__ unsigned pf_off(const Unit& u) const { return (unsigned)WS_RASS + (unsigned)u.pm * 2048u; }
    __device__ __forceinline__ void operator()(const Acc& acc, const Unit& u, int wr, int wc, int fr, int fq, const LAS u64* pf) const {
        EPI_ROWS(u, wr, fr);
        bf16* ys = (bf16*)(ws + WS_YS); const int* rass = (const int*)(ws + WS_RASS); const float* topw = (const float*)(ws + WS_TOPW);
        int rav[2][4]; float wv[2][4];
#pragma unroll
        for (int ai = 0; ai < 2; ++ai)
#pragma unroll
            for (int m = 0; m < 4; ++m) { const u64 v = pf[ai * 128 + wr * 64 + m * 16 + fr]; rav[ai][m] = (int)(unsigned)v; wv[ai][m] = __uint_as_float((unsigned)(v >> 32)) * oscale; }
#pragma unroll
        for (int ai = 0; ai < 2; ++ai)
#pragma unroll
            for (int m = 0; m < 4; ++m) {
                const int ra = rav[ai][m];
                if (ra >= 0) {
                    const float w = wv[ai][m];
#pragma unroll
                    for (int bj = 0; bj < 2; ++bj) {
                        const int col = u.pn * 256 + bj * 128 + wc * 32 + 8 * fq;
                        bf16* dst = u.aux ? (bf16*)(ws + WS_YSQ) + ((size_t)(u.aux - 1) * 2048 + (size_t)(row0 + ai * 128 + m * 16 - 64 * 256)) * DM + col : ys + (size_t)ra * DM + col;
                        *(u32x4*)dst = pack8(acc[ai][bj][m][0] * w, acc[ai][bj][m][1] * w);
                    }
                }
            }
    }
};

struct SchedPlain {
    unsigned A, B; int nM, nN, G, c; unsigned a_tile, b_tile;
    __device__ __forceinline__ bool next(int i, Unit& u) const {
        const int total = nM * nN; const int L = i * G + c; if (L >= total) return false;
        int pm, pn; pg8::tile_decode(pg8::xcd_remap(L, total), nM, nN, pm, pn);
        u.pm = pm; u.pn = pn; u.kind = 0; u.aux = 0; u.A = A + (unsigned)pm * a_tile; u.B = B + (unsigned)pn * b_tile; return true;
    }
};
struct SchedIn {
    unsigned hb, win, memn, wmkv; int G, c, nN1; bool memkv;
    __device__ __forceinline__ bool next(int i, Unit& u) const {
        const int T0 = 32 * nN1, TOT = memkv ? T0 + 32 : T0; const int L = i * G + c; if (L >= TOT) return false;
        const int w = pg8::xcd_remap(L, TOT); int pm, pn;
        if (w < T0) { pg8::tile_decode(w, 32, nN1, pm, pn); u.kind = 0; u.A = hb + (unsigned)pm * 256u * DM * 2u; u.B = win + (unsigned)pn * 256u * DM * 2u; }
        else { pg8::tile_decode(w - T0, 4, 8, pm, pn); u.kind = 1; u.A = memn + (unsigned)pm * 256u * DM * 2u; u.B = wmkv + (unsigned)pn * 256u * DM * 2u; }
        u.pm = pm; u.pn = pn; u.aux = 0; return true;
    }
};
struct SchedIn2 {
    unsigned hb, win, memn, wmkv; int G, c, pnx;
    __device__ __forceinline__ bool next(int i, Unit& u) const {
        const int L = c - (G - 64); if (i != 0 || L < 0) return false;
        if (L < 32) { u.kind = 0; u.pm = L; u.pn = pnx; u.A = hb + (unsigned)L * 256u * DM * 2u; u.B = win + (unsigned)pnx * 256u * DM * 2u; }
        else { const int t = L - 32; u.kind = 1; u.pm = t & 3; u.pn = t >> 2; u.A = memn + (unsigned)(t & 3) * 256u * DM * 2u; u.B = wmkv + (unsigned)(t >> 2) * 256u * DM * 2u; }
        u.aux = 0; return true;
    }
};
struct SchedUp {
    unsigned proj, wq, wkv; int G, c;
    __device__ __forceinline__ bool next(int i, Unit& u) const {
        constexpr int T0 = 32 * 6, TOT = T0 + 32 * 8; const int L = i * G + c; if (L >= TOT) return false;
        const int w = pg8::xcd_remap(L, TOT); int pm, pn;
        if (w < T0) { pg8::tile_decode(w, 32, 6, pm, pn); u.kind = 0; u.A = proj + ((unsigned)pm * 256u * DINP + PC_CQ) * 2u; u.B = wq + (unsigned)pn * 256u * 512u * 2u; }
        else { pg8::tile_decode(w - T0, 32, 8, pm, pn); u.kind = 1; u.A = proj + ((unsigned)pm * 256u * DINP + PC_CKV) * 2u; u.B = wkv + (unsigned)pn * 256u * 512u * 2u; }
        u.pm = pm; u.pn = pn; u.aux = 0; return true;
    }
};
struct SchedGate {
    unsigned y, wbr; int G, c;
    __device__ __forceinline__ bool next(int i, Unit& u) const {
        const int ti = i / 3, n = i - 3 * ti; const int L = ti * G + c; if (L >= 256) return false;
        int pm, pn; pg8::tile_decode(pg8::xcd_remap(L, 256), 32, 8, pm, pn);
        u.pm = pm; u.pn = pn; u.kind = n; u.aux = 0;
        u.A = y + ((unsigned)pm * 256u * 3072u + n * 1024u) * 2u; u.B = wbr + ((unsigned)n * 2048u + pn * 256u) * 1024u * 2u; return true;
    }
};
struct SchedGate0 {
    unsigned y, wbr; int G, c;
    __device__ __forceinline__ bool next(int i, Unit& u) const {
        const int L = i * G + c; if (L >= 256) return false;
        int pm, pn; pg8::tile_decode(pg8::xcd_remap(L, 256), 32, 8, pm, pn);
        u.pm = pm; u.pn = pn; u.kind = 0; u.aux = 0;
        u.A = y + (unsigned)pm * 256u * 3072u * 2u; u.B = wbr + (unsigned)pn * 256u * 1024u * 2u; return true;
    }
};
struct SchedGate8 {
    unsigned y8, wbr8; int G, c;
    __device__ __forceinline__ bool next(int i, Unit& u) const {
        const int ti = i >> 1, n = 1 + (i & 1); const int L = ti * G + c; if (L >= 256) return false;
        int pm, pn; pg8::tile_decode(pg8::xcd_remap(L, 256), 32, 8, pm, pn);
        u.pm = pm; u.pn = pn; u.kind = n; u.aux = 0;
        u.A = y8 + (unsigned)pm * 256u * 2048u + (unsigned)(n - 1) * 1024u; u.B = wbr8 + ((unsigned)(n - 1) * 2048u + (unsigned)pn * 256u) * 1024u; return true;
    }
};
struct SchedMoe {
    unsigned A, B; const unsigned char* ws; int nrt, nN, G, c; unsigned a_tile, b_tile, b_exp;
    __device__ __forceinline__ bool next(int i, Unit& u) const {
        const int total = nrt * nN; const int L = i * G + c; if (L >= total) return false;
        int pm, pn; pg8::tile_decode(pg8::xcd_remap(L, total), nrt, nN, pm, pn);
        const int e = __builtin_amdgcn_readfirstlane(__hip_atomic_load((const int*)(ws + WS_TEXP) + pm, __ATOMIC_RELAXED, __HIP_MEMORY_SCOPE_AGENT));
        u.pm = pm; u.pn = pn; u.kind = e; u.aux = 0; u.A = A + (unsigned)pm * a_tile; u.B = B + (unsigned)e * b_exp + (unsigned)pn * b_tile; return true;
    }
};

struct SchedMoeTail {
    unsigned A, B; const unsigned char* ws; int nrt, G, c; unsigned a_tile, b_tile, b_exp, kq_bytes;
    __device__ __forceinline__ bool next(int i, Unit& u) const {
        const int total = (nrt - 64) * 8 * 4; const int L = i * G + c; if (L >= total) return false;
        const int kq = L & 3, tile = L >> 2, pm = 64 + (tile >> 3), pn = tile & 7;
        const int e = __builtin_amdgcn_readfirstlane(__hip_atomic_load((const int*)(ws + WS_TEXP) + pm, __ATOMIC_RELAXED, __HIP_MEMORY_SCOPE_AGENT));
        u.pm = pm; u.pn = pn; u.kind = e; u.aux = kq + 1; u.A = A + (unsigned)pm * a_tile + (unsigned)kq * kq_bytes; u.B = B + (unsigned)e * b_exp + (unsigned)pn * b_tile + (unsigned)kq * kq_bytes; return true;
    }
};

namespace att {
__device__ __forceinline__ int crow(int r, int hi) { return (r & 3) + 8 * (r >> 2) + 4 * hi; }
__device__ __forceinline__ int v_st(int k, int c) { const int kk = (k & ~0xC) | ((k & 4) << 1) | ((k & 8) >> 1); return ((kk >> 3) * 4 + (c >> 5)) * 512 + ((kk & 7) * 32 + (c & 31)) * 2; }
__device__ __forceinline__ int v_rd_base(int lane) { return ((lane & 3) << 3) | (((lane >> 2) & 3) << 6) | (((lane >> 4) & 1) << 5) | (((lane >> 5) & 1) << 8); }
constexpr int v_rd_off(int d0, int ks, int half) { return d0 * 512 + ks * 4096 + half * 2048; }
template <int OFF> __device__ __forceinline__ s16x4 tr_read(unsigned vb) {
    s16x4 r; asm volatile("ds_read_b64_tr_b16 %0, %1 offset:%2" : "=&v"(r) : "v"(vb), "i"(OFF) : "memory"); return r;
}
template <int D0> __device__ __forceinline__ void pv_one(f32x16& od, unsigned vb, bf16x8 pa0, bf16x8 pa1, bf16x8 pa2, bf16x8 pa3) {
    const s16x4 l0 = tr_read<v_rd_off(D0, 0, 0)>(vb), h0 = tr_read<v_rd_off(D0, 0, 1)>(vb), l1 = tr_read<v_rd_off(D0, 1, 0)>(vb), h1 = tr_read<v_rd_off(D0, 1, 1)>(vb);
    const s16x4 l2 = tr_read<v_rd_off(D0, 2, 0)>(vb), h2 = tr_read<v_rd_off(D0, 2, 1)>(vb), l3 = tr_read<v_rd_off(D0, 3, 0)>(vb), h3 = tr_read<v_rd_off(D0, 3, 1)>(vb);
    asm volatile("s_waitcnt lgkmcnt(0)" ::: "memory"); SBAR();
#define ATT_PK(L, H) (bf16x8){L[0], L[1], L[2], L[3], H[0], H[1], H[2], H[3]}
    od = __builtin_amdgcn_mfma_f32_32x32x16_bf16(pa0, ATT_PK(l0, h0), od, 0, 0, 0);
    od = __builtin_amdgcn_mfma_f32_32x32x16_bf16(pa1, ATT_PK(l1, h1), od, 0, 0, 0);
    od = __builtin_amdgcn_mfma_f32_32x32x16_bf16(pa2, ATT_PK(l2, h2), od, 0, 0, 0);
    od = __builtin_amdgcn_mfma_f32_32x32x16_bf16(pa3, ATT_PK(l3, h3), od, 0, 0, 0);
#undef ATT_PK
}

template <int DK, int K1DIM, bool CAUSAL, bool OUT8 = false>
__device__ __forceinline__ void attn_unit(LAS unsigned char* lds, const int tid, const bf16* __restrict__ Qb, int ldq, const bf16* __restrict__ K1, int ldk1, const bf16* __restrict__ K2, int ldk2,
                                          const bf16* __restrict__ Vp, int ldv, bf16* __restrict__ Ob, int ldo, int NT, int q0, float C) {
    constexpr int NKS = DK / 16, KROWB = DK * 2 + 16  , SHM_K = 64 * KROWB, SHM_V = 64 * 128 * 2;
    constexpr int NC1 = K1DIM / 8, NC2 = (DK - K1DIM) / 8, KC1 = NC1 / 8, KC2 = NC2 / 8;
    static_assert(NC2 == 0 || NC2 == 8, "K2 part is 0 or 64 wide");
    const int wid = tid >> 6, lane = tid & 63, r32 = lane & 31, hi = lane >> 5;
    LAS unsigned char* V_lds = lds; LAS unsigned char* K_lds = lds + 3 * SHM_V;
    LAS float* wsp = (LAS float*)(lds + 3 * SHM_V + 2 * SHM_K) + wid * 64;
    static_assert(3 * SHM_V + 2 * SHM_K + 8 * 64 * 4 <= RING_BYTES, "attention LDS");
    const bool grpB = wid >= 4; LAS float* li_l = wsp; LAS float* al_l = wsp + 32;
    float m_reg = -1e30f, l_reg = 0.f; f32x16 o[4] = {}; bf16x8 qr[NKS];
    { const bf16* Qw = Qb + (unsigned)((wid * 32 + r32) * ldq + hi * 8);
#pragma unroll
      for (int d0 = 0; d0 < NKS; ++d0) qr[d0] = *(const bf16x8*)(Qw + d0 * 16); }
    const int sr = tid >> 4, sc = (tid & 15) * 8, vst0 = v_st(sr, sc), vst1 = v_st(32 + sr, sc);
    const unsigned vb0 = (unsigned)(uintptr_t)V_lds + v_rd_base(lane);
    const unsigned voffv = (unsigned)(sr * ldv + sc);
    unsigned koff1[KC1], kw1[KC1];
#pragma unroll
    for (int i = 0; i < KC1; ++i) { const int c = tid + 512 * i, row = c / NC1, cc = (c % NC1) * 8; koff1[i] = (unsigned)(row * ldk1 + cc); kw1[i] = (unsigned)(row * KROWB + cc * 2); }
    const unsigned koff2 = (unsigned)((tid >> 3) * ldk2 + (tid & 7) * 8), kw2 = (unsigned)((tid >> 3) * KROWB + (K1DIM + (tid & 7) * 8) * 2);
    const unsigned kr0 = (unsigned)(r32 * KROWB + hi * 16);
    bf16x8 ks1[KC1], ks2, vs0, vs1;
#define ATT_SLOAD(k0) do { const bf16* kb_ = K1 + (size_t)(k0) * ldk1; _Pragma("unroll") for (int i_ = 0; i_ < KC1; ++i_) ks1[i_] = *(const bf16x8*)(kb_ + koff1[i_]); \
        if (KC2) { const bf16* k2_ = K2 + (size_t)(k0) * ldk2; ks2 = *(const bf16x8*)(k2_ + koff2); } \
        const bf16* vb_ = Vp + (size_t)(k0) * ldv; vs0 = *(const bf16x8*)(vb_ + voffv); vs1 = *(const bf16x8*)(vb_ + (size_t)32 * ldv + voffv); } while (0)
#define ATT_SWRITE(b, vbuf) do { _Pragma("unroll") for (int i_ = 0; i_ < KC1; ++i_) *(LAS bf16x8*)(K_lds + (b) * SHM_K + kw1[i_]) = ks1[i_]; \
        if (KC2) *(LAS bf16x8*)(K_lds + (b) * SHM_K + kw2) = ks2; \
        *(LAS bf16x8*)(V_lds + (vbuf) * SHM_V + vst0) = vs0; *(LAS bf16x8*)(V_lds + (vbuf) * SHM_V + vst1) = vs1; } while (0)
#define ATT_PV(vbuf) do { const unsigned vb = vb0 + (vbuf) * SHM_V; \
          pv_one<0>(o[0], vb, pa0, pa1, pa2, pa3); pv_one<1>(o[1], vb, pa0, pa1, pa2, pa3); pv_one<2>(o[2], vb, pa0, pa1, pa2, pa3); pv_one<3>(o[3], vb, pa0, pa1, pa2, pa3); } while (0)
    __syncthreads();
    ATT_SLOAD(0); ATT_SWRITE(0, 0); __syncthreads();
    bf16x8 pa0 = {}, pa1 = {}, pa2 = {}, pa3 = {};
    int vcur = 0, vprev = 0;
#pragma unroll 1
    for (int j = 0; j < NT; ++j) {
        const int bsel = j & 1;
        if (grpB && j > 0) ATT_PV(vprev);
        if (j + 1 < NT) ATT_SLOAD((j + 1) * 64);
        f32x16 p0 = {}, p1 = {};
        { const LAS unsigned char* Kb = K_lds + bsel * SHM_K + kr0;
#pragma unroll
          for (int d0 = 0; d0 < NKS; ++d0) {
            const bf16x8 b0 = *(const LAS bf16x8*)(Kb + d0 * 32);
            const bf16x8 b1 = *(const LAS bf16x8*)(Kb + 32 * KROWB + d0 * 32);
            p0 = __builtin_amdgcn_mfma_f32_32x32x16_bf16(b0, qr[d0], p0, 0, 0, 0);
            p1 = __builtin_amdgcn_mfma_f32_32x32x16_bf16(b1, qr[d0], p1, 0, 0, 0); } }
        if (CAUSAL && j >= NT - 4) {
            const int qpos = q0 + wid * 32 + r32, kb = j * 64;
#pragma unroll
            for (int r = 0; r < 16; ++r) { const int kp = kb + crow(r, hi); p0[r] = (kp <= qpos) ? p0[r] : -1e30f; p1[r] = (kp + 32 <= qpos) ? p1[r] : -1e30f; }
        }
        float pmax = p0[0];
#pragma unroll
        for (int r = 1; r < 16; ++r) pmax = fmaxf(pmax, p0[r]);
#pragma unroll
        for (int r = 0; r < 16; ++r) pmax = fmaxf(pmax, p1[r]);
        { auto rr = __builtin_amdgcn_permlane32_swap(__float_as_uint(pmax), __float_as_uint(pmax), false, false); pmax = fmaxf(__uint_as_float(rr[0]), __uint_as_float(rr[1])); }
        if (!__all(pmax <= m_reg)) {
            const float mn = fmaxf(m_reg, pmax), alpha = __builtin_amdgcn_exp2f((m_reg - mn) * C); m_reg = mn; l_reg *= alpha;
            if (hi == 0) al_l[r32] = alpha;
            asm volatile("s_waitcnt lgkmcnt(0)" ::: "memory");
#pragma unroll
            for (int r = 0; r < 16; ++r) { const float a = al_l[crow(r, hi)];
#pragma unroll
                for (int d = 0; d < 4; ++d) o[d][r] *= a; }
        }
        const float mnC = -m_reg * C; float ps = 0.f;
#pragma unroll
        for (int r = 0; r < 16; ++r) { p0[r] = __builtin_amdgcn_exp2f(fmaf(p0[r], C, mnC)); p1[r] = __builtin_amdgcn_exp2f(fmaf(p1[r], C, mnC)); ps += p0[r] + p1[r]; }
        { auto rr = __builtin_amdgcn_permlane32_swap(__float_as_uint(ps), __float_as_uint(ps), false, false); ps = __uint_as_float(rr[0]) + __uint_as_float(rr[1]); }
        l_reg += ps;
#define ATT_PK4(P, BASE, OUT) do { unsigned a0 = cvt_pk_bf16(P[BASE + 0], P[BASE + 1]), a1 = cvt_pk_bf16(P[BASE + 2], P[BASE + 3]); \
        unsigned b0_ = cvt_pk_bf16(P[BASE + 4], P[BASE + 5]), b1_ = cvt_pk_bf16(P[BASE + 6], P[BASE + 7]); \
        auto r0_ = __builtin_amdgcn_permlane32_swap(a0, b0_, false, false); auto r1_ = __builtin_amdgcn_permlane32_swap(a1, b1_, false, false); \
        u32x4 w_ = {r0_[0], r1_[0], r0_[1], r1_[1]}; OUT = *reinterpret_cast<bf16x8*>(&w_); } while (0)
        ATT_PK4(p0, 0, pa0); ATT_PK4(p0, 8, pa1); ATT_PK4(p1, 0, pa2); ATT_PK4(p1, 8, pa3);
#undef ATT_PK4
        if (!grpB) ATT_PV(vcur);
        const int vnext = vcur == 2 ? 0 : vcur + 1;
        if (j + 1 < NT) ATT_SWRITE(bsel ^ 1, vnext);
        vprev = vcur; vcur = vnext;
        __syncthreads();
    }
    if (grpB) ATT_PV(vprev);
    if (hi == 0) li_l[r32] = l_reg;
    asm volatile("s_waitcnt lgkmcnt(0)" ::: "memory");
    int ldo_o = ldo, hi_o = hi; asm volatile("" : "+v"(hi_o), "+s"(ldo_o));
    if constexpr (OUT8) {
        unsigned char* Ow8 = (unsigned char*)Ob + (unsigned)((wid * 32) * ldo_o + r32);
#pragma unroll
        for (int r = 0; r < 16; ++r) { const int orow = crow(r, hi_o); const float rl = __builtin_amdgcn_rcpf(li_l[orow]) * F8_Y;
            unsigned char* op = Ow8 + (unsigned)(orow * ldo_o);
#pragma unroll
            for (int d0 = 0; d0 < 4; ++d0) op[d0 * 32] = (unsigned char)__builtin_amdgcn_cvt_pk_fp8_f32(clamp448(o[d0][r] * rl), 0.f, 0, false); }
    } else {
    bf16* Ow = Ob + (unsigned)((wid * 32) * ldo_o + r32);
#pragma unroll
    for (int r = 0; r < 16; ++r) { const int orow = crow(r, hi_o); const float rl = __builtin_amdgcn_rcpf(li_l[orow]);
        bf16* op = Ow + (unsigned)(orow * ldo_o);
#pragma unroll
        for (int d0 = 0; d0 < 4; ++d0) op[d0 * 32] = f2bf(o[d0][r] * rl); }
    }
#undef ATT_SLOAD
#undef ATT_SWRITE
#undef ATT_PV
}
}

namespace hg {
__device__ __forceinline__ int crow(int r, int hi) { return (r & 3) + 8 * (r >> 2) + 4 * hi; }
__device__ __forceinline__ void mma32(f32x16& acc, const LAS bf16* A, int lda, const LAS bf16* Bt, int ldb, int K, int r32, int hi) {
    for (int k0 = 0; k0 < K; k0 += 16) {
        const bf16x8 a = *(const LAS bf16x8*)(A + r32 * lda + k0 + hi * 8);
        const bf16x8 b = *(const LAS bf16x8*)(Bt + r32 * ldb + k0 + hi * 8);
        acc = __builtin_amdgcn_mfma_f32_32x32x16_bf16(a, b, acc, 0, 0, 0);
    }
}
constexpr int LD_D = 136, LD_S = 72, LD_O = 132;
constexpr int L_TOT = 0;
constexpr int L_VT = 2048;
constexpr int L_KT = L_VT + 128 * LD_S * 2;
constexpr int L_QT = L_KT + 128 * LD_S * 2;
constexpr int L_QH = L_QT + 64 * LD_D * 2;
constexpr int L_P = L_QH + 64 * LD_D * 2;
constexpr int L_O = L_P + 64 * LD_S * 2;
constexpr int L_END = L_O + 64 * LD_O * 4;
static_assert(L_END <= RING_BYTES, "hgrn LDS");

__device__ __forceinline__ void gate_scan(LAS unsigned char* lds, const float (&z)[16], float lb, int d, int jq, float (&kk)[16], float (&bl)[16], float& bref, float& b63) {
    LAS float* tot = (LAS float*)(lds + L_TOT);
    float run = 0.f;
#pragma unroll
    for (int i = 0; i < 16; ++i) {
        const float f = lb + (1.0f - lb) * HG_SIGMOID(z[i]);
        run += __logf(fmaxf(f, 1e-20f)); bl[i] = run; kk[i] = 1.0f - f;
    }
    tot[jq * 128 + d] = run;
    __syncthreads();
    const float t0 = tot[d], t1 = tot[128 + d], t2 = tot[256 + d], t3 = tot[384 + d];
    const float off = (jq > 0 ? t0 : 0.f) + (jq > 1 ? t1 : 0.f) + (jq > 2 ? t2 : 0.f);
#pragma unroll
    for (int i = 0; i < 16; ++i) bl[i] += off;
    bref = t0 + t1; b63 = (t0 + t1) + (t2 + t3);
}
__device__ __forceinline__ void stage_vt(LAS unsigned char* lds, const bf16x8 (&vch)[2], int tid) {
    LAS bf16* VT = (LAS bf16*)(lds + L_VT);
#pragma unroll
    for (int i = 0; i < 2; ++i) { const int id = tid + 512 * i, s = id >> 4, e8 = (id & 15) * 8;
#pragma unroll
        for (int q = 0; q < 8; ++q) VT[(e8 + q) * LD_S + s] = (bf16)vch[i][q]; }
}
__device__ __forceinline__ void pass1_unit(LAS unsigned char* lds, const int tid, int unit, const float* zf, const bf16* proj, const float* lbv, float* hu, float* hdec) {
    const int wid = tid >> 6, lane = tid & 63, r32 = lane & 31, hi = lane >> 5;
    const int bh = unit >> 5, c = unit & 31, b = bh >> 3, hh = bh & 7, tok0 = b * SEQ + c * CHUNK;
    const int d = tid & 127, jq = tid >> 7;
    float z[16], kk[16], bl[16], bref, b63; bf16x8 vch[2];
    const float lb = lbv[hh * 128 + d];
#pragma unroll
    for (int i = 0; i < 16; ++i) z[i] = zf[(size_t)(tok0 + jq * 16 + i) * 1024 + hh * 128 + d];
#pragma unroll
    for (int i = 0; i < 2; ++i) { const int id = tid + 512 * i, s = id >> 4, e8 = (id & 15) * 8; vch[i] = *(const bf16x8*)(proj + (size_t)(tok0 + s) * DINP + PC_I + hh * 128 + e8); }
    __syncthreads();
    gate_scan(lds, z, lb, d, jq, kk, bl, bref, b63);
    LAS bf16* KT = (LAS bf16*)(lds + L_KT);
#pragma unroll
    for (int i = 0; i < 16; ++i) KT[d * LD_S + jq * 16 + i] = f2bf(kk[i] * __expf(b63 - bl[i]));
    stage_vt(lds, vch, tid);
    if (jq == 0) hdec[(size_t)unit * 128 + d] = __expf(b63);
    __syncthreads();
    const LAS bf16* VT = (const LAS bf16*)(lds + L_VT);
    const int eb = wid >> 1;
#pragma unroll
    for (int q = 0; q < 2; ++q) { const int db = (wid & 1) * 2 + q; f32x16 acc = {};
        mma32(acc, VT + eb * 32 * LD_S, LD_S, KT + db * 32 * LD_S, LD_S, 64, r32, hi);
#pragma unroll
        for (int r = 0; r < 16; ++r) hu[(size_t)unit * 16384 + (size_t)(eb * 32 + crow(r, hi)) * 128 + db * 32 + r32] = acc[r]; }
}
__device__ __forceinline__ void pass2_task(int task, const float* hu, const float* hdec, bf16* hs) {
    const int bh = task >> 12, g = task & 4095, d4 = (g & 31) * 4;
    f32x4 st = {0.f, 0.f, 0.f, 0.f};
    const float* p = hu + (size_t)bh * 32 * 16384 + (size_t)g * 4;
    bf16* q = hs + (size_t)bh * 32 * 16384 + (size_t)g * 4;
    const float* dp = hdec + (size_t)bh * 32 * 128 + d4;
#pragma unroll 8
    for (int c = 0; c < 32; ++c) { const f32x4 u = *(const f32x4*)(p + (size_t)c * 16384); const f32x4 dv = *(const f32x4*)(dp + c * 128);
        u32x2 o; o.x = cvt_pk_bf16(st[0], st[1]); o.y = cvt_pk_bf16(st[2], st[3]); *(u32x2*)(q + (size_t)c * 16384) = o; st = dv * st + u; }
}
struct P3In { float z[16]; bf16 qraw[16]; bf16x8 vch[2]; float lb; };
__device__ __forceinline__ void pass3_load(P3In& R, const int tid, int unit, const float* zf, const bf16* proj, const float* lbv, const bf16* hs) {
    const int bh = unit >> 5, c = unit & 31, b = bh >> 3, hh = bh & 7, tok0 = b * SEQ + c * CHUNK;
    const unsigned d = tid & 127, jq = tid >> 7;
    const float* zb = zf + (size_t)tok0 * 1024 + hh * 128; const unsigned zo = jq * 16u * 1024u + d;
    const bf16* qb = proj + (size_t)tok0 * DINP + PC_Q + hh * 128; const unsigned qo = jq * 16u * (unsigned)DINP + d;
    const bf16* vb = proj + (size_t)tok0 * DINP + PC_I + hh * 128; const unsigned vo = ((unsigned)tid >> 4) * (unsigned)DINP + ((unsigned)tid & 15u) * 8u;
    R.lb = (lbv + hh * 128)[d];
#pragma unroll
    for (int i = 0; i < 16; ++i) R.z[i] = (zb + i * 1024)[zo];
#pragma unroll
    for (int i = 0; i < 16; ++i) R.qraw[i] = (qb + i * DINP)[qo];
#pragma unroll
    for (int i = 0; i < 2; ++i) R.vch[i] = *(const bf16x8*)((vb + 32 * i * DINP) + vo);
}
__device__ __forceinline__ void pass3_compute(LAS unsigned char* lds, const int tid, int unit, P3In& R, int next_unit, const float* zf, const bf16* proj, const float* lbv, const bf16* hs, const float* hgn, bf16* y) {
    const int wid = tid >> 6, lane = tid & 63, r32 = lane & 31, hi = lane >> 5;
    const int bh = unit >> 5, c = unit & 31, b = bh >> 3, hh = bh & 7, tok0 = b * SEQ + c * CHUNK;
    const int d = tid & 127, jq = tid >> 7;
    const int tb = wid >> 2, eb = wid & 3;
    const int tn = tid >> 3, part = tid & 7;
    float kk[16], bl[16], bref, b63;
    const float (&z)[16] = R.z; const bf16 (&qraw)[16] = R.qraw; const bf16x8 (&vch)[2] = R.vch; const float lb = R.lb;
    bf16x8 st[8]; u32x4 g0, g1;
    { const bf16* sp = hs + (size_t)unit * 16384 + (size_t)(eb * 32 + r32) * 128 + hi * 8;
#pragma unroll
      for (int k = 0; k < 8; ++k) st[k] = *(const bf16x8*)(sp + 16 * k); }
    { const bf16* gp = proj + (size_t)(tok0 + tn) * DINP + PC_G + hh * 128 + part * 16; g0 = *(const u32x4*)gp; g1 = *(const u32x4*)(gp + 8); }
    __syncthreads();
    gate_scan(lds, z, lb, d, jq, kk, bl, bref, b63);
    LAS bf16* KT = (LAS bf16*)(lds + L_KT); LAS bf16* QT = (LAS bf16*)(lds + L_QT); LAS bf16* QH = (LAS bf16*)(lds + L_QH);
    const float eref = __expf(bref);
#pragma unroll
    for (int i = 0; i < 16; ++i) { const int t = jq * 16 + i;
        const float qv = bf2f(qraw[i]), er = __expf(bl[i] - bref);
        QT[t * LD_D + d] = f2bf(qv * er);
        QH[t * LD_D + d] = f2bf(qv * (er * eref));
        KT[t * LD_D + d] = f2bf(kk[i] * __builtin_amdgcn_rcpf(er)); }
    stage_vt(lds, vch, tid);
    if (next_unit >= 0) pass3_load(R, tid, next_unit, zf, proj, lbv, hs);
    __syncthreads();
    LAS bf16* PL = (LAS bf16*)(lds + L_P);
    if (wid < 4) {
        const int tb2 = wid >> 1, sb = wid & 1; f32x16 acc = {};
        if (!(tb2 == 0 && sb == 1)) mma32(acc, QT + tb2 * 32 * LD_D, LD_D, KT + sb * 32 * LD_D, LD_D, 128, r32, hi);
#pragma unroll
        for (int r = 0; r < 16; ++r) { const int t = tb2 * 32 + crow(r, hi), s2 = sb * 32 + r32; PL[t * LD_S + s2] = f2bf(s2 <= t ? acc[r] : 0.f); }
    }
    __syncthreads();
    {
        f32x16 acc = {};
        mma32(acc, PL + tb * 32 * LD_S, LD_S, (const LAS bf16*)(lds + L_VT) + eb * 32 * LD_S, LD_S, 64, r32, hi);
#pragma unroll
        for (int k = 0; k < 8; ++k) {
            const bf16x8 a = *(const LAS bf16x8*)(QH + (tb * 32 + r32) * LD_D + 16 * k + hi * 8);
            acc = __builtin_amdgcn_mfma_f32_32x32x16_bf16(a, st[k], acc, 0, 0, 0);
        }
        LAS float* OL = (LAS float*)(lds + L_O);
#pragma unroll
        for (int r = 0; r < 16; ++r) OL[(tb * 32 + crow(r, hi)) * LD_O + eb * 32 + r32] = acc[r];
    }
    __syncthreads();
    {
        const LAS float* orow = (const LAS float*)(lds + L_O) + tn * LD_O + part * 16;
        float v[16]; float ss = 0.f;
#pragma unroll
        for (int i = 0; i < 16; ++i) { v[i] = orow[i]; ss += v[i] * v[i]; }
        ss += shflx(ss, 1, lane); ss += shflx(ss, 2, lane); ss += shflx(ss, 4, lane);
        const float rs = rsqrtf(ss * (1.0f / 128.0f) + EPS);
        const unsigned gw[8] = {g0.x, g0.y, g0.z, g0.w, g1.x, g1.y, g1.z, g1.w};
        float ov[16];
#pragma unroll
        for (int i = 0; i < 8; ++i) { const float ga = bflo(gw[i]), gb = bfhi(gw[i]);
            ov[2 * i] = v[2 * i] * rs * hgn[part * 16 + 2 * i] * (ga * HG_SIGMOID(ga));
            ov[2 * i + 1] = v[2 * i + 1] * rs * hgn[part * 16 + 2 * i + 1] * (gb * HG_SIGMOID(gb)); }
        bf16* yp = y + (size_t)(tok0 + tn) * 3072 + hh * 128 + part * 16;
        u32x4 w0, w1;
        w0.x = cvt_pk_bf16(ov[0], ov[1]); w0.y = cvt_pk_bf16(ov[2], ov[3]); w0.z = cvt_pk_bf16(ov[4], ov[5]); w0.w = cvt_pk_bf16(ov[6], ov[7]);
        w1.x = cvt_pk_bf16(ov[8], ov[9]); w1.y = cvt_pk_bf16(ov[10], ov[11]); w1.z = cvt_pk_bf16(ov[12], ov[13]); w1.w = cvt_pk_bf16(ov[14], ov[15]);
        *(u32x4*)yp = w0; *(u32x4*)(yp + 8) = w1;
    }
}
__device__ __forceinline__ void pass3_unit(LAS unsigned char* lds, const int tid, int unit, const float* zf, const bf16* proj, const float* lbv, const bf16* hs, const float* hgn, bf16* y) {
    P3In R; pass3_load(R, tid, unit, zf, proj, lbv, hs); pass3_compute(lds, tid, unit, R, -1, zf, proj, lbv, hs, hgn, y);
}
}

struct TDesc { const float* src; bf16* dst; const float* gain; size_t sstride, dstride; int gstride, nbatch, K, ld, Ndst, map; float f8scale; };
enum { MAP_ID = 0, MAP_WIN = 1, MAP_QUP = 2, MAP_GU_D = 3, MAP_GU_E = 4, MAP_GATE = 5, MAP_WIN4K = 6, MAP_WIN6K = 7 };
__device__ __forceinline__ int src_col(int map, int n) {
    switch (map) {
    case MAP_WIN6K: n += 2048; [[fallthrough]];
    case MAP_WIN4K: n += 4096; [[fallthrough]];
    case MAP_WIN:
        if (n < PC_KR) return n;
        if (n < PC_KR + 64) { const int p = n - PC_KR; return 5120 + (p & 1) * 32 + (p >> 1); }
        if (n < PC_QM) return -1;
        return n - 192;
    case MAP_QUP: { const int hd = n / QKD, c = n % QKD; if (c < NOPE) return n; const int p = c - NOPE; return hd * QKD + NOPE + (p & 1) * 32 + (p >> 1); }
    case MAP_GU_D: { const int t = n >> 8, r = n & 255; return r < 128 ? 128 * t + r : FF + 128 * t + (r - 128); }
    case MAP_GATE: return n + 6208;
    case MAP_GU_E: { const int t = n >> 8, r = n & 255; return r < 128 ? 128 * t + r : FFE + 128 * t + (r - 128); }
    default: return n;
    }
}
__device__ __forceinline__ void transpose_item(const TDesc& D, int item, LAS float* scr, int lane) {
    const int nblk = D.Ndst / 32, per = (D.K / 64) * nblk, bt = item / per, r = item % per, kb = r / nblk, nb = r % nblk, k0 = 64 * kb, n0 = 32 * nb;
    const float* W = D.src + (size_t)bt * D.sstride; bf16* WT = D.dst + (size_t)bt * D.dstride; const float* gn = D.gain ? D.gain + (size_t)bt * D.gstride : nullptr;
    const int sc = src_col(D.map, n0 + (lane & 31));
    const float msk = sc < 0 ? 0.f : 1.f;
    const float* wp = W + (size_t)(k0 + (lane >> 5)) * D.ld + (sc < 0 ? 0 : sc);
    float v[32];
#pragma unroll
    for (int i = 0; i < 32; ++i) v[i] = __builtin_nontemporal_load(wp + (size_t)(2 * i) * D.ld);
#pragma unroll
    for (int i = 0; i < 32; ++i) scr[(2 * i + (lane >> 5)) * 33 + (lane & 31)] = v[i] * msk;
    LDS_WAIT(); asm volatile("" ::: "memory");
    const int c = lane & 7;
    f32x4 g0 = {1.f, 1.f, 1.f, 1.f}, g1 = g0;
    if (gn) { g0 = *(const f32x4*)(gn + k0 + 8 * c); g1 = *(const f32x4*)(gn + k0 + 8 * c + 4); }
    if (D.f8scale != 0.f) {
        g0 = g0 * D.f8scale; g1 = g1 * D.f8scale; unsigned char* W8 = (unsigned char*)D.dst + (size_t)bt * D.dstride;
#pragma unroll
        for (int j = 0; j < 4; ++j) { const int n = (lane >> 3) + 8 * j; const LAS float* s = scr + (8 * c) * 33 + n;
            const f32x4 a = {s[0 * 33] * g0[0], s[1 * 33] * g0[1], s[2 * 33] * g0[2], s[3 * 33] * g0[3]}, b = {s[4 * 33] * g1[0], s[5 * 33] * g1[1], s[6 * 33] * g1[2], s[7 * 33] * g1[3]};
            *(u32x2*)(W8 + (size_t)(n0 + n) * D.K + k0 + 8 * c) = pack8_f8(a, b); }
    } else {
#pragma unroll
    for (int j = 0; j < 4; ++j) { const int n = (lane >> 3) + 8 * j; const LAS float* s = scr + (8 * c) * 33 + n;
        u32x4 o; o.x = cvt_pk_bf16(s[0 * 33] * g0[0], s[1 * 33] * g0[1]); o.y = cvt_pk_bf16(s[2 * 33] * g0[2], s[3 * 33] * g0[3]);
        o.z = cvt_pk_bf16(s[4 * 33] * g1[0], s[5 * 33] * g1[1]); o.w = cvt_pk_bf16(s[6 * 33] * g1[2], s[7 * 33] * g1[3]);
        *(u32x4*)(WT + (size_t)(n0 + n) * D.K + k0 + 8 * c) = o; }
    }
    LDS_WAIT(); asm volatile("" ::: "memory");
}
constexpr int TL_LD = 260, TL_K = 128, TL_RW = TL_K / 8;
__device__ __forceinline__ void tl_decode(const TDesc& D, int tile, int& bt, int& k0, int& n0) {
    const int nblk = D.Ndst / 256, per = (D.K / TL_K) * nblk; bt = tile / per; const int r = tile % per; k0 = TL_K * (r / nblk); n0 = 256 * (r % nblk);
}
__device__ __forceinline__ void tl_load(const TDesc& D, int tile, f32x4 (&v)[TL_RW], int wave, int lane) {
    int bt, k0, n0; tl_decode(D, tile, bt, k0, n0);
    const int sc = src_col(D.map, n0 + 4 * lane);
    const float* wp = D.src + (size_t)bt * D.sstride + (size_t)(k0 + wave * TL_RW) * D.ld + sc;
#pragma unroll
    for (int i = 0; i < TL_RW; ++i) v[i] = __builtin_nontemporal_load((const f32x4*)(wp + (size_t)i * D.ld));
}
__device__ __forceinline__ void tl_store(const TDesc& D, int tile, const f32x4 (&v)[TL_RW], LAS float* scr, int tid, int wave, int lane) {
    int bt, k0, n0; tl_decode(D, tile, bt, k0, n0);
#pragma unroll
    for (int i = 0; i < TL_RW; ++i) *(LAS f32x4*)(scr + (wave * TL_RW + i) * TL_LD + 4 * lane) = v[i];
    __syncthreads();
    constexpr int HK = TL_K / 2;
    const int n = tid >> 1, h = tid & 1; const LAS float* s = scr + (HK * h) * TL_LD + n;
    const float* gn = D.gain ? D.gain + (size_t)bt * D.gstride + k0 + HK * h : nullptr;
    const float sc = D.f8scale != 0.f ? D.f8scale : 1.0f;
#pragma unroll
    for (int p = 0; p < HK / 16; ++p) {
        f32x4 x[4];
#pragma unroll
        for (int q = 0; q < 4; ++q) { f32x4 g = {sc, sc, sc, sc}; if (gn) g = g * *(const f32x4*)(gn + 16 * p + 4 * q);
            const LAS float* sq = s + (16 * p + 4 * q) * TL_LD;
            x[q] = (f32x4){sq[0] * g[0], sq[TL_LD] * g[1], sq[2 * TL_LD] * g[2], sq[3 * TL_LD] * g[3]}; }
        if (D.f8scale != 0.f) {
            unsigned char* W8 = (unsigned char*)D.dst + (size_t)bt * D.dstride + (size_t)(n0 + n) * D.K + k0 + HK * h + 16 * p;
            const u32x2 a = pack8_f8(x[0], x[1]), b = pack8_f8(x[2], x[3]);
            *(u32x4*)W8 = (u32x4){a.x, a.y, b.x, b.y};
        } else {
            bf16* WT = D.dst + (size_t)bt * D.dstride + (size_t)(n0 + n) * D.K + k0 + HK * h + 16 * p;
            *(u32x4*)WT = pack8(x[0], x[1]); *(u32x4*)(WT + 8) = pack8(x[2], x[3]);
        }
    }
    __syncthreads();
}
__device__ __forceinline__ float row_to_bf16(const float* xrow, bf16* orow, const float* gain, bool normalize, int lane, unsigned char* o8 = nullptr) {
    f32x4 v[8]; float s = 0.f;
#pragma unroll
    for (int j = 0; j < 8; ++j) { v[j] = *(const f32x4*)(xrow + 4 * lane + 256 * j); s += (v[j][0] * v[j][0] + v[j][1] * v[j][1]) + (v[j][2] * v[j][2] + v[j][3] * v[j][3]); }
    s = wave_sum(s, lane);
    const float rs = normalize ? rsqrtf(s * (1.0f / DM) + EPS) : 1.0f;
#pragma unroll
    for (int j = 0; j < 8; ++j) { f32x4 w = v[j] * rs; if (gain) w = w * *(const f32x4*)(gain + 4 * lane + 256 * j);
        u32x2 o; o.x = cvt_pk_bf16(w[0], w[1]); o.y = cvt_pk_bf16(w[2], w[3]); *(u32x2*)(orow + 4 * lane + 256 * j) = o;
        if (o8) { const f32x4 z = w * F8_H; int q = 0; q = __builtin_amdgcn_cvt_pk_fp8_f32(clamp448(z[0]), clamp448(z[1]), q, false); q = __builtin_amdgcn_cvt_pk_fp8_f32(clamp448(z[2]), clamp448(z[3]), q, true); *(int*)(o8 + 4 * lane + 256 * j) = q; } }
    return s;
}

struct Args { const void* in[22]; float* out; unsigned char* ws; int ph_lo, ph_hi; };
static_assert(sizeof(Args) == 200 && offsetof(Args, out) == 176 && offsetof(Args, ws) == 184, "Args layout");
constexpr int PH_FINAL = 19, N_PHASES = 20;

__global__ void __launch_bounds__(NTHR, 2) trunk_fwd(Args args) {
    extern __shared__ __attribute__((aligned(16))) unsigned char lds_raw[];
    LAS unsigned char* lds = (LAS unsigned char*)lds_raw;
    const int wave0 = __builtin_amdgcn_readfirstlane((int)threadIdx.x >> 6);
#define PHASE_IDS int tid = wave0 * 64 + lane_id(); const CAS char* kargs = (const CAS char*)__builtin_amdgcn_kernarg_segment_ptr(); asm volatile("" : "+s"(kargs)); \
    GAS unsigned char* wsg = *(GAS unsigned char* const CAS*)(kargs + 184); int G = gridDim.x, bx = blockIdx.x; asm volatile("" : "+v"(tid), "+s"(wsg), "+s"(G), "+s"(bx)); unsigned char* wsl = (unsigned char*)wsg; const int lane = tid & 63, wave = __builtin_amdgcn_readfirstlane(tid >> 6); (void)lane; (void)wave
    unsigned* ctl = (unsigned*)(args.ws + WS_CTL);
    XcdBarrier bar; bar.bar = ctl + CW_BAR; bar.x = 0; bar.st = nullptr; bar.nloc = 0u; bar.nx = 0u;
    const int lo = args.ph_lo, hi = args.ph_hi;
    const bool multi = (hi - lo) > 1;
    if (multi) bar = xcd_barrier_post(ctl + CW_BAR, nullptr, wave0 * 64 + lane_id());
#define IN(k) (lo <= (k) && (k) < hi && ((k) <= MK_LAST_PHASE || (k) == PH_FINAL))
#ifndef MK_KIND_MASK
#define MK_KIND_MASK 0xFFFFFFFFu
#endif
#define KIND(k) ((MK_KIND_MASK >> (k)) & 1u)
#ifndef MK_PROBE_MFMA
#define MK_PROBE_MFMA 0
#endif
#ifndef MK_REPEAT_MASK
#define MK_REPEAT_MASK (MK_PROBE_MODE >= 0 ? (1u << 7) : 0u)
#endif
#define NREP(k) (((MK_REPEAT_MASK >> (k)) & 1u) ? 2 : 1)
#define SEAM(k) do { if (IN(k) && (k) + 1 < hi) xcd_barrier(bar, wave0 * 64 + lane_id()); } while (0)

#define X_IN ((const float*)(*(const GAS float* const CAS*)(kargs + 0)))
#define MEM_IN ((const float*)(*(const GAS float* const CAS*)(kargs + 8)))
#define positions ((const int*)(*(const GAS int* const CAS*)(kargs + 16)))
#define hg_lb ((const float*)(*(const GAS float* const CAS*)(kargs + 24)))
#define attn_norm ((const float*)(*(const GAS float* const CAS*)(kargs + 32)))
#define w_in ((const float*)(*(const GAS float* const CAS*)(kargs + 40)))
#define hg_norm ((const float*)(*(const GAS float* const CAS*)(kargs + 48)))
#define mla_q_norm ((const float*)(*(const GAS float* const CAS*)(kargs + 56)))
#define w_q_up ((const float*)(*(const GAS float* const CAS*)(kargs + 64)))
#define mla_kv_norm ((const float*)(*(const GAS float* const CAS*)(kargs + 72)))
#define w_kv_up ((const float*)(*(const GAS float* const CAS*)(kargs + 80)))
#define mem_norm ((const float*)(*(const GAS float* const CAS*)(kargs + 88)))
#define w_mem_kv ((const float*)(*(const GAS float* const CAS*)(kargs + 96)))
#define w_branch ((const float*)(*(const GAS float* const CAS*)(kargs + 104)))
#define w_o ((const float*)(*(const GAS float* const CAS*)(kargs + 112)))
#define ffn_norm ((const float*)(*(const GAS float* const CAS*)(kargs + 120)))
#define w_dense_gu ((const float*)(*(const GAS float* const CAS*)(kargs + 128)))
#define w_dense_down ((const float*)(*(const GAS float* const CAS*)(kargs + 136)))
#define w_router ((const float*)(*(const GAS float* const CAS*)(kargs + 144)))
#define w_expert_gu ((const float*)(*(const GAS float* const CAS*)(kargs + 152)))
#define w_expert_down ((const float*)(*(const GAS float* const CAS*)(kargs + 160)))
#define final_norm ((const float*)(*(const GAS float* const CAS*)(kargs + 168)))
#define RSRC wsl
#define WIN ((bf16*)(wsl + WS_WIN))
#define WMKV ((bf16*)(wsl + WS_WMKV))
#define WQUP ((bf16*)(wsl + WS_WQUP))
#define WKVUP ((bf16*)(wsl + WS_WKVUP))
#define WBR ((bf16*)(wsl + WS_WBR))
#define WO ((bf16*)(wsl + WS_WO))
#define WGU ((bf16*)(wsl + WS_WGU))
#define WDN ((bf16*)(wsl + WS_WDN))
#define WEGU ((bf16*)(wsl + WS_WEGU))
#define WEDN ((bf16*)(wsl + WS_WEDN))
#define H ((float*)(wsl + WS_H))
#define HB ((bf16*)(wsl + WS_HB))
#define PROJ ((bf16*)(wsl + WS_PROJ))
#define ZF ((float*)(wsl + WS_ZF))
#define MEMN ((bf16*)(wsl + WS_MEMN))
#define MKV ((bf16*)(wsl + WS_MKV))
#define QMLA ((bf16*)(wsl + WS_QMLA))
#define KVB ((bf16*)(wsl + WS_KVB))
#define Y ((bf16*)(wsl + WS_Y))
#define HU ((float*)(wsl + WS_HU))
#define HDEC ((float*)(wsl + WS_HDEC))
#define MRG ((float*)(wsl + WS_MRG))
#define MRGB ((bf16*)(wsl + WS_MRGB))
#define ACT ((bf16*)(wsl + WS_ACT))
#define XS ((bf16*)(wsl + WS_XS))
#define ACTE ((bf16*)(wsl + WS_ACTE))
#define YS ((float*)(wsl + WS_YS))
#define COS ((float*)(wsl + WS_COS))
#define SIN ((float*)(wsl + WS_SIN))
#define LB ((float*)(wsl + WS_LB))
#define SSQA0 ((u64*)(wsl + WS_SSQA0))
#define TOPI ((int*)(wsl + WS_TOPI))
#define TOPW ((float*)(wsl + WS_TOPW))
#define RASS ((int*)(wsl + WS_RASS))
#define TEXP ((int*)(wsl + WS_TEXP))
#define SSQ ((u64*)(wsl + CB_SSQ))
#define BLKCNT ((int*)(wsl + CB_BLKCNT))

    if (KIND(0) && IN(0)) for (int rep = 0; rep < NREP(0); ++rep) { PHASE_IDS;
        LAS float* scr = (LAS float*)(lds + wave * 16384);
        const int gw = bx * NWAVES + wave, NGW = G * NWAVES;
#define TDESC(i) ((i) == 0 ? TDesc{w_in, WIN, attn_norm, (size_t)DM * DIN, (size_t)DINP * DM, DM, 2, DM, DIN, MK_GATE_F8 ? (MK_LAT_F8 ? 4096 : 6400) : DINP, MAP_WIN, 0.f} : \
                  (i) == 1 ? TDesc{w_mem_kv, WMKV, nullptr, (size_t)DM * 2048, (size_t)2048 * DM, 0, 2, DM, 2048, 2048, MAP_ID, 0.f} : \
                  (i) == 2 ? TDesc{w_q_up, WQUP, mla_q_norm, (size_t)512 * 1536, (size_t)1536 * 512, 512, 2, 512, 1536, 1536, MAP_QUP, 0.f} : \
                  (i) == 3 ? TDesc{w_kv_up, WKVUP, mla_kv_norm, (size_t)512 * 2048, (size_t)2048 * 512, 512, 2, 512, 2048, 2048, MAP_ID, 0.f} : \
                  (i) == 4 ? (MK_BR_F8 ? TDesc{w_branch, WBR, nullptr, (size_t)3 * 1024 * 2048, (size_t)3 * 2048 * 1024, 0, 2, 1024, 2048, 2048, MAP_ID, 0.f} : TDesc{w_branch, WBR, nullptr, (size_t)1024 * 2048, (size_t)2048 * 1024, 0, 6, 1024, 2048, 2048, MAP_ID, 0.f}) : \
                  (i) == 5 ? TDesc{w_o, WO, nullptr, (size_t)DM * DM, (size_t)DM * DM, 0, 2, DM, DM, DM, MAP_ID, 0.f} : \
                  (i) == 6 ? TDesc{w_dense_gu, WGU, ffn_norm, 0, 0, 0, 1, DM, 2 * FF, 2 * FF, MAP_GU_D, MK_P7_F8 ? F8_WGU : 0.f} : \
                  (i) == 7 ? TDesc{w_dense_down, WDN, nullptr, 0, 0, 0, 1, FF, DM, DM, MAP_ID, MK_P8_F8 ? F8_WDN : 0.f} : \
                  (i) == 8 ? TDesc{w_expert_gu, WEGU, ffn_norm + DM, (size_t)DM * 2 * FFE, (size_t)2 * FFE * DM, 0, 8, DM, 2 * FFE, 2 * FFE, MAP_GU_E, MK_MOE_F8 ? F8_WGU : 0.f} : \
                             TDesc{w_expert_down, WEDN, nullptr, (size_t)FFE * DM, (size_t)DM * FFE, 0, 8, FFE, DM, DM, MAP_ID, MK_MOE_F8 ? F8_WDN : 0.f})
        constexpr int F8K = 64;
        constexpr int cnt[10] = {2 * (DM / 64) * ((MK_GATE_F8 ? (MK_LAT_F8 ? 4096 : 6400) : DINP) / 32), 2 * (DM / 64) * (2048 / 32), 2 * (512 / 64) * (1536 / 32), 2 * (512 / 64) * (2048 / 32), (MK_BR_F8 ? 2 : 6) * (1024 / 64) * (2048 / 32), 2 * (DM / 64) * (DM / 32),
                                 (DM / 64) * (2 * FF / 32), (FF / 64) * (DM / 32), 8 * (DM / F8K) * (2 * FFE / 32), 8 * (FFE / F8K) * (DM / 32)};
        int total = 0;
#pragma unroll
        for (int i = 0; i < 8; ++i) total += cnt[i];
        for (int it = gw; it < total; it += NGW) {
            int r = it;
#pragma unroll
            for (int i = 0; i < 8; ++i) { if (r >= 0 && r < cnt[i]) { const TDesc D = TDESC(i); transpose_item(D, r, scr, lane); r = -1; } else if (r >= 0) r -= cnt[i]; }
        }
        if (MK_LAT_F8) { const TDesc DL = TDesc{w_in, (bf16*)(wsl + WS_WIN8 + (size_t)6144 * DM), attn_norm, (size_t)DM * DIN, (size_t)WIN8_ROWS * DM, DM, 2, DM, DIN, 2048, MAP_WIN4K, F8_WIN};
            for (int it = gw; it < 2 * (DM / 64) * (2048 / 32); it += NGW) transpose_item(DL, it, scr, lane);
            const TDesc D24 = TDesc{w_in, WIN + (size_t)6144 * DM, attn_norm, (size_t)DM * DIN, (size_t)DINP * DM, DM, 2, DM, DIN, 256, MAP_WIN6K, 0.f};
            for (int it = gw; it < 2 * (DM / 64) * (256 / 32); it += NGW) transpose_item(D24, it, scr, lane); }
        if (MK_BR_F8) {
#pragma unroll
            for (int nb = 1; nb < 3; ++nb) { const TDesc DB = TDesc{w_branch + (size_t)nb * 1024 * 2048, (bf16*)(wsl + WS_WBR8 + (size_t)(nb - 1) * 2048 * 1024), nullptr, (size_t)3 * 1024 * 2048, (size_t)2 * 2048 * 1024, 0, 2, 1024, 2048, 2048, MAP_ID, F8_WBR};
                for (int it = gw; it < 2 * (1024 / 64) * (2048 / 32); it += NGW) transpose_item(DB, it, scr, lane); } }
        __syncthreads();
        {
            LAS float* tscr = (LAS float*)lds;
            constexpr int NT8 = 8 * (DM / TL_K) * (2 * FFE / 256), NT9 = 8 * (FFE / TL_K) * (DM / 256) + (MK_GATE_F8 ? 2 * (DM / TL_K) * (6144 / 256) : 0);
            constexpr int NT9E = 8 * (FFE / TL_K) * (DM / 256);
            const TDesc D8 = TDESC(8), D9e = TDESC(9);
            const TDesc DG = TDesc{w_in, (bf16*)(wsl + WS_WIN8), attn_norm, (size_t)DM * DIN, (size_t)WIN8_ROWS * DM, DM, 2, DM, DIN, 6144, MAP_GATE, F8_WIN};
            f32x4 va[TL_RW], vb[TL_RW];
            constexpr int NTT = NT8 + NT9;
#define TL_LOAD(tt, buf) do { if ((tt) < NTT) { if ((tt) < NT8) tl_load(D8, (tt), buf, wave, lane); else if ((tt) < NT8 + NT9E) tl_load(D9e, (tt) - NT8, buf, wave, lane); else tl_load(DG, (tt) - NT8 - NT9E, buf, wave, lane); } } while (0)
#define TL_STORE(tt, buf) do { if ((tt) < NTT) { if ((tt) < NT8) tl_store(D8, (tt), buf, tscr, tid, wave, lane); else if ((tt) < NT8 + NT9E) tl_store(D9e, (tt) - NT8, buf, tscr, tid, wave, lane); else tl_store(DG, (tt) - NT8 - NT9E, buf, tscr, tid, wave, lane); } } while (0)
            int t = bx;
            TL_LOAD(t, va);
            for (; t < NTT; t += 2 * G) {
                TL_LOAD(t + G, vb); TL_STORE(t, va);
                TL_LOAD(t + 2 * G, va); TL_STORE(t + G, vb);
            }
#undef TL_LOAD
#undef TL_STORE
        }
        for (int m0 = gw; m0 < NTOK; m0 += 4 * NGW) {
            f32x4 xv[4][8];
#pragma unroll
            for (int r = 0; r < 4; ++r) { const int m = m0 + r * NGW; if (m < NTOK) {
#pragma unroll
                for (int j = 0; j < 8; ++j) xv[r][j] = __builtin_nontemporal_load((const f32x4*)(X_IN + (size_t)m * DM + 4 * lane + 256 * j)); } }
#pragma unroll
            for (int r = 0; r < 4; ++r) { const int m = m0 + r * NGW; if (m < NTOK) { float sx = 0.f;
#pragma unroll
                for (int j = 0; j < 8; ++j) { const f32x4 w = xv[r][j]; sx += (w[0] * w[0] + w[1] * w[1]) + (w[2] * w[2] + w[3] * w[3]);
                    u32x2 o; o.x = cvt_pk_bf16(w[0], w[1]); o.y = cvt_pk_bf16(w[2], w[3]); *(u32x2*)(HB + (size_t)m * DM + 4 * lane + 256 * j) = o;
                    if (MK_GATE_F8) { const f32x4 z = w * F8_H; int q = 0; q = __builtin_amdgcn_cvt_pk_fp8_f32(clamp448(z[0]), clamp448(z[1]), q, false); q = __builtin_amdgcn_cvt_pk_fp8_f32(clamp448(z[2]), clamp448(z[3]), q, true); *(int*)(wsl + WS_HB8 + (size_t)m * DM + 4 * lane + 256 * j) = q; } }
                sx = wave_sum(sx, lane); if (lane == 0) SSQA0[m] = ssq_fix(sx); } }
        }
        for (int m = gw; m < NBATCH * NMEM; m += NGW) (void)row_to_bf16(MEM_IN + (size_t)m * DM, MEMN + (size_t)m * DM, mem_norm, true, lane);
        for (int i = bx * NTHR + tid; i < NTOK * 32; i += G * NTHR) { const int tok = i >> 5, j = i & 31;
            const float inv = powf(10000.0f, -((float)j / 32.0f)); const float ang = (float)positions[tok] * inv; COS[i] = cosf(ang); SIN[i] = sinf(ang); }
        for (int i = bx * NTHR + tid; i < 1024; i += G * NTHR) { const float l0 = hg_lb[i], l1 = hg_lb[1024 + i], mx = fmaxf(l0, l1), e0 = expf(l0 - mx), e1 = expf(l1 - mx);
            const float s0 = e0 / (e0 + e1), s1 = e1 / (e0 + e1); LB[i] = 0.f; LB[1024 + i] = fminf(fmaxf((s0 + s1) - s0, 0.f), 1.f); }
    }
    SEAM(0);

    for (int l = 0; l < 2; ++l) {
        const int pb = 1 + 8 * l;
#define ssq_attn ((l == 0) ? SSQA0 : SSQ + SSQ_A1 * NTOK)
#define ssq_cq (SSQ + (l == 0 ? SSQ_CQ0 : SSQ_CQ1) * NTOK)
#define ssq_ckv (SSQ + (l == 0 ? SSQ_CKV0 : SSQ_CKV1) * NTOK)
#define ssq_ffn (SSQ + (l == 0 ? SSQ_F0 : SSQ_F1) * NTOK)
#define lbv (LB + l * 1024)
        if (KIND(1) && IN(pb + 0)) for (int rep = 0; rep < NREP(1); ++rep) { PHASE_IDS;
            const bool deal = (G == 256);
            if (MK_GATE_F8) {
                SchedIn S{(unsigned)WS_HB, (unsigned)(WS_WIN + (size_t)l * DINP * DM * 2), (unsigned)WS_MEMN, (unsigned)(WS_WMKV + (size_t)l * 2048 * DM * 2), G, bx, deal ? (MK_LAT_F8 ? 16 : 24) : 25, !deal};
                EpiIn E{wsl, l, rep == 0, 1.0f};
                pg8::gemm_run<EpiIn, SchedIn>(lds, tid, RSRC, DM, DM, DM, S, E);
                SchedPlain S8{(unsigned)WS_HB8, (unsigned)(WS_WIN8 + (size_t)l * WIN8_ROWS * DM), 32, MK_LAT_F8 ? 32 : 24, G, bx, 256u * DM, 256u * DM};
                EpiGateLogit E8{wsl, l};
                pg8::gemm_run<EpiGateLogit, SchedPlain, true, true>(lds, tid, RSRC, DM / 2, DM / 2, DM / 2, S8, E8);
            } else {
                SchedIn S{(unsigned)WS_HB, (unsigned)(WS_WIN + (size_t)l * DINP * DM * 2), (unsigned)WS_MEMN, (unsigned)(WS_WMKV + (size_t)l * 2048 * DM * 2), G, bx, deal ? 48 : 49, !deal};
                EpiIn E{wsl, l, rep == 0, 1.0f};
                pg8::gemm_run<EpiIn, SchedIn>(lds, tid, RSRC, DM, DM, DM, S, E);
            }
        }
        SEAM(pb + 0);
        if (KIND(2) && IN(pb + 1)) for (int rep = 0; rep < NREP(2); ++rep) { PHASE_IDS;
            SchedUp S{(unsigned)WS_PROJ, (unsigned)(WS_WQUP + (size_t)l * 1536 * 512 * 2), (unsigned)(WS_WKVUP + (size_t)l * 2048 * 512 * 2), G, bx};
            EpiUp E{wsl, l};
            pg8::gemm_run<EpiUp, SchedUp>(lds, tid, RSRC, 512, DINP, 512, S, E);
            if (G == 256) {
                SchedIn2 S2{(unsigned)WS_HB, (unsigned)(WS_WIN + (size_t)l * DINP * DM * 2), (unsigned)WS_MEMN, (unsigned)(WS_WMKV + (size_t)l * 2048 * DM * 2), G, bx, MK_GATE_F8 ? 24 : 48};
                EpiIn E2{wsl, l, false, 1.0f};
                pg8::gemm_run<EpiIn, SchedIn2>(lds, tid, RSRC, DM, DM, DM, S2, E2);
                if (bx >= 192) hg::pass1_unit(lds, tid, bx - 192, ZF, PROJ, lbv, HU, HDEC);
                else for (int j = 0; j < 5; ++j) hg::pass1_unit(lds, tid, 64 + bx + 192 * j, ZF, PROJ, lbv, HU, HDEC);
            } else for (int u = (G - 1 - bx); u < 1024; u += G) hg::pass1_unit(lds, tid, u, ZF, PROJ, lbv, HU, HDEC);
        }
        SEAM(pb + 1);
        if (KIND(3) && IN(pb + 2)) for (int rep = 0; rep < NREP(3); ++rep) { PHASE_IDS;
            const float c_mla = 0.07216878364870322f * 1.4426950408889634f, c_mem = 0.0625f * 1.4426950408889634f;
            for (int vc = bx; vc < 256; vc += G) {
                int nm = 0, q_a = 0, q_b = 0, bh = 0;
                if (vc < 32) { nm = 1; bh = vc; q_a = 7; }
                else if (vc < 64) { nm = 1; bh = vc - 32; q_a = 6; }
                else if (vc < 96) { nm = 2; bh = vc - 64; q_a = 5; q_b = 1; }
                else if (vc < 128) { nm = 2; bh = vc - 96; q_a = 4; q_b = 2; }
                else if (vc < 160) { nm = 2; bh = vc - 128; q_a = 3; q_b = 0; }
#ifndef NO_MLA
                for (int k = 0; k < nm; ++k) { const int b = bh >> 3, h = bh & 7, qb = k ? q_b : q_a; const size_t t0 = (size_t)b * SEQ;
                    if (MK_BR_F8) att::attn_unit<QKD, NOPE, true, true>(lds, tid, QMLA + (t0 + qb * 256) * 1536 + h * QKD, 1536, KVB + t0 * 2048 + h * 256, 2048, PROJ + t0 * DINP + PC_KR, DINP,
                                                    KVB + t0 * 2048 + h * 256 + 128, 2048, (bf16*)(wsl + WS_Y8 + (t0 + qb * 256) * 2048 + h * 128), 2048, 4 * (qb + 1), qb * 256, c_mla);
                    else att::attn_unit<QKD, NOPE, true>(lds, tid, QMLA + (t0 + qb * 256) * 1536 + h * QKD, 1536, KVB + t0 * 2048 + h * 256, 2048, PROJ + t0 * DINP + PC_KR, DINP,
                                                    KVB + t0 * 2048 + h * 256 + 128, 2048, Y + (t0 + qb * 256) * 3072 + 1024 + h * 128, 3072, 4 * (qb + 1), qb * 256, c_mla); }
#endif
            }
            { int tid2 = tid; asm volatile("" : "+v"(tid2));
            for (int vc = bx; vc < 256; vc += G) {
                int nx = 0, x_a = 0, x_b = 0;
                if (vc >= 32 && vc < 64) { nx = 1; x_a = vc - 32; }
                else if (vc >= 128 && vc < 160) { nx = 2; x_a = 32 + 2 * (vc - 128); x_b = x_a + 1; }
                else if (vc >= 160) { const int j = vc - 160; nx = (j < 64) ? 2 : 1; x_a = 96 + j; x_b = 192 + j; }
#ifndef NO_MEM
                for (int k = 0; k < nx; ++k) { const int uu = k ? x_b : x_a, half = uu & 1, qb = (uu >> 1) & 7, bh = uu >> 4, b = bh >> 2, h = bh & 3; const size_t t0 = (size_t)b * SEQ;
                    if (MK_BR_F8) att::attn_unit<MEMD, MEMD, false, true>(lds, tid2, PROJ + (t0 + qb * 256) * DINP + PC_QM + h * 256, DINP, MKV + (size_t)b * 256 * 2048 + h * 256, 2048, nullptr, 0,
                                                      MKV + (size_t)b * 256 * 2048 + 1024 + h * 256 + half * 128, 2048, (bf16*)(wsl + WS_Y8 + (t0 + qb * 256) * 2048 + 1024 + h * 256 + half * 128), 2048, 4, 0, c_mem);
                    else att::attn_unit<MEMD, MEMD, false>(lds, tid2, PROJ + (t0 + qb * 256) * DINP + PC_QM + h * 256, DINP, MKV + (size_t)b * 256 * 2048 + h * 256, 2048, nullptr, 0,
                                                      MKV + (size_t)b * 256 * 2048 + 1024 + h * 256 + half * 128, 2048, Y + (t0 + qb * 256) * 3072 + 2048 + h * 256 + half * 128, 3072, 4, 0, c_mem); }
#endif
            } }
#ifndef NO_P2
            if (rep == 0) { int tid3 = tid; asm volatile("" : "+v"(tid3));
            for (int vc = bx; vc < 256; vc += G) if (vc >= 160) { for (int task = (vc - 160) * NTHR + tid3; task < 32 * 4096; task += 96 * NTHR) hg::pass2_task(task, HU, HDEC, (bf16*)(wsl + WS_HS)); } }
#endif
        }
        SEAM(pb + 2);
        if (KIND(4) && IN(pb + 3)) { PHASE_IDS; const int NU = 1024 * NREP(4);
            hg::P3In ra; int u = bx;
            hg::pass3_load(ra, tid, u & 1023, ZF, PROJ, lbv, (const bf16*)(wsl + WS_HS));
            for (; u < NU; u += G) { int tid_u = tid; asm volatile("" : "+v"(tid_u));
                hg::pass3_compute(lds, tid_u, u & 1023, ra, (u + G < NU) ? ((u + G) & 1023) : -1, ZF, PROJ, lbv, (const bf16*)(wsl + WS_HS), hg_norm + l * 128, Y); } }
        SEAM(pb + 3);
        if (KIND(5) && IN(pb + 4)) for (int rep = 0; rep < NREP(5); ++rep) { PHASE_IDS;
            if (MK_BR_F8) {
                SchedGate0 S0{(unsigned)WS_Y, (unsigned)(WS_WBR + (size_t)l * 3 * 2048 * 1024 * 2), G, bx};
                EpiGate0 E0{wsl};
                pg8::gemm_run<EpiGate0, SchedGate0>(lds, tid, RSRC, 1024, 3072, 1024, S0, E0);
                SchedGate8 S8{(unsigned)WS_Y8, (unsigned)(WS_WBR8 + (size_t)l * 2 * 2048 * 1024), G, bx};
                EpiGate8 E8{wsl};
                const int tid_t = wave0 * 64 + lane_id();
                int k8 = 512; asm volatile("" : "+s"(k8));
                pg8::gemm_run<EpiGate8, SchedGate8, true, true>(lds, tid_t, RSRC, k8, 1024, 512, S8, E8);
                continue; }
            SchedGate S{(unsigned)WS_Y, (unsigned)(WS_WBR + (size_t)l * 3 * 2048 * 1024 * 2), G, bx};
            EpiGate E{wsl};
            pg8::gemm_run<EpiGate, SchedGate>(lds, tid, RSRC, 1024, 3072, 1024, S, E);
        }
        SEAM(pb + 4);
        if (KIND(6) && IN(pb + 5)) { PHASE_IDS;
            SchedPlain S{(unsigned)WS_MRGB, (unsigned)(WS_WO + (size_t)l * DM * DM * 2), 32, 8, G, bx, 256u * DM * 2u, 256u * DM * 2u};
            EpiRes E{wsl, l == 0 ? SSQ_F0 : SSQ_F1, MK_P7_F8 && l == 0};
            pg8::gemm_run<EpiRes, SchedPlain>(lds, tid, RSRC, DM, DM, DM, S, E);
        }
        SEAM(pb + 5);
        if (l == 0) {
            if (KIND(7) && IN(7)) for (int rep = 0; rep < NREP(7); ++rep) { PHASE_IDS;
                if ((MK_P7_F8 || MK_P8_F8) && MK_PROBE_MODE < 0) {
                    EpiSwiglu<true, MK_P7_F8 != 0, MK_P8_F8 != 0> E8{wsl, (unsigned)WS_ACT, FF, SSQ_F0};
                    if (MK_P7_F8) { SchedPlain S8{(unsigned)WS_HB8, (unsigned)WS_WGU, 32, 44, G, bx, 256u * DM, 256u * DM};
                        pg8::gemm_run<EpiSwiglu<true, MK_P7_F8 != 0, MK_P8_F8 != 0>, SchedPlain, true, MK_P7_F8 != 0>(lds, tid, RSRC, DM / 2, DM / 2, DM / 2, S8, E8); }
                    else { SchedPlain S8{(unsigned)WS_HB, (unsigned)WS_WGU, 32, 44, G, bx, 256u * DM * 2u, 256u * DM * 2u};
                        pg8::gemm_run<EpiSwiglu<true, MK_P7_F8 != 0, MK_P8_F8 != 0>, SchedPlain, true, MK_P7_F8 != 0>(lds, tid, RSRC, DM, DM, DM, S8, E8); }
                    continue; }
                SchedPlain S{(unsigned)WS_HB, (unsigned)WS_WGU, 32, 44, G, bx, 256u * DM * 2u, 256u * DM * 2u};
                EpiSwiglu<true> E{wsl, (unsigned)WS_ACT, FF, SSQ_F0};
                if (MK_PROBE_MODE == 8 && rep == 0) { EpiSwiglu<false> EN{wsl, (unsigned)WS_ACT, FF, SSQ_F0}; pg8::gemm_run<EpiSwiglu<false>, SchedPlain, true, false, 0>(lds, tid, RSRC, 128, DM, DM, S, EN); }
                else if (MK_PROBE_MODE == 9 && rep == 0) { EpiSwiglu<true> EN{wsl, 1u, FF, SSQ_F0}; pg8::gemm_run<EpiSwiglu<true>, SchedPlain, true, false, 0>(lds, tid, RSRC, 128, DM, DM, S, EN); }
                else if (MK_PROBE_MODE == 6 && rep == 0) { EpiNull EN{wsl}; pg8::gemm_run<EpiNull, SchedPlain, true, false, 0>(lds, tid, RSRC, 128, DM, DM, S, EN); }
                else if (MK_PROBE_MODE == 7 && rep == 0) { EpiNull EN{wsl}; pg8::gemm_run<EpiNull, SchedPlain, true, false, 0>(lds, tid, RSRC, DM, DM, DM, S, EN); }
                else if (MK_PROBE_MODE == 5 && rep == 0) pg8::gemm_run<EpiSwiglu<true>, SchedPlain, true, false, 0>(lds, tid, RSRC, 128, DM, DM, S, E);
                else if (MK_PROBE_MODE > 0 && MK_PROBE_MODE < 5 && rep == 0) pg8::gemm_run<EpiSwiglu<true>, SchedPlain, true, false, MK_PROBE_MODE % 5>(lds, tid, RSRC, DM, DM, DM, S, E);
                else pg8::gemm_run<EpiSwiglu<true>, SchedPlain>(lds, tid, RSRC, DM, DM, DM, S, E);
            }
            SEAM(7);
            if (KIND(8) && IN(8)) { PHASE_IDS;
                SchedPlain S{(unsigned)WS_ACT, (unsigned)WS_WDN, 32, 8, G, bx, 256u * FF * 2u, 256u * FF * 2u};
                if (MK_P8_F8) { SchedPlain S8{(unsigned)WS_ACT, (unsigned)WS_WDN, 32, 8, G, bx, 256u * FF, 256u * FF};
                    EpiResT<true> E8{wsl, SSQ_A1, MK_GATE_F8 != 0};
                    pg8::gemm_run<EpiResT<true>, SchedPlain, true, true>(lds, tid, RSRC, FF / 2, FF / 2, FF / 2, S8, E8); }
                else {
                EpiRes E{wsl, SSQ_A1, MK_GATE_F8 != 0};
                pg8::gemm_run<EpiRes, SchedPlain>(lds, tid, RSRC, FF, FF, FF, S, E); }
#if MK_PROBE_MFMA
                { f32x4 pa[16]; bf16x8 px, py;
#pragma unroll
                  for (int j = 0; j < 8; ++j) { px[j] = (__bf16)(float)(tid + j); py[j] = (__bf16)(float)(tid - j); }
#pragma unroll
                  for (int j = 0; j < 16; ++j) pa[j] = (f32x4){0.f, 0.f, 0.f, 0.f};
                  for (int it = 0; it < 352; ++it) {
#pragma unroll
                      for (int j = 0; j < 16; ++j) pa[j] = __builtin_amdgcn_mfma_f32_16x16x32_bf16(px, py, pa[j], 0, 0, 0);
                  }
#pragma unroll
                  for (int j = 0; j < 16; ++j) asm volatile("" :: "v"(pa[j]));
                }
#endif
            }
            SEAM(8);
        }
    }
    if (KIND(15) && IN(15)) for (int rep = 0; rep < NREP(15); ++rep) { PHASE_IDS;
        LAS float* wr = (LAS float*)lds;
        LAS int* lcnt = (LAS int*)(lds + 65536);
        const u64* ssq = SSQ + SSQ_F1 * NTOK;
        for (int i = tid; i < DM * 8; i += NTHR) wr[i] = w_router[i] * ffn_norm[DM + (i >> 3)];
        for (int vc = bx; vc < 256; vc += G) {
            if (tid < 8) lcnt[tid] = 0;
            __syncthreads();
            u32x2 hrow[4][8]; float rsq[4];
#pragma unroll
            for (int q = 0; q < 4; ++q) { const int t = vc * 32 + wave * 4 + q;
#pragma unroll
                for (int j = 0; j < 8; ++j) hrow[q][j] = *(const u32x2*)(HB + (size_t)t * DM + 4 * lane + 256 * j); }
#pragma unroll
            for (int q = 0; q < 4; ++q) rsq[q] = row_rstd(ssq, vc * 32 + wave * 4 + q, 1.0f / DM);
#pragma unroll
            for (int q = 0; q < 4; ++q) {
                const int t = vc * 32 + wave * 4 + q;
                float a[8] = {0.f, 0.f, 0.f, 0.f, 0.f, 0.f, 0.f, 0.f};
#pragma unroll
                for (int j = 0; j < 8; ++j) { const int k = 4 * lane + 256 * j; const u32x2 hw = hrow[q][j]; const f32x4 hv = (f32x4){bflo(hw.x), bfhi(hw.x), bflo(hw.y), bfhi(hw.y)};
#pragma unroll
                    for (int kk = 0; kk < 4; ++kk) { const f32x4 w0 = *(const LAS f32x4*)(wr + (k + kk) * 8), w1 = *(const LAS f32x4*)(wr + (k + kk) * 8 + 4);
                        a[0] += hv[kk] * w0[0]; a[1] += hv[kk] * w0[1]; a[2] += hv[kk] * w0[2]; a[3] += hv[kk] * w0[3];
                        a[4] += hv[kk] * w1[0]; a[5] += hv[kk] * w1[1]; a[6] += hv[kk] * w1[2]; a[7] += hv[kk] * w1[3]; } }
                const float rs = rsq[q];
#pragma unroll
                for (int e = 0; e < 8; ++e) a[e] = wave_sum(a[e], lane) * rs;
                int i0 = 0; float l0 = a[0];
#pragma unroll
                for (int e = 1; e < 8; ++e) if (a[e] > l0) { l0 = a[e]; i0 = e; }
                int i1 = -1; float l1 = -3.0e38f;
#pragma unroll
                for (int e = 0; e < 8; ++e) if (e != i0 && a[e] > l1) { l1 = a[e]; i1 = e; }
                if (lane == 0) { const float ex = expf(l1 - l0), w0 = 1.0f / (1.0f + ex); TOPI[2 * t] = i0; TOPI[2 * t + 1] = i1; TOPW[2 * t] = w0; TOPW[2 * t + 1] = ex * w0;
                    __hip_atomic_fetch_add(&lcnt[i0], 1, __ATOMIC_RELAXED, __HIP_MEMORY_SCOPE_WORKGROUP); __hip_atomic_fetch_add(&lcnt[i1], 1, __ATOMIC_RELAXED, __HIP_MEMORY_SCOPE_WORKGROUP); }
            }
            __syncthreads();
            if (tid < 8) BLKCNT[vc * 8 + tid] = lcnt[tid];
            __syncthreads();
        }
    }
    SEAM(15);
    if (KIND(16) && IN(16)) for (int rep = 0; rep < NREP(16); ++rep) { PHASE_IDS;
        LAS int* bc = (LAS int*)lds;
        LAS int* pst = (LAS int*)(lds + 8192);
        LAS int* posl = (LAS int*)(lds + 8192 + 256);
        const u64* ssq = SSQ + SSQ_F1 * NTOK;
        for (int i = tid; i < 2048; i += NTHR) bc[i] = BLKCNT[i];
        __syncthreads();
        for (int vc = bx; vc < 256; vc += G) {
            {
                const int e = wave; int part = 0, mine = 0;
#pragma unroll
                for (int q = 0; q < 4; ++q) { const int i = 4 * lane + q, v = bc[i * 8 + e]; part += v; if (i < vc) mine += v; }
                float tf = wave_sum((float)part, lane), mf = wave_sum((float)mine, lane);
                if (lane == 0) { pst[8 + e] = (int)tf; pst[16 + e] = (int)mf; }
            }
            __syncthreads();
            if (tid == 0) { int s = 0; for (int e = 0; e < 8; ++e) { pst[e] = s; s += (pst[8 + e] + 255) / 256 * 256; }
                if (vc == 0) { int rt = 0; for (int e = 0; e < 8; ++e) { const int n = (pst[8 + e] + 255) / 256; for (int k = 0; k < n; ++k) TEXP[rt++] = e; } TEXP[100] = rt; } }
            __syncthreads();
            if (wave == 0) {
                const int t = vc * 32 + (lane >> 1), e = TOPI[2 * t + (lane & 1)];
                int rank = 0;
#pragma unroll
                for (int ee = 0; ee < 8; ++ee) { const unsigned long long mk = __ballot(e == ee); if (e == ee) rank = __popcll(mk & ((1ull << lane) - 1ull)); }
                const int pos = pst[e] + pst[16 + e] + rank;
                posl[lane] = pos; *(u32x2*)(RASS + 2 * pos) = (u32x2){(unsigned)(2 * t + (lane & 1)), __float_as_uint(TOPW[2 * t + (lane & 1)])}; ((int*)(wsl + WS_POS))[2 * t + (lane & 1)] = pos;
            }
            if (vc < 8 && wave == 1) { const int e = vc, s = pst[e] + pst[8 + e], en = pst[e] + (pst[8 + e] + 255) / 256 * 256; for (int p = s + lane; p < en; p += 64) *(u32x2*)(RASS + 2 * p) = (u32x2){0xffffffffu, 0u}; }
            if (vc < 8 && wave >= 2) { const int e = vc, s = pst[e] + pst[8 + e], en = pst[e] + (pst[8 + e] + 255) / 256 * 256;
                for (int p = s + (wave - 2); p < en; p += 6) for (int j = 0; j < 8; ++j) { if (MK_MOE_F8) *(int*)((unsigned char*)XS + (size_t)p * DM + 4 * lane + 256 * j) = 0; else *(u32x2*)(XS + (size_t)p * DM + 4 * lane + 256 * j) = (u32x2){0u, 0u}; } }
            __syncthreads();
            {
                u32x2 hv[4][8]; float rsv[4];
#pragma unroll
                for (int i4 = 0; i4 < 4; ++i4) { const int t = vc * 32 + wave * 4 + i4;
#pragma unroll
                    for (int j = 0; j < 8; ++j) hv[i4][j] = *(const u32x2*)(HB + (size_t)t * DM + 4 * lane + 256 * j); }
#pragma unroll
                for (int i4 = 0; i4 < 4; ++i4) rsv[i4] = row_rstd(ssq, vc * 32 + wave * 4 + i4, 1.0f / DM);
#pragma unroll
                for (int i4 = 0; i4 < 4; ++i4) { const int p0 = posl[wave * 8 + 2 * i4], p1 = posl[wave * 8 + 2 * i4 + 1]; const float rs = rsv[i4];
#pragma unroll
                    for (int j = 0; j < 8; ++j) { const u32x2 hw = hv[i4][j]; const f32x4 v = (f32x4){bflo(hw.x), bfhi(hw.x), bflo(hw.y), bfhi(hw.y)} * rs;
                        if (MK_MOE_F8) { const f32x4 w = v * F8_XS; int q = 0; q = __builtin_amdgcn_cvt_pk_fp8_f32(clamp448(w[0]), clamp448(w[1]), q, false); q = __builtin_amdgcn_cvt_pk_fp8_f32(clamp448(w[2]), clamp448(w[3]), q, true);
                            *(int*)((unsigned char*)XS + (size_t)p0 * DM + 4 * lane + 256 * j) = q; *(int*)((unsigned char*)XS + (size_t)p1 * DM + 4 * lane + 256 * j) = q; }
                        else { u32x2 o; o.x = cvt_pk_bf16(v[0], v[1]); o.y = cvt_pk_bf16(v[2], v[3]); *(u32x2*)(XS + (size_t)p0 * DM + 4 * lane + 256 * j) = o; *(u32x2*)(XS + (size_t)p1 * DM + 4 * lane + 256 * j) = o; } } }
            }
            __syncthreads();
        }
    }
    SEAM(16);
    if (KIND(17) && IN(17)) for (int rep = 0; rep < NREP(17); ++rep) { PHASE_IDS;
        const int nrt = __builtin_amdgcn_readfirstlane(__hip_atomic_load(TEXP + 100, __ATOMIC_RELAXED, __HIP_MEMORY_SCOPE_AGENT));
        if (MK_MOE_F8) {
            SchedMoe S{(unsigned)WS_XS, (unsigned)WS_WEGU, wsl, nrt, 56, G, bx, 256u * DM, 256u * DM, 2u * FFE * DM};
            EpiSwigluF8 E{wsl};
            pg8::gemm_run<EpiSwigluF8, SchedMoe, true, true>(lds, tid, RSRC, DM / 2, DM / 2, DM / 2, S, E);
        } else {
            SchedMoe S{(unsigned)WS_XS, (unsigned)WS_WEGU, wsl, nrt, 56, G, bx, 256u * DM * 2u, 256u * DM * 2u, 2u * FFE * DM * 2u};
            EpiSwiglu<false> E{wsl, (unsigned)WS_ACTE, FFE, 0};
            pg8::gemm_run<EpiSwiglu<false>, SchedMoe>(lds, tid, RSRC, DM, DM, DM, S, E);
        }
    }
    SEAM(17);
    if (KIND(18) && IN(18)) for (int rep = 0; rep < NREP(18); ++rep) { PHASE_IDS;
        const int nrt = __builtin_amdgcn_readfirstlane(__hip_atomic_load(TEXP + 100, __ATOMIC_RELAXED, __HIP_MEMORY_SCOPE_AGENT));
        if (MK_MOE_F8) {
            SchedMoe S{(unsigned)WS_ACTE, (unsigned)WS_WEDN, wsl, 64, 8, G, bx, 256u * FFE, 256u * FFE, (unsigned)DM * FFE};
            EpiMoeDown E{wsl, 1.0f / (F8_ACT * F8_WDN)};
            pg8::gemm_run<EpiMoeDown, SchedMoe, true, true>(lds, tid, RSRC, FFE / 2, FFE / 2, FFE / 2, S, E);
            SchedMoeTail ST{(unsigned)WS_ACTE, (unsigned)WS_WEDN, wsl, nrt, G, bx, 256u * FFE, 256u * FFE, (unsigned)DM * FFE, (unsigned)FFE / 4};
            const int tid_t = wave0 * 64 + lane_id();
            pg8::gemm_run<EpiMoeDown, SchedMoeTail, true, true>(lds, tid_t, RSRC, FFE / 8, FFE / 2, FFE / 2, ST, E);
        } else {
            SchedMoe S{(unsigned)WS_ACTE, (unsigned)WS_WEDN, wsl, nrt, 8, G, bx, 256u * FFE * 2u, 256u * FFE * 2u, (unsigned)DM * FFE * 2u};
            EpiMoeDown E{wsl, 1.0f};
            pg8::gemm_run<EpiMoeDown, SchedMoe>(lds, tid, RSRC, FFE, FFE, FFE, S, E);
        }
    }
    SEAM(18);
    if (IN(PH_FINAL)) { PHASE_IDS;
        const int gw = bx * NWAVES + wave, NGW = G * NWAVES;
        const bool have_moe = (MK_LAST_PHASE >= 18), have_h = (MK_LAST_PHASE >= 6); float* out_p = (float*)*(GAS float* const CAS*)(kargs + 176);
        for (int m0 = gw; m0 < NTOK; m0 += 2 * NGW) {
            int pos[2][2];
#pragma unroll
            for (int r = 0; r < 2; ++r) { const int m = m0 + r * NGW;
#pragma unroll
                for (int kk = 0; kk < 2; ++kk) pos[r][kk] = (have_moe && m < NTOK) ? __hip_atomic_load((const int*)(wsl + WS_POS) + 2 * m + kk, __ATOMIC_RELAXED, __HIP_MEMORY_SCOPE_AGENT) : 0; }
#pragma unroll
            for (int r = 0; r < 2; ++r)
#pragma unroll
                for (int kk = 0; kk < 2; ++kk) pos[r][kk] = __builtin_amdgcn_readfirstlane(pos[r][kk]);
            u32x2 hbv[2][8], yv[2][2][8];
#pragma unroll
            for (int r = 0; r < 2; ++r) { const int m = m0 + r * NGW; if (m < NTOK) {
#pragma unroll
                for (int j = 0; j < 8; ++j) { const int k = 4 * lane + 256 * j; hbv[r][j] = *(const u32x2*)(HB + (size_t)m * DM + k);
#pragma unroll
                    for (int kk = 0; kk < 2; ++kk) { const bool tl = MK_MOE_F8 && pos[r][kk] >= 64 * 256;
                        const bf16* yp = tl ? (const bf16*)(wsl + WS_YSQ) + (size_t)(pos[r][kk] - 64 * 256) * DM : (const bf16*)YS + (size_t)(2 * m + kk) * DM;
                        yv[r][kk][j] = have_moe ? *(const u32x2*)(yp + k) : (u32x2){0u, 0u}; } } } }
#pragma unroll
            for (int r = 0; r < 2; ++r) { const int m = m0 + r * NGW; if (m < NTOK) {
                f32x4 v[8]; float sx = 0.f;
#pragma unroll
                for (int j = 0; j < 8; ++j) { const int k = 4 * lane + 256 * j; const u32x2 hw = hbv[r][j];
                    v[j] = have_h ? (f32x4){bflo(hw.x), bfhi(hw.x), bflo(hw.y), bfhi(hw.y)} : *(const f32x4*)(X_IN + (size_t)m * DM + k);
#pragma unroll
                    for (int kk = 0; kk < 2; ++kk) { const u32x2 ya = yv[r][kk][j]; v[j][0] += bflo(ya.x); v[j][1] += bfhi(ya.x); v[j][2] += bflo(ya.y); v[j][3] += bfhi(ya.y);
                        if (MK_MOE_F8 && have_moe && pos[r][kk] >= 64 * 256) {
#pragma unroll
                            for (int q = 1; q < 4; ++q) { const u32x2 yb = *(const u32x2*)((const bf16*)(wsl + WS_YSQ) + ((size_t)q * 2048 + (pos[r][kk] - 64 * 256)) * DM + k);
                                v[j][0] += bflo(yb.x); v[j][1] += bfhi(yb.x); v[j][2] += bflo(yb.y); v[j][3] += bfhi(yb.y); } } }
                    sx += (v[j][0] * v[j][0] + v[j][1] * v[j][1]) + (v[j][2] * v[j][2] + v[j][3] * v[j][3]); }
                const float rs = rsqrtf(wave_sum(sx, lane) * (1.0f / DM) + EPS);
#pragma unroll
                for (int j = 0; j < 8; ++j) { const int k = 4 * lane + 256 * j; *(f32x4*)(out_p + (size_t)m * DM + k) = v[j] * rs * *(const f32x4*)(final_norm + k); }
            } }
        }
    }
#undef IN
#undef SEAM
}

extern "C" void kernel_launch(void* const* d_in, const int* in_sizes, int n_in, void* d_out, int out_size, void* d_ws, size_t ws_size, hipStream_t stream) {
    static int grid = 0;
    if (grid == 0) {
        if (n_in != 22 || out_size != NTOK * DM || ws_size < WS_END) { fprintf(stderr, "kernel_launch: unexpected shapes (n_in %d, out %d, ws %zu < %zu); nothing launched\n", n_in, out_size, ws_size, (size_t)WS_END); grid = -1; return; }
        int dev = 0, cus = 0, per_cu = 0;
        if (hipGetDevice(&dev) != hipSuccess || hipDeviceGetAttribute(&cus, hipDeviceAttributeMultiprocessorCount, dev) != hipSuccess) { grid = -1; return; }
        if (hipFuncSetAttribute((const void*)trunk_fwd, hipFuncAttributeMaxDynamicSharedMemorySize, LDS_BYTES) != hipSuccess) { fprintf(stderr, "kernel_launch: hipFuncSetAttribute failed\n"); grid = -1; return; }
        if (hipOccupancyMaxActiveBlocksPerMultiprocessor(&per_cu, (const void*)trunk_fwd, NTHR, LDS_BYTES) != hipSuccess || per_cu < 1) fprintf(stderr, "kernel_launch: occupancy query reports %d\n", per_cu);
        (void)hipGetLastError();
        grid = cus;
    }
    if (grid < 0) return;
    (void)hipMemsetAsync((char*)d_ws + WS_CTL, 0, CTL_BYTES, stream);
    Args a{};
    for (int i = 0; i < 22; ++i) a.in[i] = d_in[i];
    a.out = (float*)d_out; a.ws = (unsigned char*)d_ws;
    if (MK_N_LAUNCHES == 1) { a.ph_lo = 0; a.ph_hi = N_PHASES; hipLaunchKernelGGL(trunk_fwd, dim3(grid), dim3(NTHR), LDS_BYTES, stream, a); }
    else { for (int p = 0; p < N_PHASES; ++p) { if (p > MK_LAST_PHASE && p != PH_FINAL) continue; a.ph_lo = p; a.ph_hi = p + 1; hipLaunchKernelGGL(trunk_fwd, dim3(grid), dim3(NTHR), LDS_BYTES, stream, a); } }
    const hipError_t le = hipPeekAtLastError();
    if (le != hipSuccess) fprintf(stderr, "kernel_launch: launch failed: %s\n", hipGetErrorName(le));
}
```
